# Optimizing an MI355X kernel written in HIP

```python
import jax, jax.numpy as jnp
from jax import lax
import numpy as np

D_MODEL = 1024
BATCH = 2
SEQ = 8192
DEPTH = 1

GRID_W = 64
D_MIX = 2 * D_MODEL
SSM_HEADS = 16
SSM_HEAD_DIM = 64
D_SSM = SSM_HEADS * SSM_HEAD_DIM
SSM_GROUPS = 2
HEADS_PER_GROUP = SSM_HEADS // SSM_GROUPS
D_STATE = 128
D_CONV = 5
CHUNK = 128
CONV_DIM = D_SSM + 2 * SSM_GROUPS * D_STATE
NA_HEADS = 16
NA_HEAD_DIM = 64
D_NA = NA_HEADS * NA_HEAD_DIM
NA_MAX_ROWS = 8
NA_COLS = 16
D_FF = 4 * D_MODEL
PROJ_DIM = D_SSM + CONV_DIM + 2 * SSM_HEADS + 3 * D_NA
EPS = 1e-5

kernel_name = "hymba_ssd_natten_sqrelu_block"


def rmsnorm(x, w):
    xf = x.astype(jnp.float32)
    y = xf * lax.rsqrt(jnp.mean(xf * xf, axis=-1, keepdims=True) + EPS)
    return (y * w.astype(jnp.float32)).astype(x.dtype)


def depthwise_conv_centred(u, w, b):
    pad_l = (D_CONV - 1) // 2
    out = lax.conv_general_dilated(
        u, w.astype(u.dtype)[:, None, :], window_strides=(1,),
        padding=[(pad_l, D_CONV - 1 - pad_l)],
        dimension_numbers=("NWC", "WIO", "NWC"),
        feature_group_count=u.shape[-1])
    return out + b.astype(u.dtype)


def ssd_chunked(xdt, log_a, b_mat, c_mat):
    bsz, t = xdt.shape[:2]
    nc = t // CHUNK
    xc = xdt.astype(jnp.float32).reshape(bsz, nc, CHUNK, SSM_GROUPS, HEADS_PER_GROUP, SSM_HEAD_DIM)
    ac = log_a.astype(jnp.float32).reshape(bsz, nc, CHUNK, SSM_GROUPS, HEADS_PER_GROUP)
    bc = b_mat.astype(jnp.float32).reshape(bsz, nc, CHUNK, SSM_GROUPS, D_STATE)
    cc = c_mat.astype(jnp.float32).reshape(bsz, nc, CHUNK, SSM_GROUPS, D_STATE)
    a_cum = jnp.cumsum(ac, axis=2)
    seg = a_cum[:, :, :, None] - a_cum[:, :, None, :]
    lower = jnp.tril(jnp.ones((CHUNK, CHUNK), dtype=bool))[None, None, :, :, None, None]
    decay = jnp.exp(jnp.where(lower, seg, -jnp.inf))
    cb = jnp.einsum("bclgn,bcsgn->bclsg", cc, bc)
    y_diag = jnp.einsum("bclsge,bcsgep->bclgep", cb[..., None] * decay, xc)
    decay_to_end = jnp.exp(a_cum[:, :, -1:] - a_cum)
    chunk_states = jnp.einsum("bclgn,bclgep->bcgepn", bc, xc * decay_to_end[..., None])
    chunk_decay = jnp.exp(a_cum[:, :, -1])

    def step(h, inp):
        s_c, d_c = inp
        return d_c[..., None, None] * h + s_c, h

    h0 = jnp.zeros((bsz, SSM_GROUPS, HEADS_PER_GROUP, SSM_HEAD_DIM, D_STATE), jnp.float32)
    _, h_in = lax.scan(step, h0, (jnp.moveaxis(chunk_states, 1, 0), jnp.moveaxis(chunk_decay, 1, 0)))
    h_in = jnp.moveaxis(h_in, 0, 1)
    y_off = jnp.einsum("bclgn,bcgepn->bclgep", cc, h_in) * jnp.exp(a_cum)[..., None]
    return (y_diag + y_off).reshape(bsz, t, SSM_GROUPS, HEADS_PER_GROUP, SSM_HEAD_DIM)


def ssd_mixer(z, xbc, dt_raw, conv_w, conv_b, dt_bias_f, dt_bias_b, a_log_f, a_log_b, d_skip, norm_w):
    bsz, t, _ = xbc.shape
    xbc = jax.nn.silu(depthwise_conv_centred(xbc, conv_w, conv_b))
    xs, b_mat, c_mat = jnp.split(xbc, [D_SSM, D_SSM + SSM_GROUPS * D_STATE], axis=-1)
    xs = xs.astype(jnp.float32).reshape(bsz, t, SSM_GROUPS, HEADS_PER_GROUP, SSM_HEAD_DIM)
    b_mat = b_mat.reshape(bsz, t, SSM_GROUPS, D_STATE)
    c_mat = c_mat.reshape(bsz, t, SSM_GROUPS, D_STATE)
    dt_f_raw, dt_b_raw = jnp.split(dt_raw.astype(jnp.float32), 2, axis=-1)
    dt_f = jax.nn.softplus(dt_f_raw + dt_bias_f.astype(jnp.float32)).reshape(bsz, t, SSM_GROUPS, HEADS_PER_GROUP)
    dt_b = jax.nn.softplus(dt_b_raw + dt_bias_b.astype(jnp.float32)).reshape(bsz, t, SSM_GROUPS, HEADS_PER_GROUP)
    a_f = -jnp.exp(a_log_f.astype(jnp.float32)).reshape(SSM_GROUPS, HEADS_PER_GROUP)
    a_b = -jnp.exp(a_log_b.astype(jnp.float32)).reshape(SSM_GROUPS, HEADS_PER_GROUP)
    flip = lambda u: jnp.flip(u, axis=1)
    y_f = ssd_chunked(xs * dt_f[..., None], dt_f * a_f, b_mat, c_mat)
    y_b = flip(ssd_chunked(flip(xs * dt_b[..., None]), flip(dt_b * a_b), flip(b_mat), flip(c_mat)))
    y = y_f + y_b + d_skip.astype(jnp.float32).reshape(SSM_GROUPS, HEADS_PER_GROUP)[..., None] * xs
    gw = D_SSM // SSM_GROUPS
    g = y.reshape(bsz, t, SSM_GROUPS, gw) * jax.nn.silu(z.astype(jnp.float32)).reshape(bsz, t, SSM_GROUPS, gw)
    g = g * lax.rsqrt(jnp.mean(g * g, axis=-1, keepdims=True) + EPS)
    g = g * norm_w.astype(jnp.float32).reshape(SSM_GROUPS, gw)
    return g.reshape(bsz, t, D_SSM).astype(z.dtype)


def neighbourhood_attention(q, k, v, q_norm_w, k_norm_w, rpb):
    bsz, t, _ = q.shape
    rows = t // GRID_W
    kh = min(NA_MAX_ROWS, rows)
    q = rmsnorm(q.reshape(bsz, t, NA_HEADS, NA_HEAD_DIM), q_norm_w) * (NA_HEAD_DIM ** -0.5)
    k = rmsnorm(k.reshape(bsz, t, NA_HEADS, NA_HEAD_DIM), k_norm_w)
    qg = q.reshape(bsz, rows, GRID_W, NA_HEADS, NA_HEAD_DIM)
    kg = k.reshape(bsz, rows, GRID_W, NA_HEADS, NA_HEAD_DIM)
    vg = v.reshape(bsz, rows, GRID_W, NA_HEADS, NA_HEAD_DIM)
    col = jnp.arange(GRID_W)
    c0 = jnp.clip(col - NA_COLS // 2, 0, GRID_W - NA_COLS)
    col_win = c0[:, None] + jnp.arange(NA_COLS)
    col_rel = col_win - col[:, None] + (NA_COLS - 1)

    def row_block(i):
        r0 = jnp.clip(i - kh // 2, 0, rows - kh)
        q_i = lax.dynamic_index_in_dim(qg, i, axis=1, keepdims=False)
        k_rows = lax.dynamic_slice_in_dim(kg, r0, kh, axis=1)
        v_rows = lax.dynamic_slice_in_dim(vg, r0, kh, axis=1)
        k_win = k_rows[:, :, col_win]
        v_win = v_rows[:, :, col_win]
        row_rel = r0 + jnp.arange(kh) - i + (NA_MAX_ROWS - 1)
        bias = rpb[:, row_rel[None, :, None], col_rel[:, None, :]]
        s = jnp.einsum("bjhd,bajchd->bhjac", q_i, k_win).astype(jnp.float32) + bias.astype(jnp.float32)[None]
        p = jax.nn.softmax(s.reshape(bsz, NA_HEADS, GRID_W, kh * NA_COLS), axis=-1)
        p = p.reshape(bsz, NA_HEADS, GRID_W, kh, NA_COLS).astype(v.dtype)
        return jnp.einsum("bhjac,bajchd->bjhd", p, v_win)

    out = lax.map(row_block, jnp.arange(rows))
    return jnp.moveaxis(out, 0, 1).reshape(bsz, t, D_NA)


def hybrid_layer(x, norm_mix_w, w_in, conv_w, conv_b, dt_bias_fwd, dt_bias_bwd, a_log_fwd, a_log_bwd,
                 d_skip, ssm_norm_w, q_norm_w, k_norm_w, rel_pos_bias, w_out, norm_mlp_w, w_mlp_in, w_mlp_out):
    h = rmsnorm(x, norm_mix_w)
    proj = h @ w_in
    offs = np.cumsum([D_SSM, CONV_DIM, 2 * SSM_HEADS, D_NA, D_NA]).tolist()
    z, xbc, dt_raw, q, k, v = jnp.split(proj, offs, axis=-1)
    y_ssm = ssd_mixer(z, xbc, dt_raw, conv_w, conv_b, dt_bias_fwd, dt_bias_bwd,
                      a_log_fwd, a_log_bwd, d_skip, ssm_norm_w)
    y_na = neighbourhood_attention(q, k, v, q_norm_w, k_norm_w, rel_pos_bias)
    x = x + jnp.concatenate([y_ssm, y_na.astype(y_ssm.dtype)], axis=-1) @ w_out
    h = rmsnorm(x, norm_mlp_w)
    return x + jnp.square(jax.nn.relu(h @ w_mlp_in)) @ w_mlp_out


def setup_inputs(seed: int = 0) -> dict:
    key = jax.random.key(seed)
    ks = jax.random.split(key, 20)
    f32 = jnp.float32
    L = DEPTH
    nrm = lambda k, shape, s: jax.random.normal(k, shape, f32) * s
    dt0 = jnp.exp(jax.random.uniform(ks[4], (L, 2, SSM_HEADS), f32, np.log(1e-3), np.log(1e-1)))
    dt_bias = dt0 + jnp.log(-jnp.expm1(-dt0))
    a_log = jnp.log(jax.random.uniform(ks[5], (L, 2, SSM_HEADS), f32, 1.0, 16.0))
    return {
        "x": jax.random.normal(ks[0], (BATCH, SEQ, D_MODEL), f32),
        "norm_mix_w": 1.0 + nrm(ks[1], (L, D_MODEL), 0.02),
        "w_in": nrm(ks[2], (L, D_MODEL, PROJ_DIM), D_MODEL ** -0.5),
        "conv_w": nrm(ks[3], (L, D_CONV, CONV_DIM), D_CONV ** -0.5),
        "conv_b": nrm(ks[6], (L, CONV_DIM), 0.02),
        "dt_bias_fwd": dt_bias[:, 0],
        "dt_bias_bwd": dt_bias[:, 1],
        "a_log_fwd": a_log[:, 0],
        "a_log_bwd": a_log[:, 1],
        "d_skip": 1.0 + nrm(ks[7], (L, SSM_HEADS), 0.02),
        "ssm_norm_w": 1.0 + nrm(ks[8], (L, D_SSM), 0.02),
        "q_norm_w": 1.0 + nrm(ks[9], (L, NA_HEAD_DIM), 0.02),
        "k_norm_w": 1.0 + nrm(ks[10], (L, NA_HEAD_DIM), 0.02),
        "rel_pos_bias": nrm(ks[11], (L, NA_HEADS, 2 * NA_MAX_ROWS - 1, 2 * NA_COLS - 1), 0.1),
        "w_out": nrm(ks[12], (L, D_MIX, D_MODEL), D_MIX ** -0.5),
        "norm_mlp_w": 1.0 + nrm(ks[13], (L, D_MODEL), 0.02),
        "w_mlp_in": nrm(ks[14], (L, D_MODEL, D_FF), D_MODEL ** -0.5),
        "w_mlp_out": nrm(ks[15], (L, D_FF, D_MODEL), D_FF ** -0.5),
    }


def reference(x, norm_mix_w, w_in, conv_w, conv_b, dt_bias_fwd, dt_bias_bwd, a_log_fwd, a_log_bwd,
              d_skip, ssm_norm_w, q_norm_w, k_norm_w, rel_pos_bias, w_out, norm_mlp_w, w_mlp_in, w_mlp_out):
    for layer in range(DEPTH):
        x = hybrid_layer(x, norm_mix_w[layer], w_in[layer], conv_w[layer], conv_b[layer],
                         dt_bias_fwd[layer], dt_bias_bwd[layer], a_log_fwd[layer], a_log_bwd[layer],
                         d_skip[layer], ssm_norm_w[layer], q_norm_w[layer], k_norm_w[layer],
                         rel_pos_bias[layer], w_out[layer], norm_mlp_w[layer],
                         w_mlp_in[layer], w_mlp_out[layer])
    return x
```

```cpp
#include <hip/hip_runtime.h>
#include <cstdio>
#include <cstdint>
namespace pg8 {
#define PG8_LAS __attribute__((address_space(3)))
typedef unsigned short bf16_t;
typedef short bf16x8 __attribute__((ext_vector_type(8)));
typedef float f32x4 __attribute__((ext_vector_type(4)));
typedef unsigned u32x4 __attribute__((ext_vector_type(4)));
constexpr int BM = 256, BK = 64, HALF = 128, HTB = HALF * BK * 2  , STAGE_BYTES = 8 * HTB, NXCD = 8, WGM = 8;

__host__ __device__ __forceinline__ int lds_byte(int r, int c) { const int st = (r >> 4) * 2 + (c >> 5), rr = r & 15, cc = c & 31, ob = rr * 64 + cc * 2; return st * 1024 + (ob ^ (((ob >> 9) & 1) << 5)); }
__host__ __device__ __forceinline__ void stage_rc(int b, int& R, int& C) { const int st = b / 1024, sb = b % 1024, swz = sb ^ (((sb >> 9) & 1) << 5); R = (st >> 1) * 16 + swz / 64; C = (st & 1) * 32 + (swz % 64) / 2; }
__host__ __device__ __forceinline__ int perm32(int rho) { const int n = rho >> 4, i = rho & 15; return 8 * (i >> 2) + 4 * n + (i & 3); }

struct Unit { int pm, pn; };
struct Gemm { const bf16_t* A; const bf16_t* Bt; int M, N, K; };

struct StaticOrder {
    int nM, nN, nwg, G, c;
    __host__ __device__ void init(int M, int N, int G_, int c_) { nM = M / BM; nN = N / BM; nwg = nM * nN; G = G_; c = c_; }
    __host__ __device__ bool next(int i, Unit& u) const {
        const long L = (long)i * G + c; if (L >= nwg) return false;
        int wgid = (int)L; { const int q = nwg / NXCD, r = nwg % NXCD, xcd = wgid % NXCD, off = wgid / NXCD; wgid = (xcd < r ? xcd * (q + 1) : r * (q + 1) + (xcd - r) * q) + off; }
        const int nig = WGM * nN, gid = wgid / nig, fm = gid * WGM, gsz = (nM - fm) < WGM ? (nM - fm) : WGM;
        u.pm = fm + ((wgid % nig) % gsz); u.pn = (wgid % nig) / gsz; return true;
    }
    __device__ __forceinline__ void a_ready(const Unit&) const {}
    __device__ __forceinline__ void done(const Unit&) const {}
};

__device__ __forceinline__ unsigned cvt_pk_bf16(float lo, float hi) { unsigned r; asm volatile("v_cvt_pk_bf16_f32 %0, %1, %2" : "=v"(r) : "v"(lo), "v"(hi)); return r; }
typedef float f32x2 __attribute__((ext_vector_type(2)));
__device__ __forceinline__ f32x2 gelu_pk(f32x2 v) {
    const f32x2 av = __builtin_elementwise_abs(v), d = av * 0.2316418882f + 1.0f;
    f32x2 t; t.x = __builtin_amdgcn_rcpf(d.x); t.y = __builtin_amdgcn_rcpf(d.y);
    f32x2 q = t * 0.5307027145f + (-0.7265760135f); q = q * t + 0.7107068705f; q = q * t + (-0.142248368f); q = q * t + 0.127414796f; q = q * t;
    const f32x2 s = (v * v) * (-0.72134752044f);
    f32x2 e; e.x = __builtin_amdgcn_exp2f(s.x); e.y = __builtin_amdgcn_exp2f(s.y);
    const f32x2 m = v * (q * e), r = v - m;
    f32x2 o; o.x = v.x < 0.f ? m.x : r.x; o.y = v.y < 0.f ? m.y : r.y; return o;
}

template <int ACT  > struct EpiBf16 {
    static constexpr bool PERM = true, AFTER_DRAIN = false; static_assert(ACT == 0 || ACT == 1, "EpiBf16: ACT is 0 (none) or 1 (gelu_pk)");
    bf16_t* O; int ldc; const float* bias; int split_cols; size_t split_stride; float scale0;
    __device__ __forceinline__ void operator()(const f32x4 (&acc)[2][2][4][2], const Unit& u, int wr, int wc, int fr, int fq) const {
        const int row0 = u.pm * BM + wr * 64 + fr; int colt = u.pn * BM; bf16_t* base = O;
        float sc = 1.f; if (split_cols) { const int t = colt / split_cols; base += (size_t)t * split_stride; colt -= t * split_cols; if (t == 0) sc = scale0; }
        const int col0 = colt + wc * 32 + 8 * fq, bcol0 = u.pn * BM + wc * 32 + 8 * fq;
        f32x4 bv[2][2];
#pragma unroll
        for (int bj = 0; bj < 2; ++bj)
#pragma unroll
            for (int n = 0; n < 2; ++n) bv[bj][n] = bias ? *(const f32x4*)(bias + bcol0 + bj * HALF + 4 * n) : (f32x4){0.f, 0.f, 0.f, 0.f};
#pragma unroll
        for (int ai = 0; ai < 2; ++ai)
#pragma unroll
            for (int m = 0; m < 4; ++m) { bf16_t* rowp = base + (size_t)(row0 + ai * HALF + m * 16) * ldc + col0;
#pragma unroll
                for (int bj = 0; bj < 2; ++bj) { f32x4 v0 = acc[ai][bj][m][0] + bv[bj][0], v1 = acc[ai][bj][m][1] + bv[bj][1];
                    if (ACT == 1) { f32x2 a = gelu_pk((f32x2){v0[0], v0[1]}), b = gelu_pk((f32x2){v0[2], v0[3]}), c = gelu_pk((f32x2){v1[0], v1[1]}), d = gelu_pk((f32x2){v1[2], v1[3]});
                        v0 = (f32x4){a.x, a.y, b.x, b.y}; v1 = (f32x4){c.x, c.y, d.x, d.y}; }
                    v0 = v0 * sc; v1 = v1 * sc; u32x4 w; w.x = cvt_pk_bf16(v0[0], v0[1]); w.y = cvt_pk_bf16(v0[2], v0[3]); w.z = cvt_pk_bf16(v1[0], v1[1]); w.w = cvt_pk_bf16(v1[2], v1[3]);
                    *(u32x4*)(rowp + bj * HALF) = w; } }
    }
};
template <class Epi, class Sched, bool ALIGN_EPI = false, bool SP2 = false>
__device__ __forceinline__ void gemm_phase(PG8_LAS unsigned char* lds, const Gemm g, const Sched& S, const Epi& E) {
    const int tid = threadIdx.x, wid = __builtin_amdgcn_readfirstlane(tid >> 6), lane = tid & 63, wr = wid >> 2, wc = wid & 3, fr = lane & 15, fq = lane >> 4;
    const int K = g.K, nt = K / BK;
    unsigned voffA[2], voffB[2];
#pragma unroll
    for (int i = 0; i < 2; ++i) { int R, C; stage_rc(tid * 16 + i * 8192, R, C); const int Rb = Epi::PERM ? ((R & ~31) + perm32(R & 31)) : R;
        voffA[i] = (unsigned)(R * K + C) * 2u; voffB[i] = (unsigned)(Rb * K + C) * 2u; }
    const size_t kstep = (size_t)(BK * 2);
    const size_t hstep = (size_t)HALF * K * 2;
    const size_t tstep = 2 * hstep;
    const unsigned ldsw = (unsigned)wid * 1024u;
    const int aoff = lds_byte(wr * 64 + fr, fq * 8), boff = lds_byte(wc * 32 + fr, fq * 8);
#define PG8_SA(b, h) (((b) * 2 + (h)) * HTB)
#define PG8_SB(b, h) ((4 + (b) * 2 + (h)) * HTB)
#define PG8_STAGE(bufoff, gbase, voff) do { _Pragma("unroll") for (int _i = 0; _i < 2; ++_i) \
        __builtin_amdgcn_global_load_lds((const unsigned*)((const char*)(gbase) + (voff)[_i]), (PG8_LAS unsigned*)(lds + (bufoff) + ldsw + _i * 8192), 16, 0, 0); } while (0)
#define PG8_LDA(dst, b, h) do { _Pragma("unroll") for (int m = 0; m < 4; ++m) _Pragma("unroll") for (int k = 0; k < 2; ++k) dst[m][k] = *(const PG8_LAS bf16x8*)(lds + PG8_SA(b, h) + aoff + m * 2048 + k * 1024); } while (0)
#define PG8_LDB(dst, b, h) do { _Pragma("unroll") for (int n = 0; n < 2; ++n) _Pragma("unroll") for (int k = 0; k < 2; ++k) dst[n][k] = *(const PG8_LAS bf16x8*)(lds + PG8_SB(b, h) + boff + n * 2048 + k * 1024); } while (0)
#define PG8_MMA(ai, bj, At, Bt) do { __builtin_amdgcn_s_setprio(1); _Pragma("unroll") for (int m = 0; m < 4; ++m) _Pragma("unroll") for (int n = 0; n < 2; ++n) _Pragma("unroll") for (int k = 0; k < 2; ++k) \
        acc[ai][bj][m][n] = __builtin_amdgcn_mfma_f32_16x16x32_bf16(Bt[n][k], At[m][k], acc[ai][bj][m][n], 0, 0, 0); __builtin_amdgcn_s_setprio(0); } while (0)
#define PG8_WAIT_V(n) asm volatile("s_waitcnt vmcnt(" #n ")" ::: "memory")
#define PG8_WAIT_L(n) asm volatile("s_waitcnt lgkmcnt(" #n ")" ::: "memory")
#define PG8_BAR __builtin_amdgcn_s_barrier()
#define PG8_SCHED __builtin_amdgcn_sched_barrier(0)
    Unit cur, nxt; int ui = 0;
    if (!S.next(0, cur)) return;
    f32x4 acc[2][2][4][2];
#pragma unroll
    for (int a = 0; a < 2; ++a)
#pragma unroll
        for (int b = 0; b < 2; ++b)
#pragma unroll
            for (int m = 0; m < 4; ++m)
#pragma unroll
                for (int n = 0; n < 2; ++n) acc[a][b][m][n] = (f32x4){0.f, 0.f, 0.f, 0.f};
    bf16x8 At[4][2], B0[2][2], B1[2][2];
    const char* cA = (const char*)g.A + (size_t)cur.pm * tstep; const char* cB = (const char*)g.Bt + (size_t)cur.pn * tstep;
    S.a_ready(cur);
    if constexpr (SP2) {
        PG8_STAGE(PG8_SB(0, 0), cB, voffB); PG8_STAGE(PG8_SB(0, 1), cB + hstep, voffB); PG8_STAGE(PG8_SA(0, 0), cA, voffA); PG8_STAGE(PG8_SA(0, 1), cA + hstep, voffA);
        if (wr == 1) PG8_BAR;
        PG8_WAIT_V(2); PG8_BAR;
        PG8_STAGE(PG8_SB(1, 0), cB + kstep, voffB); PG8_STAGE(PG8_SA(1, 0), cA + kstep, voffA); PG8_STAGE(PG8_SB(1, 1), cB + hstep + kstep, voffB);
        PG8_WAIT_V(6); PG8_BAR;
    } else {
        PG8_STAGE(PG8_SB(0, 0), cB, voffB); PG8_STAGE(PG8_SA(0, 0), cA, voffA); PG8_STAGE(PG8_SB(0, 1), cB + hstep, voffB); PG8_STAGE(PG8_SA(0, 1), cA + hstep, voffA);
        if (wr == 1) PG8_BAR;
        PG8_WAIT_V(4); PG8_BAR;
        PG8_STAGE(PG8_SB(1, 0), cB + kstep, voffB); PG8_STAGE(PG8_SA(1, 0), cA + kstep, voffA); PG8_STAGE(PG8_SB(1, 1), cB + hstep + kstep, voffB);
        PG8_WAIT_V(6); PG8_BAR;
    }
    for (;;) {
        const bool has_next = S.next(ui + 1, nxt);
        const char* nA = has_next ? (const char*)g.A + (size_t)nxt.pm * tstep : cA; const char* nB = has_next ? (const char*)g.Bt + (size_t)nxt.pn * tstep : cB;
        for (int t = 0; t < nt; t += 2) {
            const bool last = (t == nt - 2);
            const char* a1 = cA + (size_t)(t + 1) * kstep;
            const char* a2 = last ? nA : cA + (size_t)(t + 2) * kstep; const char* b2 = last ? nB : cB + (size_t)(t + 2) * kstep;
            const char* a3 = a2 + kstep; const char* b3 = b2 + kstep;
            if (last && has_next) S.a_ready(nxt);
            if constexpr (SP2) {
            PG8_LDB(B0, 0, 0); PG8_LDB(B1, 0, 1); PG8_SCHED; PG8_LDA(At, 0, 0); PG8_STAGE(PG8_SA(1, 1), a1 + hstep, voffA);
            PG8_WAIT_V(8); PG8_WAIT_L(0); PG8_BAR; PG8_MMA(0, 0, At, B0); PG8_MMA(0, 1, At, B1); PG8_BAR; PG8_SCHED;
            PG8_LDA(At, 0, 1); PG8_STAGE(PG8_SB(0, 0), b2, voffB); PG8_STAGE(PG8_SB(0, 1), b2 + hstep, voffB); PG8_STAGE(PG8_SA(0, 0), a2, voffA);
            PG8_WAIT_V(8); PG8_WAIT_L(0); PG8_BAR; PG8_MMA(1, 0, At, B0); PG8_MMA(1, 1, At, B1); PG8_BAR; PG8_SCHED;
            PG8_LDB(B0, 1, 0); PG8_LDB(B1, 1, 1); PG8_SCHED; PG8_LDA(At, 1, 0); PG8_STAGE(PG8_SA(0, 1), a2 + hstep, voffA);
            PG8_WAIT_V(8); PG8_WAIT_L(0); PG8_BAR; PG8_MMA(0, 0, At, B0); PG8_MMA(0, 1, At, B1); PG8_BAR; PG8_SCHED;
            PG8_LDA(At, 1, 1); PG8_STAGE(PG8_SB(1, 0), b3, voffB); PG8_STAGE(PG8_SB(1, 1), b3 + hstep, voffB); PG8_STAGE(PG8_SA(1, 0), a3, voffA);
            PG8_WAIT_V(8); PG8_WAIT_L(0); PG8_BAR; PG8_MMA(1, 0, At, B0); PG8_MMA(1, 1, At, B1); PG8_BAR; PG8_SCHED;
            } else {
            PG8_LDB(B0, 0, 0); PG8_SCHED; PG8_LDA(At, 0, 0); PG8_STAGE(PG8_SA(1, 1), a1 + hstep, voffA);
            PG8_WAIT_L(8); PG8_BAR; PG8_WAIT_L(0); PG8_MMA(0, 0, At, B0); PG8_BAR; PG8_SCHED;
            PG8_LDB(B1, 0, 1); PG8_STAGE(PG8_SB(0, 0), b2, voffB);
            PG8_BAR; PG8_WAIT_L(0); PG8_MMA(0, 1, At, B1); PG8_BAR;
            PG8_LDA(At, 0, 1); PG8_STAGE(PG8_SA(0, 0), a2, voffA);
            PG8_BAR; PG8_WAIT_L(0); PG8_MMA(1, 0, At, B0); PG8_BAR; PG8_SCHED;
            PG8_STAGE(PG8_SB(0, 1), b2 + hstep, voffB);
            PG8_WAIT_V(6); PG8_BAR; PG8_MMA(1, 1, At, B1); PG8_BAR;
            PG8_LDB(B0, 1, 0); PG8_SCHED; PG8_LDA(At, 1, 0); PG8_STAGE(PG8_SA(0, 1), a2 + hstep, voffA);
            PG8_WAIT_L(8); PG8_BAR; PG8_WAIT_L(0); PG8_MMA(0, 0, At, B0); PG8_BAR; PG8_SCHED;
            PG8_LDB(B1, 1, 1); PG8_STAGE(PG8_SB(1, 0), b3, voffB);
            PG8_BAR; PG8_WAIT_L(0); PG8_MMA(0, 1, At, B1); PG8_BAR;
            PG8_LDA(At, 1, 1); PG8_STAGE(PG8_SA(1, 0), a3, voffA);
            PG8_BAR; PG8_WAIT_L(0); PG8_MMA(1, 0, At, B0); PG8_BAR; PG8_SCHED;
            PG8_STAGE(PG8_SB(1, 1), b3 + hstep, voffB);
            PG8_WAIT_V(6); PG8_BAR; PG8_MMA(1, 1, At, B1); PG8_BAR;
            }
        }
        if constexpr (ALIGN_EPI) { if (wr == 0) PG8_BAR; }
        if constexpr (!Epi::AFTER_DRAIN) { E(acc, cur, wr, wc, fr, fq); S.done(cur); }
        if (!has_next) break;
#pragma unroll
        for (int a = 0; a < 2; ++a)
#pragma unroll
            for (int b = 0; b < 2; ++b)
#pragma unroll
                for (int m = 0; m < 4; ++m)
#pragma unroll
                    for (int n = 0; n < 2; ++n) acc[a][b][m][n] = (f32x4){0.f, 0.f, 0.f, 0.f};
        cur = nxt; cA = nA; cB = nB; ++ui;
        if constexpr (ALIGN_EPI) { if (wr == 1) PG8_BAR; }
    }
    PG8_WAIT_V(0);
    if constexpr (!ALIGN_EPI) { if (wr == 0) PG8_BAR; }
    PG8_BAR;
    if constexpr (Epi::AFTER_DRAIN) { E.fused(acc, cur, wr, wc, fr, fq, lds, wid, lane); S.done(cur); }
#undef PG8_SA
#undef PG8_SB
#undef PG8_STAGE
#undef PG8_LDA
#undef PG8_LDB
#undef PG8_MMA
#undef PG8_WAIT_V
#undef PG8_WAIT_L
#undef PG8_BAR
#undef PG8_SCHED
}
}
namespace pg8 {
typedef unsigned u32x2 __attribute__((ext_vector_type(2)));
__device__ __forceinline__ float softplus_f(float x) { return fmaxf(x, 0.f) + log1pf(__expf(-fabsf(x))); }
struct EpiInProj {
    static constexpr bool PERM = true, AFTER_DRAIN = false;
    bf16_t* ZQ; bf16_t* XBC; bf16_t* KB; bf16_t* VB; float* DT; const float* qw; const float* kw; const float* dbf; const float* dbb;
    __device__ __forceinline__ void plain(const f32x4 (&acc)[2][2][4][2], bf16_t* base, int ldc, int row0, int col0) const {
#pragma unroll
        for (int ai = 0; ai < 2; ++ai)
#pragma unroll
            for (int m = 0; m < 4; ++m) { bf16_t* rowp = base + (size_t)(row0 + ai * HALF + m * 16) * ldc + col0;
#pragma unroll
                for (int bj = 0; bj < 2; ++bj) { const f32x4 v0 = acc[ai][bj][m][0], v1 = acc[ai][bj][m][1];
                    u32x4 w; w.x = cvt_pk_bf16(v0[0], v0[1]); w.y = cvt_pk_bf16(v0[2], v0[3]); w.z = cvt_pk_bf16(v1[0], v1[1]); w.w = cvt_pk_bf16(v1[2], v1[3]);
                    *(u32x4*)(rowp + bj * HALF) = w; } }
    }
    __device__ __forceinline__ void headnorm(const f32x4 (&acc)[2][2][4][2], bf16_t* base, int ldc, int row0, int colh, const float* w, float scale, int fq) const {
        f32x4 wv[2][2];
#pragma unroll
        for (int bj = 0; bj < 2; ++bj)
#pragma unroll
            for (int n = 0; n < 2; ++n) wv[bj][n] = *(const f32x4*)(w + 32 * bj + 8 * fq + 4 * n) * scale;
#pragma unroll
        for (int ai = 0; ai < 2; ++ai)
#pragma unroll
            for (int m = 0; m < 4; ++m) {
                float ss = 0.f;
#pragma unroll
                for (int bj = 0; bj < 2; ++bj)
#pragma unroll
                    for (int n = 0; n < 2; ++n) { const f32x4 x = acc[ai][bj][m][n]; ss += (x[0] * x[0] + x[1] * x[1]) + (x[2] * x[2] + x[3] * x[3]); }
                ss += __shfl_xor(ss, 16); ss += __shfl_xor(ss, 32);
                const float rstd = 1.0f / sqrtf(ss * (1.0f / 64.0f) + 1e-5f);
                bf16_t* rowp = base + (size_t)(row0 + ai * HALF + m * 16) * ldc + colh + 8 * fq;
#pragma unroll
                for (int bj = 0; bj < 2; ++bj) { const f32x4 v0 = acc[ai][bj][m][0] * rstd * wv[bj][0], v1 = acc[ai][bj][m][1] * rstd * wv[bj][1];
                    u32x4 o; o.x = cvt_pk_bf16(v0[0], v0[1]); o.y = cvt_pk_bf16(v0[2], v0[3]); o.z = cvt_pk_bf16(v1[0], v1[1]); o.w = cvt_pk_bf16(v1[2], v1[3]);
                    *(u32x4*)(rowp + 32 * bj) = o; } }
    }
    __device__ __forceinline__ void operator()(const f32x4 (&acc)[2][2][4][2], const Unit& u, int wr, int wc, int fr, int fq) const {
        const int row0 = u.pm * BM + wr * 64 + fr, pn = u.pn, colw = wc * 32 + 8 * fq;
        if (pn < 4) plain(acc, ZQ, 2048, row0, pn * 256 + colw);
        else if (pn < 10) plain(acc, XBC, 1536, row0, (pn - 4) * 256 + colw);
        else if (pn < 14) headnorm(acc, ZQ, 2048, row0, 1024 + 64 * (4 * (pn - 10) + wc), qw, 0.125f, fq);
        else if (pn < 18) headnorm(acc, KB, 1024, row0, 64 * (4 * (pn - 14) + wc), kw, 1.0f, fq);
        else if (pn < 22) plain(acc, VB, 1024, row0, (pn - 18) * 256 + colw);
        else if (wc == 0) {
            f32x4 bv[2];
#pragma unroll
            for (int n = 0; n < 2; ++n) { const int c = 8 * fq + 4 * n; bv[n] = (c < 16) ? *(const f32x4*)(dbf + c) : *(const f32x4*)(dbb + c - 16); }
#pragma unroll
            for (int ai = 0; ai < 2; ++ai)
#pragma unroll
                for (int m = 0; m < 4; ++m) { float* rowp = DT + (size_t)(row0 + ai * HALF + m * 16) * 32 + 8 * fq;
#pragma unroll
                    for (int n = 0; n < 2; ++n) { const f32x4 x = acc[ai][0][m][n] + bv[n]; f32x4 o; o[0] = softplus_f(x[0]); o[1] = softplus_f(x[1]); o[2] = softplus_f(x[2]); o[3] = softplus_f(x[3]);
                        *(f32x4*)(rowp + 4 * n) = o; } }
        }
    }
};
struct EpiOutProj {
    static constexpr bool PERM = true, AFTER_DRAIN = false;
    const float* X; float* OUT; bf16_t* XW; const float* wn; float* SS;
    __device__ __forceinline__ void operator()(const f32x4 (&acc)[2][2][4][2], const Unit& u, int wr, int wc, int fr, int fq) const {
        const int row0 = u.pm * BM + wr * 64 + fr, col0 = u.pn * BM + wc * 32 + 8 * fq;
        f32x4 wv[2][2];
#pragma unroll
        for (int bj = 0; bj < 2; ++bj)
#pragma unroll
            for (int n = 0; n < 2; ++n) wv[bj][n] = *(const f32x4*)(wn + col0 + bj * HALF + 4 * n);
#pragma unroll
        for (int ai = 0; ai < 2; ++ai)
#pragma unroll
            for (int m = 0; m < 4; ++m) { const int row = row0 + ai * HALF + m * 16; const size_t off = (size_t)row * 1024 + col0; float ss = 0.f;
#pragma unroll
                for (int bj = 0; bj < 2; ++bj) {
                    const f32x4 a0 = *(const f32x4*)(X + off + bj * HALF), a1 = *(const f32x4*)(X + off + bj * HALF + 4);
                    const f32x4 v0 = acc[ai][bj][m][0] + a0, v1 = acc[ai][bj][m][1] + a1;
                    *(f32x4*)(OUT + off + bj * HALF) = v0; *(f32x4*)(OUT + off + bj * HALF + 4) = v1;
                    ss += (v0[0] * v0[0] + v0[1] * v0[1]) + (v0[2] * v0[2] + v0[3] * v0[3]) + (v1[0] * v1[0] + v1[1] * v1[1]) + (v1[2] * v1[2] + v1[3] * v1[3]);
                    const f32x4 y0 = v0 * wv[bj][0], y1 = v1 * wv[bj][1];
                    u32x4 o; o.x = cvt_pk_bf16(y0[0], y0[1]); o.y = cvt_pk_bf16(y0[2], y0[3]); o.z = cvt_pk_bf16(y1[0], y1[1]); o.w = cvt_pk_bf16(y1[2], y1[3]);
                    *(u32x4*)(XW + off + bj * HALF) = o; }
                ss += __shfl_xor(ss, 16); ss += __shfl_xor(ss, 32);
                if (fq == 0) SS[(size_t)row * 16 + 4 * u.pn + wc] = ss; }
    }
};
struct EpiMlpIn {
    static constexpr bool PERM = true, AFTER_DRAIN = false;
    bf16_t* H; const float* SS;
    __device__ __forceinline__ void operator()(const f32x4 (&acc)[2][2][4][2], const Unit& u, int wr, int wc, int fr, int fq) const {
        const int row0 = u.pm * BM + wr * 64 + fr, col0 = u.pn * BM + wc * 32 + 8 * fq;
#pragma unroll
        for (int ai = 0; ai < 2; ++ai)
#pragma unroll
            for (int m = 0; m < 4; ++m) { const int row = row0 + ai * HALF + m * 16;
                const f32x4 s0 = *(const f32x4*)(SS + (size_t)row * 16), s1 = *(const f32x4*)(SS + (size_t)row * 16 + 4), s2 = *(const f32x4*)(SS + (size_t)row * 16 + 8), s3 = *(const f32x4*)(SS + (size_t)row * 16 + 12);
                const f32x4 st = (s0 + s1) + (s2 + s3); const float rstd = 1.0f / sqrtf(((st[0] + st[1]) + (st[2] + st[3])) * (1.0f / 1024.0f) + 1e-5f);
                bf16_t* rowp = H + (size_t)row * 4096 + col0;
#pragma unroll
                for (int bj = 0; bj < 2; ++bj) { f32x4 v0 = acc[ai][bj][m][0] * rstd, v1 = acc[ai][bj][m][1] * rstd;
#pragma unroll
                    for (int j = 0; j < 4; ++j) { const float a = fmaxf(v0[j], 0.f), b = fmaxf(v1[j], 0.f); v0[j] = a * a; v1[j] = b * b; }
                    u32x4 o; o.x = cvt_pk_bf16(v0[0], v0[1]); o.y = cvt_pk_bf16(v0[2], v0[3]); o.z = cvt_pk_bf16(v1[0], v1[1]); o.w = cvt_pk_bf16(v1[2], v1[3]);
                    *(u32x4*)(rowp + bj * HALF) = o; } }
    }
};
struct EpiMlpOut {
    static constexpr bool PERM = true, AFTER_DRAIN = false;
    float* OUT;
    __device__ __forceinline__ void operator()(const f32x4 (&acc)[2][2][4][2], const Unit& u, int wr, int wc, int fr, int fq) const {
        const int row0 = u.pm * BM + wr * 64 + fr, col0 = u.pn * BM + wc * 32 + 8 * fq;
#pragma unroll
        for (int ai = 0; ai < 2; ++ai)
#pragma unroll
            for (int m = 0; m < 4; ++m) { float* rowp = OUT + (size_t)(row0 + ai * HALF + m * 16) * 1024 + col0;
#pragma unroll
                for (int bj = 0; bj < 2; ++bj) { const f32x4 a0 = *(const f32x4*)(rowp + bj * HALF), a1 = *(const f32x4*)(rowp + bj * HALF + 4);
                    *(f32x4*)(rowp + bj * HALF) = acc[ai][bj][m][0] + a0; *(f32x4*)(rowp + bj * HALF + 4) = acc[ai][bj][m][1] + a1; } }
    }
};
}
#ifndef PG8_SP2
#define PG8_SP2 true
#endif
#ifndef PG8_ALIGN
#define PG8_ALIGN true
#endif
#define GAS __attribute__((address_space(1)))
#define LAS __attribute__((address_space(3)))
typedef unsigned short bf16;
typedef unsigned v4u __attribute__((ext_vector_type(4)));
typedef float f32x4 __attribute__((ext_vector_type(4)));
typedef short bf16x8 __attribute__((ext_vector_type(8)));
typedef GAS unsigned gu32;
typedef GAS unsigned long long gu64;
#define RLX_AGENT __ATOMIC_RELAXED, __HIP_MEMORY_SCOPE_AGENT
#define LDS_WAIT() asm volatile("s_waitcnt lgkmcnt(0)" ::: "memory")
#define VM_WAIT() asm volatile("s_waitcnt vmcnt(0)" ::: "memory")
__device__ __forceinline__ unsigned long long rt() { return __builtin_amdgcn_s_memrealtime(); }
__device__ __forceinline__ unsigned f2bf(float f) { unsigned u = __builtin_bit_cast(unsigned, f); return (u + 0x7fffu + ((u >> 16) & 1u)) >> 16; }
__device__ __forceinline__ unsigned pk2(float lo, float hi) { return f2bf(lo) | (f2bf(hi) << 16); }

#define XB_TMO      128
#define XB_XCNT(j)  (256  + 64 * (j))
#define XB_XSUB(j)  (1280 + 64 * (j))
#define XB_XGEN(j)  (2304 + 64 * (j))
#define XB_TOP      3328
#define XB_TOPGEN   3392
#define XCD_BAR_WORDS 3456
#define XB_SPIN_CAP (1u << 18)

__device__ __forceinline__ unsigned xb_ld(unsigned* p)              { return __hip_atomic_load(p, __ATOMIC_RELAXED, __HIP_MEMORY_SCOPE_AGENT); }
__device__ __forceinline__ unsigned xb_add(unsigned* p, unsigned v) { return __hip_atomic_fetch_add(p, v, __ATOMIC_RELAXED, __HIP_MEMORY_SCOPE_AGENT); }
__device__ __forceinline__ unsigned xb_xcc_id() { return (unsigned)__builtin_amdgcn_s_getreg((3 << 11) | 20) & 0xFu; }
#define XB_SPIN(cond, bar) do { unsigned _sp = 0; while (cond) { __builtin_amdgcn_s_sleep(1); \
    if ((++_sp & 255u) == 0u) { if (xb_ld(&(bar)[XB_TMO])) break; if (_sp > XB_SPIN_CAP) { atomicAdd(&(bar)[XB_TMO], 1u); break; } } } } while (0)

struct XcdBarrier {
    unsigned* bar; unsigned x;
    volatile LAS unsigned* st;
};

__device__ __forceinline__ XcdBarrier xcd_barrier_post(unsigned* bar, volatile LAS unsigned* st) {
    XcdBarrier b; b.bar = bar; b.x = xb_xcc_id(); b.st = st;
    if (threadIdx.x == 0) (void)xb_add(&bar[XB_XCNT(b.x)], 1u);
    return b;
}
__device__ __forceinline__ void xcd_barrier_complete(unsigned* bar, unsigned x, unsigned& nloc, unsigned& nx) {
    const unsigned G = gridDim.x * gridDim.y * gridDim.z;
    unsigned sum, cnt, mine, sp = 0u;
    for (;;) {
        sum = 0u; cnt = 0u; mine = 0u;
#pragma unroll
        for (unsigned j = 0; j < 16; ++j) { const unsigned c = xb_ld(&bar[XB_XCNT(j)]); sum += c; cnt += (c > 0u) ? 1u : 0u; mine = (j == x) ? c : mine; }
        if (sum == G) break;
        __builtin_amdgcn_s_sleep(1);
        if ((++sp & 255u) == 0u) { if (xb_ld(&bar[XB_TMO])) break; if (sp > XB_SPIN_CAP) { atomicAdd(&bar[XB_TMO], 1u); break; } }
    }
    nloc = mine > 0u ? mine : 1u; nx = cnt > 0u ? cnt : 1u;
}

__device__ __forceinline__ void xcd_barrier(const XcdBarrier& b) {
    asm volatile("s_waitcnt vmcnt(0)" ::: "memory");
    __syncthreads();
    if (threadIdx.x == 0) {
        unsigned* bar = b.bar;
        __builtin_amdgcn_s_waitcnt(0);
        unsigned nloc = b.st[0], nx = b.st[1];
        if (nloc == 0u) { xcd_barrier_complete(bar, b.x, nloc, nx); b.st[0] = nloc; b.st[1] = nx; }
        const unsigned old = xb_add(&bar[XB_XSUB(b.x)], 1u);
        const unsigned gen = old / nloc;
        if (old + 1u == (gen + 1u) * nloc) {
            __builtin_amdgcn_fence(__ATOMIC_RELEASE, "agent");
            asm volatile("s_waitcnt vmcnt(0)" ::: "memory");
            const unsigned og = xb_add(&bar[XB_TOP], 1u);
            const unsigned tg = og / nx;
            if (og + 1u == (tg + 1u) * nx) xb_add(&bar[XB_TOPGEN], 1u);
            else XB_SPIN(xb_ld(&bar[XB_TOPGEN]) == tg, bar);
            __builtin_amdgcn_fence(__ATOMIC_ACQUIRE, "agent");
            xb_add(&bar[XB_XGEN(b.x)], 1u);
            asm volatile("s_waitcnt vmcnt(0)" ::: "memory");
        } else {
            XB_SPIN(xb_ld(&bar[XB_XGEN(b.x)]) == gen, bar);
            __builtin_amdgcn_fence(__ATOMIC_ACQUIRE, "agent");
            asm volatile("s_waitcnt vmcnt(0)" ::: "memory");
        }
    }
    __syncthreads();
}

constexpr int NWAVES = 8;
#ifndef MK_N_LAUNCHES
#define MK_N_LAUNCHES 1
#endif
constexpr int PER_PHASE = 8;
constexpr int N_LAUNCHES = MK_N_LAUNCHES;

constexpr int BATCH = 2, T = 8192, D = 1024, M = BATCH * T, FF = 4096;
constexpr int NH = 16, HD = 64, NGRP = 2, HPG = 8, NST = 128, CONVD = 1536, CH = 128, NCH = T / CH;
constexpr int GW = 64, GROWS = T / GW, KH = 8, KW = 16;
constexpr int PROJ = 5664, NPROJ = 5888;
constexpr float EPS = 1e-5f;

constexpr size_t MiB = 1u << 20;
constexpr size_t WS_CTL = 0, CTL_ZERO_BYTES = 1 * MiB;
constexpr size_t WS_WIN = 1 * MiB;
constexpr size_t WS_XN = 13 * MiB;
constexpr size_t WS_SF = 1 * MiB;
constexpr size_t WS_SB = 33 * MiB;
constexpr size_t WS_ZQ = 65 * MiB;
constexpr size_t WS_XBC = 129 * MiB;
constexpr size_t WS_K = 177 * MiB;
constexpr size_t WS_V = 209 * MiB;
constexpr size_t WS_DT = 241 * MiB;
constexpr size_t WS_CB = 243 * MiB;
constexpr size_t WS_DEC = 251 * MiB;
constexpr size_t WS_WOUT = 177 * MiB;
constexpr size_t WS_W1 = 181 * MiB;
constexpr size_t WS_W2 = 189 * MiB;
constexpr size_t WS_XW = 1 * MiB;
constexpr size_t WS_SS = 33 * MiB;
constexpr size_t WS_H = 40 * MiB;
constexpr size_t WS_END = 256 * MiB;
constexpr int CW_TMO = 0, CW_CODE = 1, CW_BAR = 4096;

constexpr int RING_OFF = 0, RING_BYTES = 131072;
constexpr int LDSCTL_OFF = RING_BYTES, MISC_OFF = LDSCTL_OFF + 320;
constexpr int LDS_BYTES = 147456;
static_assert(MISC_OFF + 128 <= LDS_BYTES, "LDS map");

struct Frame {
    LAS unsigned char* lds;
    volatile LAS unsigned* MISC;
    gu32* ctl;
    int tid, lane, wave;
    int vcu, G;
    const float* in[18]; float* out; unsigned char* ws;
};
__device__ __forceinline__ float bf2f(bf16 v) { return __builtin_bit_cast(float, (unsigned)v << 16); }
__device__ __forceinline__ float wave_sum(float v) {
#pragma unroll
    for (int o = 1; o < 64; o <<= 1) v += __shfl_xor(v, o);
    return v;
}
__device__ __forceinline__ float silu_f(float x) { return x / (1.0f + __expf(-x)); }

__device__ __forceinline__ void p0_transpose_item(const float* W, int K, int N, bf16* WT, int kb, int src0, int dst0, LAS float* scr, int lane) {
    const int k0 = 64 * kb;
    if (src0 >= 0) {
#pragma unroll 8
        for (int i = 0; i < 32; ++i) { const int kk = 2 * i + (lane >> 5); scr[kk * 33 + (lane & 31)] = W[(size_t)(k0 + kk) * N + src0 + (lane & 31)]; }
    } else {
#pragma unroll 8
        for (int i = 0; i < 32; ++i) { const int kk = 2 * i + (lane >> 5); scr[kk * 33 + (lane & 31)] = 0.f; }
    }
    LDS_WAIT(); asm volatile("" ::: "memory");
    const int c = lane & 7;
#pragma unroll
    for (int j = 0; j < 4; ++j) { const int n = (lane >> 3) + 8 * j; const LAS float* s = scr + (8 * c) * 33 + n;
        v4u o; o.x = pk2(s[0 * 33], s[1 * 33]); o.y = pk2(s[2 * 33], s[3 * 33]); o.z = pk2(s[4 * 33], s[5 * 33]); o.w = pk2(s[6 * 33], s[7 * 33]);
        *(GAS v4u*)(WT + (size_t)(dst0 + n) * K + k0 + 8 * c) = o; }
    LDS_WAIT(); asm volatile("" ::: "memory");
}
__device__ __forceinline__ int inproj_src(int nb) {
    const int gc = 32 * nb;
    if (gc < 2560) return gc;
    if (gc < 4608) { const int r = gc - 2560, sel = r >> 10, rr = r & 1023, t = rr >> 8, c = rr & 255, bj = c >> 7, wc = (c >> 5) & 3;
        return 2592 + 1024 * sel + 64 * (4 * t + wc) + 32 * bj; }
    if (gc < 5632) return 4640 + (gc - 4608);
    if (gc < 5664) return 2560;
    return -1;
}
__device__ __forceinline__ void rms_row_to_bf16(int lane, const float* xrow, const float* w, bf16* orow) {
    const GAS f32x4* xr = (const GAS f32x4*)xrow + lane; const GAS f32x4* wr = (const GAS f32x4*)w + lane;
    f32x4 v[4]; float s = 0.f;
#pragma unroll
    for (int j = 0; j < 4; ++j) { v[j] = xr[64 * j]; s += (v[j].x * v[j].x + v[j].y * v[j].y) + (v[j].z * v[j].z + v[j].w * v[j].w); }
    const float rstd = 1.f / sqrtf(wave_sum(s) * (1.f / D) + EPS);
    GAS unsigned long long* o8 = (GAS unsigned long long*)orow + lane;
#pragma unroll
    for (int j = 0; j < 4; ++j) { const f32x4 ww = wr[64 * j];
        o8[64 * j] = (unsigned long long)pk2(v[j].x * rstd * ww.x, v[j].y * rstd * ww.y) | ((unsigned long long)pk2(v[j].z * rstd * ww.z, v[j].w * rstd * ww.w) << 32); }
}
__device__ __forceinline__ void p0_prologue(Frame& F) {
    LAS float* scr = (LAS float*)(F.lds + RING_OFF + F.wave * 16384);
    const int gw = F.vcu * NWAVES + F.wave, NGW = F.G * NWAVES;
    bf16* WinT = (bf16*)(F.ws + WS_WIN);
    constexpr int NITEMS = (D / 64) * (NPROJ / 32);
    for (int it = gw; it < NITEMS; it += NGW) { const int kb = it / (NPROJ / 32), nb = it % (NPROJ / 32);
        p0_transpose_item(F.in[2], D, PROJ, WinT, kb, inproj_src(nb), 32 * nb, scr, F.lane); }
    bf16* XN = (bf16*)(F.ws + WS_XN);
    for (int m = gw; m < M; m += NGW) rms_row_to_bf16(F.lane, F.in[0] + (size_t)m * D, F.in[1], XN + (size_t)m * D);
}
__device__ __forceinline__ void p_weights_late(Frame& F) {
    LAS float* scr = (LAS float*)(F.lds + RING_OFF + F.wave * 16384);
    const int gw = F.vcu * NWAVES + F.wave, NGW = F.G * NWAVES;
    constexpr int I_O = (2048 / 64) * (1024 / 32), I_1 = (1024 / 64) * (4096 / 32), I_2 = (4096 / 64) * (1024 / 32);
    for (int it = gw; it < I_O + I_1 + I_2; it += NGW) {
        int r = it;
        if (r < I_O) { p0_transpose_item(F.in[14], 2048, 1024, (bf16*)(F.ws + WS_WOUT), r / 32, 32 * (r % 32), 32 * (r % 32), scr, F.lane); continue; } r -= I_O;
        if (r < I_1) { p0_transpose_item(F.in[16], 1024, 4096, (bf16*)(F.ws + WS_W1), r / 128, 32 * (r % 128), 32 * (r % 128), scr, F.lane); continue; } r -= I_1;
        p0_transpose_item(F.in[17], 4096, 1024, (bf16*)(F.ws + WS_W2), r / 32, 32 * (r % 32), 32 * (r % 32), scr, F.lane);
    }
}

__device__ __forceinline__ float conv_silu_at(const bf16* XBC, const float* cw, const float* cb, int m, int ch) {
    const int t = m & (T - 1); float a = cb[ch];
#pragma unroll
    for (int k = 0; k < 5; ++k) { const int tt = t + k - 2; if (tt >= 0 && tt < T) a += cw[k * CONVD + ch] * bf2f(XBC[(size_t)(m + k - 2) * CONVD + ch]); }
    return silu_f(a);
}

__device__ __forceinline__ void ssd_states_simple(Frame& F) {
    LAS float* Bs = (LAS float*)(F.lds);
    LAS float* Xs = (LAS float*)(F.lds + 65536);
    LAS float* wf = (LAS float*)(F.lds + 98304);
    LAS float* wb = wf + 128; LAS float* acf = wf + 256; LAS float* rcb = wf + 384;
    const bf16* XBC = (const bf16*)(F.ws + WS_XBC); const float* DT = (const float*)(F.ws + WS_DT);
    const float* cw = F.in[3]; const float* cb = F.in[4];
    bf16* SF = (bf16*)(F.ws + WS_SF); bf16* SB = (bf16*)(F.ws + WS_SB); float* DEC = (float*)(F.ws + WS_DEC);
    const int tid = F.tid;
    for (int item = F.vcu; item < BATCH * NCH * NH; item += F.G) {
        const int h = item % NH, bc = item / NH, g = h / HPG, m0 = bc * CH;
        for (int idx = tid; idx < CH * NST; idx += 512) { const int l = idx >> 7, n = idx & 127; Bs[idx] = conv_silu_at(XBC, cw, cb, m0 + l, 1024 + g * NST + n); }
        for (int idx = tid; idx < CH * HD; idx += 512) { const int l = idx >> 6, p = idx & 63; Xs[idx] = conv_silu_at(XBC, cw, cb, m0 + l, h * HD + p); }
        if (tid == 0) { const float A = -__expf(F.in[7][h]); float s = 0.f; for (int l = 0; l < CH; ++l) { s += DT[(size_t)(m0 + l) * 32 + h] * A; acf[l] = s; } }
        if (tid == 64) { const float A = -__expf(F.in[8][h]); float s = 0.f; for (int l = CH - 1; l >= 0; --l) { s += DT[(size_t)(m0 + l) * 32 + 16 + h] * A; rcb[l] = s; } }
        __syncthreads();
        if (tid < CH) { wf[tid] = DT[(size_t)(m0 + tid) * 32 + h] * __expf(acf[CH - 1] - acf[tid]); wb[tid] = DT[(size_t)(m0 + tid) * 32 + 16 + h] * __expf(rcb[0] - rcb[tid]); }
        __syncthreads();
        const int n = tid >> 2, p0 = (tid & 3) * 16;
        float af[16], ab[16];
#pragma unroll
        for (int i = 0; i < 16; ++i) { af[i] = 0.f; ab[i] = 0.f; }
        for (int l = 0; l < CH; ++l) { const float bv = Bs[l * NST + n], bf_ = bv * wf[l], bb_ = bv * wb[l];
#pragma unroll
            for (int i = 0; i < 16; ++i) { const float x = Xs[l * HD + p0 + i]; af[i] += bf_ * x; ab[i] += bb_ * x; } }
        const size_t base = (size_t)item * (HD * NST);
#pragma unroll
        for (int i = 0; i < 16; ++i) { SF[base + (size_t)(p0 + i) * NST + n] = (bf16)f2bf(af[i]); SB[base + (size_t)(p0 + i) * NST + n] = (bf16)f2bf(ab[i]); }
        if (tid == 0) { DEC[item] = __expf(acf[CH - 1]); DEC[BATCH * NCH * NH + item] = __expf(rcb[0]); }
        __syncthreads();
    }
}

__device__ __forceinline__ void na_simple(Frame& F) {
    bf16* ZQ = (bf16*)(F.ws + WS_ZQ); const bf16* KB = (const bf16*)(F.ws + WS_K); const bf16* VB = (const bf16*)(F.ws + WS_V);
    const float* rpb = F.in[13];
    const int gw = F.vcu * NWAVES + F.wave, NGW = F.G * NWAVES;
    for (int w = gw; w < BATCH * GROWS * NH; w += NGW) {
        const int hh = w % NH, bi = w / NH, i = bi % GROWS, b = bi / GROWS, j = F.lane;
        const int mq = b * T + i * GW + j;
        int r0 = i - KH / 2; r0 = r0 < 0 ? 0 : (r0 > GROWS - KH ? GROWS - KH : r0);
        int c0 = j - KW / 2; c0 = c0 < 0 ? 0 : (c0 > GW - KW ? GW - KW : c0);
        float q[64], o[64];
        { const v4u* qp = (const v4u*)(ZQ + (size_t)mq * 2048 + 1024 + hh * 64);
#pragma unroll
          for (int c = 0; c < 8; ++c) { const v4u v = qp[c];
#pragma unroll
              for (int e = 0; e < 4; ++e) { q[8 * c + 2 * e] = __builtin_bit_cast(float, v[e] << 16); q[8 * c + 2 * e + 1] = __builtin_bit_cast(float, v[e] & 0xffff0000u); } } }
#pragma unroll
        for (int d = 0; d < 64; ++d) o[d] = 0.f;
        float mx = -1e30f, lsum = 0.f;
        for (int a = 0; a < KH; ++a) for (int cc = 0; cc < KW; ++cc) {
            const int kr = r0 + a, kc = c0 + cc; const size_t mk = (size_t)(b * T + kr * GW + kc) * 1024 + hh * 64;
            const v4u* kp = (const v4u*)(KB + mk); float s = 0.f;
#pragma unroll
            for (int c = 0; c < 8; ++c) { const v4u v = kp[c];
#pragma unroll
                for (int e = 0; e < 4; ++e) { s += q[8 * c + 2 * e] * __builtin_bit_cast(float, v[e] << 16); s += q[8 * c + 2 * e + 1] * __builtin_bit_cast(float, v[e] & 0xffff0000u); } }
            s += rpb[(hh * 15 + (kr - i + 7)) * 31 + (kc - j + 15)];
            const float mn = fmaxf(mx, s), f = __expf(mx - mn), p = __expf(s - mn);
            lsum = lsum * f + p; mx = mn;
            const v4u* vp = (const v4u*)(VB + mk);
#pragma unroll
            for (int c = 0; c < 8; ++c) { const v4u v = vp[c];
#pragma unroll
                for (int e = 0; e < 4; ++e) { o[8 * c + 2 * e] = o[8 * c + 2 * e] * f + p * __builtin_bit_cast(float, v[e] << 16); o[8 * c + 2 * e + 1] = o[8 * c + 2 * e + 1] * f + p * __builtin_bit_cast(float, v[e] & 0xffff0000u); } }
        }
        const float inv = 1.0f / lsum;
        v4u* op = (v4u*)(ZQ + (size_t)mq * 2048 + 1024 + hh * 64);
#pragma unroll
        for (int c = 0; c < 8; ++c) { v4u v;
#pragma unroll
            for (int e = 0; e < 4; ++e) v[e] = pk2(o[8 * c + 2 * e] * inv, o[8 * c + 2 * e + 1] * inv);
            op[c] = v; }
    }
}

__device__ __forceinline__ void ssd_scan(Frame& F) {
    const float* DEC = (const float*)(F.ws + WS_DEC);
    for (int gid = F.vcu * 512 + F.tid; gid < 2 * BATCH * NH * 2048; gid += F.G * 512) {
        const int dir = gid >> 16, rem = gid & 65535, b = rem >> 15, h = (rem >> 11) & 15, e4 = rem & 2047;
        bf16* S = (bf16*)(F.ws + (dir ? WS_SB : WS_SF));
        const float* dec = DEC + dir * (BATCH * NCH * NH);
        float h0 = 0.f, h1 = 0.f, h2 = 0.f, h3 = 0.f;
        for (int cc = 0; cc < NCH; ++cc) { const int c = dir ? NCH - 1 - cc : cc; const int item = (b * NCH + c) * NH + h;
            unsigned long long* p = (unsigned long long*)(S + (size_t)item * (HD * NST)) + e4;
            const unsigned long long v = *p; const float d = dec[item];
            *p = (unsigned long long)pk2(h0, h1) | ((unsigned long long)pk2(h2, h3) << 32);
            h0 = d * h0 + __builtin_bit_cast(float, (unsigned)(v << 16)); h1 = d * h1 + __builtin_bit_cast(float, (unsigned)v & 0xffff0000u);
            h2 = d * h2 + __builtin_bit_cast(float, (unsigned)(v >> 32) << 16);
            h3 = d * h3 + __builtin_bit_cast(float, (unsigned)(v >> 32) & 0xffff0000u); }
    }
}

__device__ __forceinline__ void ssd_out_simple(Frame& F) {
    LAS bf16* Cc = (LAS bf16*)(F.lds);
    LAS bf16* CBs = (LAS bf16*)(F.lds + 32768);
    LAS bf16* Bc = (LAS bf16*)(F.lds + 65536);
    LAS bf16* Xc = (LAS bf16*)(F.lds + 65536);
    LAS bf16* Hfs = (LAS bf16*)(F.lds + 65536 + 16384);
    LAS bf16* Hbs = (LAS bf16*)(F.lds + 65536 + 32768);
    LAS float* acf = (LAS float*)(F.lds + 114688);
    LAS float* rcb = acf + 128; LAS float* dtf = acf + 256; LAS float* dtb = acf + 384;
    bf16* ZQ = (bf16*)(F.ws + WS_ZQ); const bf16* XBC = (const bf16*)(F.ws + WS_XBC); const float* DT = (const float*)(F.ws + WS_DT);
    const bf16* SF = (const bf16*)(F.ws + WS_SF); const bf16* SB = (const bf16*)(F.ws + WS_SB);
    const float* cw = F.in[3]; const float* cb = F.in[4]; float* Y = F.out;
    const int tid = F.tid;
    for (int item = F.vcu; item < BATCH * NCH * NGRP; item += F.G) {
        const int g = item % NGRP, bc = item / NGRP, m0 = bc * CH;
        for (int idx = tid; idx < CH * NST; idx += 512) { const int l = idx >> 7, n = idx & 127;
            Bc[idx] = (bf16)f2bf(conv_silu_at(XBC, cw, cb, m0 + l, 1024 + g * NST + n)); Cc[idx] = (bf16)f2bf(conv_silu_at(XBC, cw, cb, m0 + l, 1280 + g * NST + n)); }
        __syncthreads();
        for (int idx = tid; idx < CH * CH; idx += 512) { const int l = idx >> 7, s = idx & 127; float a = 0.f;
            for (int n = 0; n < NST; ++n) a += bf2f(Cc[l * NST + n]) * bf2f(Bc[s * NST + n]);
            CBs[idx] = (bf16)f2bf(a); }
        __syncthreads();
        for (int hh = 0; hh < HPG; ++hh) {
            const int h = g * HPG + hh; const size_t sbase = (size_t)(bc * NH + h) * (HD * NST);
            for (int idx = tid; idx < CH * HD; idx += 512) { const int l = idx >> 6, p = idx & 63; Xc[idx] = (bf16)f2bf(conv_silu_at(XBC, cw, cb, m0 + l, h * HD + p)); }
            for (int idx = tid; idx < HD * NST; idx += 512) { Hfs[idx] = SF[sbase + idx]; Hbs[idx] = SB[sbase + idx]; }
            if (tid == 0) { const float A = -__expf(F.in[7][h]); float s = 0.f; for (int l = 0; l < CH; ++l) { s += DT[(size_t)(m0 + l) * 32 + h] * A; acf[l] = s; } }
            if (tid == 64) { const float A = -__expf(F.in[8][h]); float s = 0.f; for (int l = CH - 1; l >= 0; --l) { s += DT[(size_t)(m0 + l) * 32 + 16 + h] * A; rcb[l] = s; } }
            if (tid >= 128 && tid < 256) { const int l = tid - 128; dtf[l] = DT[(size_t)(m0 + l) * 32 + h]; dtb[l] = DT[(size_t)(m0 + l) * 32 + 16 + h]; }
            __syncthreads();
            const int l = tid >> 2, p0 = (tid & 3) * 16; const float Dh = F.in[9][h];
            float y[16];
#pragma unroll
            for (int i = 0; i < 16; ++i) y[i] = 0.f;
            const float al = acf[l], rl = rcb[l];
            for (int s = 0; s < CH; ++s) {
                float mm = 0.f;
                if (l >= s) mm += __expf(al - acf[s]) * dtf[s];
                if (l <= s) mm += __expf(rl - rcb[s]) * dtb[s];
                float gv = bf2f(CBs[l * CH + s]) * mm; if (l == s) gv += Dh;
#pragma unroll
                for (int i = 0; i < 16; ++i) y[i] += gv * bf2f(Xc[s * HD + p0 + i]);
            }
            const float ef = __expf(al), eb = __expf(rl);
            for (int n = 0; n < NST; ++n) { const float cv = bf2f(Cc[l * NST + n]), cf = cv * ef, cbk = cv * eb;
#pragma unroll
                for (int i = 0; i < 16; ++i) y[i] += cf * bf2f(Hfs[(p0 + i) * NST + n]) + cbk * bf2f(Hbs[(p0 + i) * NST + n]); }
#pragma unroll
            for (int i = 0; i < 16; ++i) Y[(size_t)(m0 + l) * 1024 + h * HD + p0 + i] = y[i];
            __syncthreads();
        }
        __threadfence_block(); __syncthreads();
        { const int l = tid >> 2, q4 = tid & 3; const size_t ro = (size_t)(m0 + l);
          const float* yr = Y + ro * 1024 + g * 512 + q4 * 128; bf16* zr = ZQ + ro * 2048 + g * 512 + q4 * 128; const float* nw = F.in[10] + g * 512 + q4 * 128;
          float ss = 0.f;
          for (int i = 0; i < 128; ++i) { const float gt = yr[i] * silu_f(bf2f(zr[i])); ss += gt * gt; }
          ss += __shfl_xor(ss, 1); ss += __shfl_xor(ss, 2);
          const float rstd = 1.0f / sqrtf(ss * (1.0f / 512.0f) + EPS);
          for (int i = 0; i < 128; ++i) { const float gt = yr[i] * silu_f(bf2f(zr[i])); zr[i] = (bf16)f2bf(gt * rstd * nw[i]); } }
        __syncthreads();
    }
}

struct Args { const float* in[18]; float* out; unsigned char* ws; int ph_lo, ph_hi, li, pad; };
__global__ void __launch_bounds__(NWAVES * 64, 2) skel_fwd(Args args) {
    extern __shared__ __attribute__((aligned(16))) unsigned char lds[];
    Frame F;
    F.lds = (LAS unsigned char*)lds;
    F.MISC = (volatile LAS unsigned*)(F.lds + MISC_OFF);
    F.tid = threadIdx.x; F.lane = F.tid & 63; F.wave = __builtin_amdgcn_readfirstlane(F.tid >> 6);
    F.G = gridDim.x; { const int bx = blockIdx.x; F.vcu = (F.G % 8 == 0) ? (bx % 8) * (F.G / 8) + bx / 8 : bx; }
    F.ws = args.ws; F.out = args.out;
#pragma unroll
    for (int i = 0; i < 18; ++i) F.in[i] = args.in[i];
    F.ctl = (gu32*)(F.ws + WS_CTL);
#define GRID_BAR(seam) do { if (N_LAUNCHES == PER_PHASE) { if (F.tid == 0) __hip_atomic_store(F.ctl + CW_TMO, 0xBADBA0u | (unsigned)(seam), RLX_AGENT); } \
    else { xcd_barrier(bar); } } while (0)
    for (int u = F.tid; u < (LDS_BYTES - LDSCTL_OFF) / 4; u += NWAVES * 64) ((LAS unsigned*)(F.lds + LDSCTL_OFF))[u] = 0u;
    __syncthreads();
    XcdBarrier bar; bar.bar = (unsigned*)(F.ctl + CW_BAR); bar.x = 0; bar.st = nullptr;
    if (N_LAUNCHES != PER_PHASE) bar = xcd_barrier_post((unsigned*)(F.ctl + CW_BAR), F.MISC + 8);
    const int lo = args.ph_lo, hi = args.ph_hi;
#define IN(k) (lo <= (k) && (k) < hi)
#define BOTH(k) (IN(k) && IN((k) + 1))
    unsigned char* ws = F.ws;
    if (IN(0)) { p0_prologue(F); if (BOTH(0)) GRID_BAR(0); }
    if (IN(1)) {
        pg8::Gemm g{(const bf16*)(ws + WS_XN), (const bf16*)(ws + WS_WIN), M, NPROJ, D}; pg8::StaticOrder S; S.init(M, NPROJ, F.G, (int)blockIdx.x);
        pg8::EpiInProj E{(bf16*)(ws + WS_ZQ), (bf16*)(ws + WS_XBC), (bf16*)(ws + WS_K), (bf16*)(ws + WS_V), (float*)(ws + WS_DT), F.in[11], F.in[12], F.in[5], F.in[6]};
        pg8::gemm_phase<pg8::EpiInProj, pg8::StaticOrder, PG8_ALIGN, PG8_SP2>(F.lds + RING_OFF, g, S, E);
        if (BOTH(1)) GRID_BAR(1);
    }
    if (IN(2)) { ssd_states_simple(F); __syncthreads(); na_simple(F); if (BOTH(2)) GRID_BAR(2); }
    if (IN(3)) { ssd_scan(F); p_weights_late(F); if (BOTH(3)) GRID_BAR(3); }
    if (IN(4)) { ssd_out_simple(F); if (BOTH(4)) GRID_BAR(4); }
    if (IN(5)) {
        pg8::Gemm g{(const bf16*)(ws + WS_ZQ), (const bf16*)(ws + WS_WOUT), M, D, 2048}; pg8::StaticOrder S; S.init(M, D, F.G, (int)blockIdx.x);
        pg8::EpiOutProj E{F.in[0], F.out, (bf16*)(ws + WS_XW), F.in[15], (float*)(ws + WS_SS)};
        pg8::gemm_phase<pg8::EpiOutProj, pg8::StaticOrder, false, PG8_SP2>(F.lds + RING_OFF, g, S, E);
        if (BOTH(5)) GRID_BAR(5);
    }
    if (IN(6)) {
        pg8::Gemm g{(const bf16*)(ws + WS_XW), (const bf16*)(ws + WS_W1), M, FF, D}; pg8::StaticOrder S; S.init(M, FF, F.G, (int)blockIdx.x);
        pg8::EpiMlpIn E{(bf16*)(ws + WS_H), (const float*)(ws + WS_SS)};
        pg8::gemm_phase<pg8::EpiMlpIn, pg8::StaticOrder, PG8_ALIGN, PG8_SP2>(F.lds + RING_OFF, g, S, E);
        if (BOTH(6)) GRID_BAR(6);
    }
    if (IN(7)) {
        pg8::Gemm g{(const bf16*)(ws + WS_H), (const bf16*)(ws + WS_W2), M, D, FF}; pg8::StaticOrder S; S.init(M, D, F.G, (int)blockIdx.x);
        pg8::EpiMlpOut E{F.out};
        pg8::gemm_phase<pg8::EpiMlpOut, pg8::StaticOrder, false, PG8_SP2>(F.lds + RING_OFF, g, S, E);
    }
#undef IN
#undef BOTH
}

extern "C" void kernel_launch(void* const* d_in, const int* in_sizes, int n_in, void* d_out, int out_size, void* d_ws, size_t ws_size, hipStream_t stream) {
    static int grid = 0;
    if (grid == 0) {
        if (n_in != 18 || in_sizes[0] != M * D || out_size != M * D || ws_size < WS_END) { fprintf(stderr, "kernel_launch: unexpected shapes (n_in %d, in0 %d, out %d, ws %zu); nothing launched\n", n_in, n_in > 0 ? in_sizes[0] : -1, out_size, ws_size); grid = -1; return; }
        int dev = 0, cus = 0, per_cu = 0;
        if (hipGetDevice(&dev) != hipSuccess || hipDeviceGetAttribute(&cus, hipDeviceAttributeMultiprocessorCount, dev) != hipSuccess) { grid = -1; return; }
        if (hipFuncSetAttribute((const void*)skel_fwd, hipFuncAttributeMaxDynamicSharedMemorySize, LDS_BYTES) != hipSuccess) { fprintf(stderr, "kernel_launch: hipFuncSetAttribute failed\n"); grid = -1; return; }
        if (hipOccupancyMaxActiveBlocksPerMultiprocessor(&per_cu, (const void*)skel_fwd, NWAVES * 64, LDS_BYTES) != hipSuccess || per_cu < 1)
            fprintf(stderr, "kernel_launch: note: occupancy query reports %d workgroups per CU\n", per_cu);
        (void)hipGetLastError();
        grid = cus;
    }
    if (grid < 0) return;
    if (hipMemsetAsync((char*)d_ws + WS_CTL, 0, CTL_ZERO_BYTES, stream) != hipSuccess) { fprintf(stderr, "kernel_launch: hipMemsetAsync failed\n"); return; }
    Args a{};
    for (int i = 0; i < 18; ++i) a.in[i] = (const float*)d_in[i];
    a.out = (float*)d_out; a.ws = (unsigned char*)d_ws;
    if (N_LAUNCHES == 1) { a.ph_lo = 0; a.ph_hi = PER_PHASE; a.li = 0; hipLaunchKernelGGL(skel_fwd, dim3(grid), dim3(NWAVES * 64), LDS_BYTES, stream, a); }
    else for (int li = 0; li < PER_PHASE; ++li) { a.ph_lo = li; a.ph_hi = li + 1; a.li = li; hipLaunchKernelGGL(skel_fwd, dim3(grid), dim3(NWAVES * 64), LDS_BYTES, stream, a); }
}
```

```cpp
#include <hip/hip_runtime.h>
#include <cstdio>
#include <cstdint>
namespace pg8 {
#define PG8_LAS __attribute__((address_space(3)))
typedef unsigned short bf16_t;
typedef short bf16x8 __attribute__((ext_vector_type(8)));
typedef float f32x4 __attribute__((ext_vector_type(4)));
typedef unsigned u32x4 __attribute__((ext_vector_type(4)));
constexpr int BM = 256, BK = 64, HALF = 128, HTB = HALF * BK * 2  , STAGE_BYTES = 8 * HTB, NXCD = 8, WGM = 4;

__host__ __device__ __forceinline__ int lds_byte(int r, int c) { const int st = (r >> 4) * 2 + (c >> 5), rr = r & 15, cc = c & 31, ob = rr * 64 + cc * 2; return st * 1024 + (ob ^ (((ob >> 9) & 1) << 5)); }
__host__ __device__ __forceinline__ void stage_rc(int b, int& R, int& C) { const int st = b / 1024, sb = b % 1024, swz = sb ^ (((sb >> 9) & 1) << 5); R = (st >> 1) * 16 + swz / 64; C = (st & 1) * 32 + (swz % 64) / 2; }
__host__ __device__ __forceinline__ int perm32(int rho) { const int n = rho >> 4, i = rho & 15; return 8 * (i >> 2) + 4 * n + (i & 3); }

struct Unit { int pm, pn; };
struct Gemm { const bf16_t* A; const bf16_t* Bt; int M, N, K; };

struct StaticOrder {
    int nM, nN, nwg, G, c;
    __host__ __device__ void init(int M, int N, int G_, int c_) { nM = M / BM; nN = N / BM; nwg = nM * nN; G = G_; c = c_; }
    __host__ __device__ bool next(int i, Unit& u) const {
        const long L = (long)i * G + c; if (L >= nwg) return false;
        int wgid = (int)L; { const int q = nwg / NXCD, r = nwg % NXCD, xcd = wgid % NXCD, off = wgid / NXCD; wgid = (xcd < r ? xcd * (q + 1) : r * (q + 1) + (xcd - r) * q) + off; }
        const int nig = WGM * nN, gid = wgid / nig, fm = gid * WGM, gsz = (nM - fm) < WGM ? (nM - fm) : WGM;
        u.pm = fm + ((wgid % nig) % gsz); u.pn = (wgid % nig) / gsz; return true;
    }
    __device__ __forceinline__ void a_ready(const Unit&) const {}
    __device__ __forceinline__ void done(const Unit&) const {}
};

typedef float f32x2_cv __attribute__((ext_vector_type(2))); typedef __bf16 bf16x2_cv __attribute__((ext_vector_type(2)));
__device__ __forceinline__ unsigned cvt_pk_bf16(float lo, float hi) { const f32x2_cv v = {lo, hi}; const bf16x2_cv b = __builtin_convertvector(v, bf16x2_cv); return __builtin_bit_cast(unsigned, b); }
typedef float f32x2 __attribute__((ext_vector_type(2)));
__device__ __forceinline__ f32x2 gelu_pk(f32x2 v) {
    const f32x2 av = __builtin_elementwise_abs(v), d = av * 0.2316418882f + 1.0f;
    f32x2 t; t.x = __builtin_amdgcn_rcpf(d.x); t.y = __builtin_amdgcn_rcpf(d.y);
    f32x2 q = t * 0.5307027145f + (-0.7265760135f); q = q * t + 0.7107068705f; q = q * t + (-0.142248368f); q = q * t + 0.127414796f; q = q * t;
    const f32x2 s = (v * v) * (-0.72134752044f);
    f32x2 e; e.x = __builtin_amdgcn_exp2f(s.x); e.y = __builtin_amdgcn_exp2f(s.y);
    const f32x2 m = v * (q * e), r = v - m;
    f32x2 o; o.x = v.x < 0.f ? m.x : r.x; o.y = v.y < 0.f ? m.y : r.y; return o;
}

template <int ACT  > struct EpiBf16 {
    static constexpr bool PERM = true, AFTER_DRAIN = false; static_assert(ACT == 0 || ACT == 1, "EpiBf16: ACT is 0 (none) or 1 (gelu_pk)");
    bf16_t* O; int ldc; const float* bias; int split_cols; size_t split_stride; float scale0;
    __device__ __forceinline__ void operator()(const f32x4 (&acc)[2][2][4][2], const Unit& u, int wr, int wc, int fr, int fq) const {
        const int row0 = u.pm * BM + wr * 64 + fr; int colt = u.pn * BM; bf16_t* base = O;
        float sc = 1.f; if (split_cols) { const int t = colt / split_cols; base += (size_t)t * split_stride; colt -= t * split_cols; if (t == 0) sc = scale0; }
        const int col0 = colt + wc * 32 + 8 * fq, bcol0 = u.pn * BM + wc * 32 + 8 * fq;
        f32x4 bv[2][2];
#pragma unroll
        for (int bj = 0; bj < 2; ++bj)
#pragma unroll
            for (int n = 0; n < 2; ++n) bv[bj][n] = bias ? *(const f32x4*)(bias + bcol0 + bj * HALF + 4 * n) : (f32x4){0.f, 0.f, 0.f, 0.f};
#pragma unroll
        for (int ai = 0; ai < 2; ++ai)
#pragma unroll
            for (int m = 0; m < 4; ++m) { bf16_t* rowp = base + (size_t)(row0 + ai * HALF + m * 16) * ldc + col0;
#pragma unroll
                for (int bj = 0; bj < 2; ++bj) { f32x4 v0 = acc[ai][bj][m][0] + bv[bj][0], v1 = acc[ai][bj][m][1] + bv[bj][1];
                    if (ACT == 1) { f32x2 a = gelu_pk((f32x2){v0[0], v0[1]}), b = gelu_pk((f32x2){v0[2], v0[3]}), c = gelu_pk((f32x2){v1[0], v1[1]}), d = gelu_pk((f32x2){v1[2], v1[3]});
                        v0 = (f32x4){a.x, a.y, b.x, b.y}; v1 = (f32x4){c.x, c.y, d.x, d.y}; }
                    v0 = v0 * sc; v1 = v1 * sc; u32x4 w; w.x = cvt_pk_bf16(v0[0], v0[1]); w.y = cvt_pk_bf16(v0[2], v0[3]); w.z = cvt_pk_bf16(v1[0], v1[1]); w.w = cvt_pk_bf16(v1[2], v1[3]);
                    *(u32x4*)(rowp + bj * HALF) = w; } }
    }
};
template <class Epi, class Sched, bool ALIGN_EPI = false, bool SP2 = false>
__device__ __forceinline__ void gemm_phase(PG8_LAS unsigned char* lds, const Gemm g, const Sched& S, const Epi& E) {
    const int tid = threadIdx.x, wid = __builtin_amdgcn_readfirstlane(tid >> 6), lane = tid & 63, wr = wid >> 2, wc = wid & 3, fr = lane & 15, fq = lane >> 4;
    const int K = g.K, nt = K / BK;
    unsigned voffA[2], voffB[2];
#pragma unroll
    for (int i = 0; i < 2; ++i) { int R, C; stage_rc(tid * 16 + i * 8192, R, C); const int Rb = Epi::PERM ? ((R & ~31) + perm32(R & 31)) : R;
        voffA[i] = (unsigned)(R * K + C) * 2u; voffB[i] = (unsigned)(Rb * K + C) * 2u; }
    const size_t kstep = (size_t)(BK * 2);
    const size_t hstep = (size_t)HALF * K * 2;
    const size_t tstep = 2 * hstep;
    const unsigned ldsw = (unsigned)wid * 1024u;
    const int aoff = lds_byte(wr * 64 + fr, fq * 8), boff = lds_byte(wc * 32 + fr, fq * 8);
#define PG8_SA(b, h) (((b) * 2 + (h)) * HTB)
#define PG8_SB(b, h) ((4 + (b) * 2 + (h)) * HTB)
#define PG8_STAGE(bufoff, gbase, voff) do { _Pragma("unroll") for (int _i = 0; _i < 2; ++_i) \
        __builtin_amdgcn_global_load_lds((const unsigned*)((const char*)(gbase) + (voff)[_i]), (PG8_LAS unsigned*)(lds + (bufoff) + ldsw + _i * 8192), 16, 0, 0); } while (0)
#define PG8_LDA(dst, b, h) do { _Pragma("unroll") for (int m = 0; m < 4; ++m) _Pragma("unroll") for (int k = 0; k < 2; ++k) dst[m][k] = *(const PG8_LAS bf16x8*)(lds + PG8_SA(b, h) + aoff + m * 2048 + k * 1024); } while (0)
#define PG8_LDB(dst, b, h) do { _Pragma("unroll") for (int n = 0; n < 2; ++n) _Pragma("unroll") for (int k = 0; k < 2; ++k) dst[n][k] = *(const PG8_LAS bf16x8*)(lds + PG8_SB(b, h) + boff + n * 2048 + k * 1024); } while (0)
#define PG8_MMA(ai, bj, At, Bt) do { __builtin_amdgcn_s_setprio(1); _Pragma("unroll") for (int m = 0; m < 4; ++m) _Pragma("unroll") for (int n = 0; n < 2; ++n) _Pragma("unroll") for (int k = 0; k < 2; ++k) \
        acc[ai][bj][m][n] = __builtin_amdgcn_mfma_f32_16x16x32_bf16(Bt[n][k], At[m][k], acc[ai][bj][m][n], 0, 0, 0); __builtin_amdgcn_s_setprio(0); } while (0)
#define PG8_WAIT_V(n) asm volatile("s_waitcnt vmcnt(" #n ")" ::: "memory")
#define PG8_WAIT_L(n) asm volatile("s_waitcnt lgkmcnt(" #n ")" ::: "memory")
#define PG8_BAR __builtin_amdgcn_s_barrier()
#define PG8_SCHED __builtin_amdgcn_sched_barrier(0)
    Unit cur, nxt; int ui = 0;
    if (!S.next(0, cur)) return;
    f32x4 acc[2][2][4][2];
#pragma unroll
    for (int a = 0; a < 2; ++a)
#pragma unroll
        for (int b = 0; b < 2; ++b)
#pragma unroll
            for (int m = 0; m < 4; ++m)
#pragma unroll
                for (int n = 0; n < 2; ++n) acc[a][b][m][n] = (f32x4){0.f, 0.f, 0.f, 0.f};
    bf16x8 At[4][2], B0[2][2], B1[2][2];
    const char* cA = (const char*)g.A + (size_t)cur.pm * tstep; const char* cB = (const char*)g.Bt + (size_t)cur.pn * tstep;
    S.a_ready(cur);
    if constexpr (SP2) {
        PG8_STAGE(PG8_SB(0, 0), cB, voffB); PG8_STAGE(PG8_SB(0, 1), cB + hstep, voffB); PG8_STAGE(PG8_SA(0, 0), cA, voffA); PG8_STAGE(PG8_SA(0, 1), cA + hstep, voffA);
        if (wr == 1) PG8_BAR;
        PG8_WAIT_V(2); PG8_BAR;
        PG8_STAGE(PG8_SB(1, 0), cB + kstep, voffB); PG8_STAGE(PG8_SA(1, 0), cA + kstep, voffA); PG8_STAGE(PG8_SB(1, 1), cB + hstep + kstep, voffB);
        PG8_WAIT_V(6); PG8_BAR;
    } else {
        PG8_STAGE(PG8_SB(0, 0), cB, voffB); PG8_STAGE(PG8_SA(0, 0), cA, voffA); PG8_STAGE(PG8_SB(0, 1), cB + hstep, voffB); PG8_STAGE(PG8_SA(0, 1), cA + hstep, voffA);
        if (wr == 1) PG8_BAR;
        PG8_WAIT_V(4); PG8_BAR;
        PG8_STAGE(PG8_SB(1, 0), cB + kstep, voffB); PG8_STAGE(PG8_SA(1, 0), cA + kstep, voffA); PG8_STAGE(PG8_SB(1, 1), cB + hstep + kstep, voffB);
        PG8_WAIT_V(6); PG8_BAR;
    }
    for (;;) {
        const bool has_next = S.next(ui + 1, nxt);
        const char* nA = has_next ? (const char*)g.A + (size_t)nxt.pm * tstep : cA; const char* nB = has_next ? (const char*)g.Bt + (size_t)nxt.pn * tstep : cB;
        for (int t = 0; t < nt; t += 2) {
            const bool last = (t == nt - 2);
            const char* a1 = cA + (size_t)(t + 1) * kstep;
            const char* a2 = last ? nA : cA + (size_t)(t + 2) * kstep; const char* b2 = last ? nB : cB + (size_t)(t + 2) * kstep;
            const char* a3 = a2 + kstep; const char* b3 = b2 + kstep;
            if (last && has_next) S.a_ready(nxt);
            if constexpr (SP2) {
            PG8_LDB(B0, 0, 0); PG8_LDB(B1, 0, 1); PG8_SCHED; PG8_LDA(At, 0, 0); PG8_STAGE(PG8_SA(1, 1), a1 + hstep, voffA);
            PG8_WAIT_V(8); PG8_WAIT_L(0); PG8_BAR; PG8_MMA(0, 0, At, B0); PG8_MMA(0, 1, At, B1); PG8_BAR; PG8_SCHED;
            PG8_LDA(At, 0, 1); PG8_STAGE(PG8_SB(0, 0), b2, voffB); PG8_STAGE(PG8_SB(0, 1), b2 + hstep, voffB); PG8_STAGE(PG8_SA(0, 0), a2, voffA);
            PG8_WAIT_V(8); PG8_WAIT_L(0); PG8_BAR; PG8_MMA(1, 0, At, B0); PG8_MMA(1, 1, At, B1); PG8_BAR; PG8_SCHED;
            PG8_LDB(B0, 1, 0); PG8_LDB(B1, 1, 1); PG8_SCHED; PG8_LDA(At, 1, 0); PG8_STAGE(PG8_SA(0, 1), a2 + hstep, voffA);
            PG8_WAIT_V(8); PG8_WAIT_L(0); PG8_BAR; PG8_MMA(0, 0, At, B0); PG8_MMA(0, 1, At, B1); PG8_BAR; PG8_SCHED;
            PG8_LDA(At, 1, 1); PG8_STAGE(PG8_SB(1, 0), b3, voffB); PG8_STAGE(PG8_SB(1, 1), b3 + hstep, voffB); PG8_STAGE(PG8_SA(1, 0), a3, voffA);
            PG8_WAIT_V(8); PG8_WAIT_L(0); PG8_BAR; PG8_MMA(1, 0, At, B0); PG8_MMA(1, 1, At, B1); PG8_BAR; PG8_SCHED;
            } else {
            PG8_LDB(B0, 0, 0); PG8_SCHED; PG8_LDA(At, 0, 0); PG8_STAGE(PG8_SA(1, 1), a1 + hstep, voffA);
            PG8_WAIT_L(8); PG8_BAR; PG8_WAIT_L(0); PG8_MMA(0, 0, At, B0); PG8_BAR; PG8_SCHED;
            PG8_LDB(B1, 0, 1); PG8_STAGE(PG8_SB(0, 0), b2, voffB);
            PG8_BAR; PG8_WAIT_L(0); PG8_MMA(0, 1, At, B1); PG8_BAR;
            PG8_LDA(At, 0, 1); PG8_STAGE(PG8_SA(0, 0), a2, voffA);
            PG8_BAR; PG8_WAIT_L(0); PG8_MMA(1, 0, At, B0); PG8_BAR; PG8_SCHED;
            PG8_STAGE(PG8_SB(0, 1), b2 + hstep, voffB);
            PG8_WAIT_V(6); PG8_BAR; PG8_MMA(1, 1, At, B1); PG8_BAR;
            PG8_LDB(B0, 1, 0); PG8_SCHED; PG8_LDA(At, 1, 0); PG8_STAGE(PG8_SA(0, 1), a2 + hstep, voffA);
            PG8_WAIT_L(8); PG8_BAR; PG8_WAIT_L(0); PG8_MMA(0, 0, At, B0); PG8_BAR; PG8_SCHED;
            PG8_LDB(B1, 1, 1); PG8_STAGE(PG8_SB(1, 0), b3, voffB);
            PG8_BAR; PG8_WAIT_L(0); PG8_MMA(0, 1, At, B1); PG8_BAR;
            PG8_LDA(At, 1, 1); PG8_STAGE(PG8_SA(1, 0), a3, voffA);
            PG8_BAR; PG8_WAIT_L(0); PG8_MMA(1, 0, At, B0); PG8_BAR; PG8_SCHED;
            PG8_STAGE(PG8_SB(1, 1), b3 + hstep, voffB);
            PG8_WAIT_V(6); PG8_BAR; PG8_MMA(1, 1, At, B1); PG8_BAR;
            }
        }
        if constexpr (ALIGN_EPI) { if (wr == 0) PG8_BAR; }
        if constexpr (!Epi::AFTER_DRAIN) { E(acc, cur, wr, wc, fr, fq); S.done(cur); }
        if (!has_next) break;
#pragma unroll
        for (int a = 0; a < 2; ++a)
#pragma unroll
            for (int b = 0; b < 2; ++b)
#pragma unroll
                for (int m = 0; m < 4; ++m)
#pragma unroll
                    for (int n = 0; n < 2; ++n) acc[a][b][m][n] = (f32x4){0.f, 0.f, 0.f, 0.f};
        cur = nxt; cA = nA; cB = nB; ++ui;
        if constexpr (ALIGN_EPI) { if (wr == 1) PG8_BAR; }
    }
    PG8_WAIT_V(0);
    if constexpr (!ALIGN_EPI) { if (wr == 0) PG8_BAR; }
    PG8_BAR;
    if constexpr (Epi::AFTER_DRAIN) { E.fused(acc, cur, wr, wc, fr, fq, lds, wid, lane); S.done(cur); }
#undef PG8_SA
#undef PG8_SB
#undef PG8_STAGE
#undef PG8_LDA
#undef PG8_LDB
#undef PG8_MMA
#undef PG8_WAIT_V
#undef PG8_WAIT_L
#undef PG8_BAR
#undef PG8_SCHED
}
}
namespace pg8 {
struct P1Order {
    StaticOrder main; int G, c;
    __host__ __device__ void init(int M_, int Nmain, int G_, int c_) { main.init(M_, Nmain, G_, c_); G = G_; c = c_; }
    __host__ __device__ bool next(int i, Unit& u) const {
        if (main.next(i, u)) { u.pm += 24; return true; }
        const long L = (long)i * G + c - main.nwg; if (L >= 256) return false;
        u.pm = 19 + (int)(L & 3); u.pn = 24 + (int)(L >> 2); return true;
    }
    __device__ __forceinline__ void a_ready(const Unit&) const {}
    __device__ __forceinline__ void done(const Unit&) const {}
};
typedef unsigned u32x2 __attribute__((ext_vector_type(2)));
__device__ __forceinline__ float softplus_f(float x) { const float e = __expf(-fabsf(x)); return fmaxf(x, 0.f) + (e < 1e-4f ? e * (1.0f - 0.5f * e) : __logf(1.0f + e)); }
struct EpiInProj {
    static constexpr bool PERM = true, AFTER_DRAIN = false;
    bf16_t* ZQ; bf16_t* XBC; bf16_t* KB; bf16_t* VB; float* DT; const float* qw; const float* kw; const float* dbf; const float* dbb;
    __device__ __forceinline__ void plain(const f32x4 (&acc)[2][2][4][2], bf16_t* base, int ldc, int row0, int col0) const {
#pragma unroll
        for (int ai = 0; ai < 2; ++ai)
#pragma unroll
            for (int m = 0; m < 4; ++m) { bf16_t* rowp = base + (size_t)(row0 + ai * HALF + m * 16) * ldc + col0;
#pragma unroll
                for (int bj = 0; bj < 2; ++bj) { const f32x4 v0 = acc[ai][bj][m][0], v1 = acc[ai][bj][m][1];
                    u32x4 w; w.x = cvt_pk_bf16(v0[0], v0[1]); w.y = cvt_pk_bf16(v0[2], v0[3]); w.z = cvt_pk_bf16(v1[0], v1[1]); w.w = cvt_pk_bf16(v1[2], v1[3]);
                    *(u32x4*)(rowp + bj * HALF) = w; } }
    }
    __device__ __forceinline__ void headnorm(const f32x4 (&acc)[2][2][4][2], bf16_t* base, int ldc, int row0, int colh, const float* w, float scale, int fq) const {
        f32x4 wv[2][2];
#pragma unroll
        for (int bj = 0; bj < 2; ++bj)
#pragma unroll
            for (int n = 0; n < 2; ++n) wv[bj][n] = *(const f32x4*)(w + 32 * bj + 8 * fq + 4 * n) * scale;
#pragma unroll
        for (int ai = 0; ai < 2; ++ai)
#pragma unroll
            for (int m = 0; m < 4; ++m) {
                float ss = 0.f;
#pragma unroll
                for (int bj = 0; bj < 2; ++bj)
#pragma unroll
                    for (int n = 0; n < 2; ++n) { const f32x4 x = acc[ai][bj][m][n]; ss += (x[0] * x[0] + x[1] * x[1]) + (x[2] * x[2] + x[3] * x[3]); }
                ss += __shfl_xor(ss, 16); ss += __shfl_xor(ss, 32);
                const float rstd = 1.0f / sqrtf(ss * (1.0f / 64.0f) + 1e-5f);
                bf16_t* rowp = base + (size_t)(row0 + ai * HALF + m * 16) * ldc + colh + 8 * fq;
#pragma unroll
                for (int bj = 0; bj < 2; ++bj) { const f32x4 v0 = acc[ai][bj][m][0] * rstd * wv[bj][0], v1 = acc[ai][bj][m][1] * rstd * wv[bj][1];
                    u32x4 o; o.x = cvt_pk_bf16(v0[0], v0[1]); o.y = cvt_pk_bf16(v0[2], v0[3]); o.z = cvt_pk_bf16(v1[0], v1[1]); o.w = cvt_pk_bf16(v1[2], v1[3]);
                    *(u32x4*)(rowp + 32 * bj) = o; } }
    }
    __device__ __forceinline__ void operator()(const f32x4 (&acc)[2][2][4][2], const Unit& u, int wr, int wc, int fr, int fq) const {
        asm volatile("" : "+v"(fr), "+v"(fq));
        const int colw = wc * 32 + 8 * fq;
        if (u.pn >= 24) { plain(acc, VB, 16384, (u.pm - 19) * BM + wr * 64 + fr, (u.pn - 24) * BM + colw); return; }
        const int row0 = (u.pm - 24) * BM + wr * 64 + fr, pn = u.pn;
        if (pn < 4) plain(acc, ZQ, 2048, row0, pn * 256 + colw);
        else if (pn < 10) plain(acc, XBC, 1536, row0, (pn - 4) * 256 + colw);
        else if (pn < 14) headnorm(acc, ZQ, 2048, row0, 1024 + 64 * (4 * (pn - 10) + wc), qw, 0.125f * 1.4426950408889634f, fq);
        else if (pn < 18) headnorm(acc, KB, 1024, row0, 64 * (4 * (pn - 14) + wc), kw, 1.0f, fq);
        else if (wc == 0) {
            f32x4 bv[2];
#pragma unroll
            for (int n = 0; n < 2; ++n) { const int c = 8 * fq + 4 * n; bv[n] = (c < 16) ? *(const f32x4*)(dbf + c) : *(const f32x4*)(dbb + c - 16); }
#pragma unroll
            for (int ai = 0; ai < 2; ++ai)
#pragma unroll
                for (int m = 0; m < 4; ++m) { float* rowp = DT + (size_t)(row0 + ai * HALF + m * 16) * 32 + 8 * fq;
#pragma unroll
                    for (int n = 0; n < 2; ++n) { const f32x4 x = acc[ai][0][m][n] + bv[n]; f32x4 o; o[0] = softplus_f(x[0]); o[1] = softplus_f(x[1]); o[2] = softplus_f(x[2]); o[3] = softplus_f(x[3]);
                        *(f32x4*)(rowp + 4 * n) = o; } }
        }
    }
};
struct EpiOutProj {
    static constexpr bool PERM = true, AFTER_DRAIN = false;
    const float* X; float* OUT; bf16_t* XW; const float* wn; float* SS;
    __device__ __forceinline__ void operator()(const f32x4 (&acc)[2][2][4][2], const Unit& u, int wr, int wc, int fr, int fq) const {
        const int row0 = u.pm * BM + wr * 64 + fr, col0 = u.pn * BM + wc * 32 + 8 * fq;
        f32x4 wv[2][2];
#pragma unroll
        for (int bj = 0; bj < 2; ++bj)
#pragma unroll
            for (int n = 0; n < 2; ++n) wv[bj][n] = *(const f32x4*)(wn + col0 + bj * HALF + 4 * n);
#pragma unroll
        for (int ai = 0; ai < 2; ++ai) {
            f32x4 xr[4][2][2];
#pragma unroll
            for (int m = 0; m < 4; ++m)
#pragma unroll
                for (int bj = 0; bj < 2; ++bj) { const size_t off = (size_t)(row0 + ai * HALF + m * 16) * 1024 + col0 + bj * HALF;
                    xr[m][bj][0] = *(const f32x4*)(X + off); xr[m][bj][1] = *(const f32x4*)(X + off + 4); }
            asm volatile("" ::: "memory");
#pragma unroll
            for (int m = 0; m < 4; ++m) { const int row = row0 + ai * HALF + m * 16; const size_t off = (size_t)row * 1024 + col0; float ss = 0.f;
#pragma unroll
                for (int bj = 0; bj < 2; ++bj) {
                    const f32x4 v0 = acc[ai][bj][m][0] + xr[m][bj][0], v1 = acc[ai][bj][m][1] + xr[m][bj][1];
                    *(f32x4*)(OUT + off + bj * HALF) = v0; *(f32x4*)(OUT + off + bj * HALF + 4) = v1;
                    ss += (v0[0] * v0[0] + v0[1] * v0[1]) + (v0[2] * v0[2] + v0[3] * v0[3]) + (v1[0] * v1[0] + v1[1] * v1[1]) + (v1[2] * v1[2] + v1[3] * v1[3]);
                    const f32x4 y0 = v0 * wv[bj][0], y1 = v1 * wv[bj][1];
                    u32x4 o; o.x = cvt_pk_bf16(y0[0], y0[1]); o.y = cvt_pk_bf16(y0[2], y0[3]); o.z = cvt_pk_bf16(y1[0], y1[1]); o.w = cvt_pk_bf16(y1[2], y1[3]);
                    *(u32x4*)(XW + off + bj * HALF) = o; }
                ss += __shfl_xor(ss, 16); ss += __shfl_xor(ss, 32);
                if (fq == 0) SS[(size_t)row * 16 + 4 * u.pn + wc] = ss; }
            asm volatile("" ::: "memory");
        }
    }
};
struct EpiMlpIn {
    static constexpr bool PERM = true, AFTER_DRAIN = false;
    bf16_t* H; const float* SS;
    __device__ __forceinline__ void operator()(const f32x4 (&acc)[2][2][4][2], const Unit& u, int wr, int wc, int fr, int fq) const {
        const int row0 = u.pm * BM + wr * 64 + fr, col0 = u.pn * BM + wc * 32 + 8 * fq;
        float rs2[2][4];
#pragma unroll
        for (int ai = 0; ai < 2; ++ai) { f32x4 sp[4][4];
#pragma unroll
            for (int m = 0; m < 4; ++m)
#pragma unroll
                for (int k = 0; k < 4; ++k) sp[m][k] = *(const f32x4*)(SS + (size_t)(row0 + ai * HALF + m * 16) * 16 + 4 * k);
#pragma unroll
            for (int m = 0; m < 4; ++m) { const f32x4 st = (sp[m][0] + sp[m][1]) + (sp[m][2] + sp[m][3]); rs2[ai][m] = __builtin_amdgcn_rcpf(((st[0] + st[1]) + (st[2] + st[3])) * (1.0f / 1024.0f) + 1e-5f); } }
        asm volatile("" ::: "memory");
#pragma unroll
        for (int ai = 0; ai < 2; ++ai)
#pragma unroll
            for (int m = 0; m < 4; ++m) { bf16_t* rowp = H + (size_t)(row0 + ai * HALF + m * 16) * 4096 + col0; const float r2 = rs2[ai][m];
#pragma unroll
                for (int bj = 0; bj < 2; ++bj) { f32x4 v0 = acc[ai][bj][m][0], v1 = acc[ai][bj][m][1];
#pragma unroll
                    for (int j = 0; j < 4; ++j) { const float a = fmaxf(v0[j], 0.f), b = fmaxf(v1[j], 0.f); v0[j] = a * a * r2; v1[j] = b * b * r2; }
                    u32x4 o; o.x = cvt_pk_bf16(v0[0], v0[1]); o.y = cvt_pk_bf16(v0[2], v0[3]); o.z = cvt_pk_bf16(v1[0], v1[1]); o.w = cvt_pk_bf16(v1[2], v1[3]);
                    *(u32x4*)(rowp + bj * HALF) = o; } }
    }
};
struct EpiMlpOut {
    static constexpr bool PERM = true, AFTER_DRAIN = false;
    float* OUT; int dry;
    __device__ __forceinline__ void operator()(const f32x4 (&acc)[2][2][4][2], const Unit& u, int wr, int wc, int fr, int fq) const {
        const int row0 = u.pm * BM + wr * 64 + fr, col0 = u.pn * BM + wc * 32 + 8 * fq;
#pragma unroll
        for (int ai = 0; ai < 2; ++ai) {
            f32x4 xr[4][2][2];
#pragma unroll
            for (int m = 0; m < 4; ++m)
#pragma unroll
                for (int bj = 0; bj < 2; ++bj) { const float* rowp = OUT + (size_t)(row0 + ai * HALF + m * 16) * 1024 + col0 + bj * HALF; xr[m][bj][0] = *(const f32x4*)(rowp); xr[m][bj][1] = *(const f32x4*)(rowp + 4); }
            asm volatile("" ::: "memory");
#pragma unroll
            for (int m = 0; m < 4; ++m)
#pragma unroll
                for (int bj = 0; bj < 2; ++bj) { float* rowp = OUT + (size_t)(row0 + ai * HALF + m * 16) * 1024 + col0 + bj * HALF;
                    if (!dry) { *(f32x4*)(rowp) = acc[ai][bj][m][0] + xr[m][bj][0]; *(f32x4*)(rowp + 4) = acc[ai][bj][m][1] + xr[m][bj][1]; } }
            asm volatile("" ::: "memory");
        }
    }
};
}
#ifndef PG8_SP2
#define PG8_SP2 true
#endif
#ifndef PG8_ALIGN
#define PG8_ALIGN true
#endif
#define GAS __attribute__((address_space(1)))
#define LAS __attribute__((address_space(3)))
typedef unsigned short bf16;
typedef unsigned v4u __attribute__((ext_vector_type(4)));
typedef float f32x4 __attribute__((ext_vector_type(4)));
typedef short bf16x8 __attribute__((ext_vector_type(8)));
typedef GAS unsigned gu32;
typedef GAS unsigned long long gu64;
#define RLX_AGENT __ATOMIC_RELAXED, __HIP_MEMORY_SCOPE_AGENT
#define LDS_WAIT() asm volatile("s_waitcnt lgkmcnt(0)" ::: "memory")
#define VM_WAIT() asm volatile("s_waitcnt vmcnt(0)" ::: "memory")
__device__ __forceinline__ unsigned long long rt() { return __builtin_amdgcn_s_memrealtime(); }
__device__ __forceinline__ unsigned f2bf(float f) { unsigned u = __builtin_bit_cast(unsigned, f); return (u + 0x7fffu + ((u >> 16) & 1u)) >> 16; }
typedef float f32x2_hw __attribute__((ext_vector_type(2))); typedef __bf16 bf16x2_hw __attribute__((ext_vector_type(2)));
__device__ __forceinline__ unsigned pk2(float lo, float hi) { const f32x2_hw v = {lo, hi}; const bf16x2_hw b = __builtin_convertvector(v, bf16x2_hw); return __builtin_bit_cast(unsigned, b); }

#define XB_TMO      128
#define XB_XCNT(j)  (256  + 64 * (j))
#define XB_XSUB(j)  (1280 + 64 * (j))
#define XB_XGEN(j)  (2304 + 64 * (j))
#define XB_TOP      3328
#define XB_TOPGEN   3392
#define XCD_BAR_WORDS 3456
#define XB_SPIN_CAP (1u << 18)

__device__ __forceinline__ unsigned xb_ld(unsigned* p)              { return __hip_atomic_load(p, __ATOMIC_RELAXED, __HIP_MEMORY_SCOPE_AGENT); }
__device__ __forceinline__ unsigned xb_add(unsigned* p, unsigned v) { return __hip_atomic_fetch_add(p, v, __ATOMIC_RELAXED, __HIP_MEMORY_SCOPE_AGENT); }
__device__ __forceinline__ unsigned xb_xcc_id() { return (unsigned)__builtin_amdgcn_s_getreg((3 << 11) | 20) & 0xFu; }
#define XB_SPIN(cond, bar) do { unsigned _sp = 0; while (cond) { __builtin_amdgcn_s_sleep(1); \
    if ((++_sp & 255u) == 0u) { if (xb_ld(&(bar)[XB_TMO])) break; if (_sp > XB_SPIN_CAP) { atomicAdd(&(bar)[XB_TMO], 1u); break; } } } } while (0)

struct XcdBarrier {
    unsigned* bar; unsigned x;
    volatile LAS unsigned* st;
};

__device__ __forceinline__ XcdBarrier xcd_barrier_post(unsigned* bar, volatile LAS unsigned* st) {
    XcdBarrier b; b.bar = bar; b.x = xb_xcc_id(); b.st = st;
    if (threadIdx.x == 0) (void)xb_add(&bar[XB_XCNT(b.x)], 1u);
    return b;
}
__device__ __forceinline__ void xcd_barrier_complete(unsigned* bar, unsigned x, unsigned& nloc, unsigned& nx) {
    const unsigned G = gridDim.x * gridDim.y * gridDim.z;
    unsigned sum, cnt, mine, sp = 0u;
    for (;;) {
        sum = 0u; cnt = 0u; mine = 0u;
#pragma unroll
        for (unsigned j = 0; j < 16; ++j) { const unsigned c = xb_ld(&bar[XB_XCNT(j)]); sum += c; cnt += (c > 0u) ? 1u : 0u; mine = (j == x) ? c : mine; }
        if (sum == G) break;
        __builtin_amdgcn_s_sleep(1);
        if ((++sp & 255u) == 0u) { if (xb_ld(&bar[XB_TMO])) break; if (sp > XB_SPIN_CAP) { atomicAdd(&bar[XB_TMO], 1u); break; } }
    }
    nloc = mine > 0u ? mine : 1u; nx = cnt > 0u ? cnt : 1u;
}

__device__ __forceinline__ void xcd_barrier(const XcdBarrier& b) {
    asm volatile("s_waitcnt vmcnt(0)" ::: "memory");
    __syncthreads();
    if (threadIdx.x == 0) {
        unsigned* bar = b.bar;
        __builtin_amdgcn_s_waitcnt(0);
        unsigned nloc = b.st[0], nx = b.st[1];
        if (nloc == 0u) { xcd_barrier_complete(bar, b.x, nloc, nx); b.st[0] = nloc; b.st[1] = nx; }
        const unsigned old = xb_add(&bar[XB_XSUB(b.x)], 1u);
        const unsigned gen = old / nloc;
        if (old + 1u == (gen + 1u) * nloc) {
            __builtin_amdgcn_fence(__ATOMIC_RELEASE, "agent");
            asm volatile("s_waitcnt vmcnt(0)" ::: "memory");
            const unsigned og = xb_add(&bar[XB_TOP], 1u);
            const unsigned tg = og / nx;
            if (og + 1u == (tg + 1u) * nx) xb_add(&bar[XB_TOPGEN], 1u);
            else XB_SPIN(xb_ld(&bar[XB_TOPGEN]) == tg, bar);
            __builtin_amdgcn_fence(__ATOMIC_ACQUIRE, "agent");
            xb_add(&bar[XB_XGEN(b.x)], 1u);
            asm volatile("s_waitcnt vmcnt(0)" ::: "memory");
        } else {
            XB_SPIN(xb_ld(&bar[XB_XGEN(b.x)]) == gen, bar);
            __builtin_amdgcn_fence(__ATOMIC_ACQUIRE, "agent");
            asm volatile("s_waitcnt vmcnt(0)" ::: "memory");
        }
    }
    __syncthreads();
}

constexpr int NWAVES = 8;
#ifndef MK_N_LAUNCHES
#define MK_N_LAUNCHES 1
#endif
constexpr int PER_PHASE = 8;
constexpr int N_LAUNCHES = MK_N_LAUNCHES;

constexpr int BATCH = 2, T = 8192, D = 1024, M = BATCH * T, FF = 4096;
constexpr int NH = 16, HD = 64, NGRP = 2, HPG = 8, NST = 128, CONVD = 1536, CH = 128, NCH = T / CH;
constexpr int GW = 64, GROWS = T / GW, KH = 8, KW = 16;
constexpr int PROJ = 5664, NPROJ = 5888, NMAIN = 4864;
constexpr float EPS = 1e-5f;

constexpr size_t MiB = 1u << 20;
constexpr size_t WS_CTL = 0, CTL_ZERO_BYTES = 65536;
constexpr size_t WS_WIN = 1 * MiB;
constexpr size_t WS_XN = 13 * MiB;
static_assert(WS_XN - WS_WIN == 24u * 256u * 1024u * 2u, "P1Order: XN must start 24 row panels above the weight copy");
constexpr size_t WS_SF = 1 * MiB;
constexpr size_t WS_SB = 33 * MiB;
constexpr size_t WS_ZQ = 65 * MiB;
constexpr size_t WS_XBC = 129 * MiB;
constexpr size_t WS_K = 177 * MiB;
constexpr size_t WS_V = 209 * MiB;
constexpr size_t WS_DT = 241 * MiB;
constexpr size_t WS_CB = 243 * MiB;
constexpr size_t WS_DEC = 251 * MiB;
constexpr size_t WS_WOUT = 177 * MiB;
constexpr size_t WS_W1 = 181 * MiB;
constexpr size_t WS_W2 = 189 * MiB;
constexpr size_t WS_XW = 1 * MiB;
constexpr size_t WS_SS = 33 * MiB;
constexpr size_t WS_H = 40 * MiB;
constexpr size_t WS_END = 256 * MiB;
constexpr size_t SC_XST = 0, SC_BN = 32 * MiB, SC_CN = 40 * MiB;
constexpr int CW_TMO = 0, CW_CODE = 1, CW_BAR = 4096;

constexpr int RING_OFF = 0, RING_BYTES = 131072;
constexpr int LDS_BYTES = 163840;
constexpr int LDSCTL_OFF = LDS_BYTES - 512, MISC_OFF = LDSCTL_OFF + 320;
static_assert(MISC_OFF + 128 <= LDS_BYTES, "LDS map");

struct Frame {
    LAS unsigned char* lds;
    volatile LAS unsigned* MISC;
    gu32* ctl;
    int tid, lane, wave;
    int vcu, G;
    const float* in[18]; float* out; unsigned char* ws;
};
#define PL_SWAP(W, m) unsigned a_ = __builtin_bit_cast(unsigned, m), b_ = a_; asm volatile("" : "+v"(b_)); const auto r_ = __builtin_amdgcn_permlane##W##_swap(a_, b_, false, false); \
    unsigned r0_ = r_[0], r1_ = r_[1]; asm volatile("" : "+v"(r0_), "+v"(r1_)); const float x0_ = __builtin_bit_cast(float, r0_), x1_ = __builtin_bit_cast(float, r1_)
__device__ __forceinline__ float red16_max(float m) { PL_SWAP(16, m); return fmaxf(x0_, x1_); }
__device__ __forceinline__ float red32_max(float m) { PL_SWAP(32, m); return fmaxf(x0_, x1_); }
__device__ __forceinline__ float red16_add(float m) { PL_SWAP(16, m); return x0_ + x1_; }
__device__ __forceinline__ float red32_add(float m) { PL_SWAP(32, m); return x0_ + x1_; }
__device__ __forceinline__ float bf2f(bf16 v) { return __builtin_bit_cast(float, (unsigned)v << 16); }
__device__ __forceinline__ float wave_sum(float v) {
#pragma unroll
    for (int o = 1; o < 64; o <<= 1) v += __shfl_xor(v, o);
    return v;
}
__device__ __forceinline__ float silu_f(float x) { return x * __builtin_amdgcn_rcpf(1.0f + __expf(-x)); }

__device__ __forceinline__ void p0_transpose_item(const float* W, int K, int N, bf16* WT, int kb, int src0, int dst0, LAS float* scr, int lane) {
    const int k0 = 64 * kb;
    if (src0 >= 0) {
#pragma unroll 8
        for (int i = 0; i < 32; ++i) { const int kk = 2 * i + (lane >> 5); scr[kk * 33 + (lane & 31)] = W[(size_t)(k0 + kk) * N + src0 + (lane & 31)]; }
    } else {
#pragma unroll 8
        for (int i = 0; i < 32; ++i) { const int kk = 2 * i + (lane >> 5); scr[kk * 33 + (lane & 31)] = 0.f; }
    }
    LDS_WAIT(); asm volatile("" ::: "memory");
    const int c = lane & 7;
#pragma unroll
    for (int j = 0; j < 4; ++j) { const int n = (lane >> 3) + 8 * j; const LAS float* s = scr + (8 * c) * 33 + n;
        v4u o; o.x = pk2(s[0 * 33], s[1 * 33]); o.y = pk2(s[2 * 33], s[3 * 33]); o.z = pk2(s[4 * 33], s[5 * 33]); o.w = pk2(s[6 * 33], s[7 * 33]);
        *(GAS v4u*)(WT + (size_t)(dst0 + n) * K + k0 + 8 * c) = o; }
    LDS_WAIT(); asm volatile("" ::: "memory");
}
__device__ __forceinline__ int inproj_src(int nb) {
    const int gc = 32 * nb;
    if (gc < 2560) return gc;
    if (gc < 4608) { const int r = gc - 2560, sel = r >> 10, rr = r & 1023, t = rr >> 8, c = rr & 255, bj = c >> 7, wc = (c >> 5) & 3;
        return 2592 + 1024 * sel + 64 * (4 * t + wc) + 32 * bj; }
    if (gc < 4640) return 2560;
    if (gc < 4864) return -1;
    return 4640 + (gc - 4864);
}
__device__ __forceinline__ void rms_row_to_bf16(int lane, const float* xrow, const float* w, bf16* orow) {
    const GAS f32x4* xr = (const GAS f32x4*)xrow + lane; const GAS f32x4* wr = (const GAS f32x4*)w + lane;
    f32x4 v[4]; float s = 0.f;
#pragma unroll
    for (int j = 0; j < 4; ++j) { v[j] = xr[64 * j]; s += (v[j].x * v[j].x + v[j].y * v[j].y) + (v[j].z * v[j].z + v[j].w * v[j].w); }
    const float rstd = 1.f / sqrtf(wave_sum(s) * (1.f / D) + EPS);
    GAS unsigned long long* o8 = (GAS unsigned long long*)orow + lane;
#pragma unroll
    for (int j = 0; j < 4; ++j) { const f32x4 ww = wr[64 * j];
        o8[64 * j] = (unsigned long long)pk2(v[j].x * rstd * ww.x, v[j].y * rstd * ww.y) | ((unsigned long long)pk2(v[j].z * rstd * ww.z, v[j].w * rstd * ww.w) << 32); }
}
__device__ __forceinline__ void p0_prologue(Frame& F) {
    LAS float* scr = (LAS float*)(F.lds + RING_OFF + F.wave * 16384);
    const int gw = F.vcu * NWAVES + F.wave, NGW = F.G * NWAVES;
    bf16* WinT = (bf16*)(F.ws + WS_WIN);
    constexpr int NITEMS = (D / 64) * (NPROJ / 32);
    for (int it = gw; it < NITEMS; it += NGW) { const int kb = it / (NPROJ / 32), nb = it % (NPROJ / 32);
        p0_transpose_item(F.in[2], D, PROJ, WinT, kb, inproj_src(nb), 32 * nb, scr, F.lane); }
    bf16* XN = (bf16*)(F.ws + WS_XN);
    for (int m = gw; m < M; m += NGW) rms_row_to_bf16(F.lane, F.in[0] + (size_t)m * D, F.in[1], XN + (size_t)m * D);
}
__device__ __forceinline__ void p_weights_late(Frame& F) {
    LAS float* scr = (LAS float*)(F.lds + RING_OFF + F.wave * 16384);
    const int gw = F.vcu * NWAVES + F.wave, NGW = F.G * NWAVES;
    constexpr int I_O = (2048 / 64) * (1024 / 32), I_1 = (1024 / 64) * (4096 / 32), I_2 = (4096 / 64) * (1024 / 32);
    for (int it = gw; it < I_O + I_1 + I_2; it += NGW) {
        int r = it;
        if (r < I_O) { p0_transpose_item(F.in[14], 2048, 1024, (bf16*)(F.ws + WS_WOUT), r / 32, 32 * (r % 32), 32 * (r % 32), scr, F.lane); continue; } r -= I_O;
        if (r < I_1) { p0_transpose_item(F.in[16], 1024, 4096, (bf16*)(F.ws + WS_W1), r / 128, 32 * (r % 128), 32 * (r % 128), scr, F.lane); continue; } r -= I_1;
        p0_transpose_item(F.in[17], 4096, 1024, (bf16*)(F.ws + WS_W2), r / 32, 32 * (r % 32), 32 * (r % 32), scr, F.lane);
    }
}

__device__ __forceinline__ void ssd_scan(Frame& F, const int dry) {
    const float* DEC = (const float*)(F.ws + WS_DEC);
    for (int gid = F.vcu * 512 + F.tid; gid < 2 * BATCH * NH * 2048; gid += F.G * 512) {
        const int dir = gid >> 16, rem = gid & 65535, b = rem >> 15, h = (rem >> 11) & 15, e4 = rem & 2047;
        unsigned long long* S = (unsigned long long*)(F.ws + (dir ? WS_SB : WS_SF)) + e4;
        const float* dec = DEC + dir * (BATCH * NCH * NH);
        float h0 = 0.f, h1 = 0.f, h2 = 0.f, h3 = 0.f;
        unsigned long long va[16], vb[16]; float da[16], db[16];
#define SCAN_ITEM(cc) ((b * NCH + (dir ? NCH - 1 - (cc) : (cc))) * NH + h)
#define SCAN_LOAD(V, Dv, bt) do { _Pragma("unroll") for (int i = 0; i < 16; ++i) { const int it_ = SCAN_ITEM(16 * (bt) + i); V[i] = S[(size_t)it_ * 2048]; Dv[i] = dec[it_]; } } while (0)
#define SCAN_PROC(V, Dv, bt) do { _Pragma("unroll") for (int i = 0; i < 16; ++i) { const int it_ = SCAN_ITEM(16 * (bt) + i); const unsigned long long v = V[i]; const float d = Dv[i]; \
            if (!dry) S[(size_t)it_ * 2048] = (unsigned long long)pk2(h0, h1) | ((unsigned long long)pk2(h2, h3) << 32); \
            h0 = d * h0 + __builtin_bit_cast(float, (unsigned)v << 16); h1 = d * h1 + __builtin_bit_cast(float, (unsigned)v & 0xffff0000u); \
            h2 = d * h2 + __builtin_bit_cast(float, (unsigned)(v >> 32) << 16); h3 = d * h3 + __builtin_bit_cast(float, (unsigned)(v >> 32) & 0xffff0000u); } } while (0)
        SCAN_LOAD(va, da, 0);
        SCAN_LOAD(vb, db, 1); SCAN_PROC(va, da, 0);
        SCAN_LOAD(va, da, 2); SCAN_PROC(vb, db, 1);
        SCAN_LOAD(vb, db, 3); SCAN_PROC(va, da, 2);
        SCAN_PROC(vb, db, 3);
#undef SCAN_ITEM
#undef SCAN_LOAD
#undef SCAN_PROC
    }
}

typedef float f32x16 __attribute__((ext_vector_type(16)));
typedef unsigned u32x2v __attribute__((ext_vector_type(2)));
constexpr int V_ACF = 0, V_RCB = 128, V_DTF = 256, V_DTB = 384, V_CFF = 512, V_CFB = 640, V_EF = 768, V_EB = 896;
__device__ __forceinline__ float bflo(unsigned u) { return __builtin_bit_cast(float, u << 16); }
__device__ __forceinline__ float bfhi(unsigned u) { return __builtin_bit_cast(float, u & 0xffff0000u); }
__device__ __forceinline__ void ssd_out_mfma(Frame& F, const int dry) {
    LAS unsigned char* CBs = F.lds;
    LAS unsigned char* Cs = F.lds + 16384;
    LAS float* vecs = (LAS float*)(F.lds + 32768) + F.wave * 1024;
    LAS float* rowss = (LAS float*)(F.lds + 69632);
    LAS float* rstdv = rowss + 512;
    bf16* ZQ = (bf16*)(F.ws + WS_ZQ); const float* DT = (const float*)(F.ws + WS_DT);
    const bf16* SF = (const bf16*)(F.ws + WS_SF); const bf16* SB = (const bf16*)(F.ws + WS_SB);
    const bf16* XST = (const bf16*)((const unsigned char*)F.out + SC_XST); const bf16* BN = (const bf16*)((const unsigned char*)F.out + SC_BN); const bf16* CN = (const bf16*)((const unsigned char*)F.out + SC_CN);
    const int w = F.wave;
    for (int item = F.vcu; item < BATCH * NCH * NGRP * 2; item += F.G) {
        int lane = F.lane; asm volatile("" : "+v"(lane));
        const int r = lane & 31, hp = lane >> 5;
        const int half = item & 1, g = (item >> 1) & 1, bc = item >> 2, m0 = bc * CH, h = HPG * g + w, L0 = 64 * half;
        const bf16* xst = XST + (size_t)(bc * NH + h) * (HD * CH);
        const size_t sbase = (size_t)(bc * NH + h) * (HD * NST);
        bf16x8 xsf[2][8], bfr[8];
        { const bf16* bn = BN + ((size_t)(bc * NGRP + g) * CH + 32 * (w & 3) + r) * NST + 8 * hp;
#pragma unroll
          for (int ks = 0; ks < 8; ++ks) bfr[ks] = *(const bf16x8*)(bn + 16 * ks);
#pragma unroll
          for (int pt = 0; pt < 2; ++pt)
#pragma unroll
              for (int ks = 0; ks < 8; ++ks) xsf[pt][ks] = *(const bf16x8*)(xst + (size_t)(32 * pt + r) * CH + 16 * ks + 8 * hp); }
        { const int row = F.tid >> 3, ch2 = 2 * (F.tid & 7); const v4u* src = (const v4u*)(CN + ((size_t)(bc * NGRP + g) * CH + L0 + row) * NST + 8 * ch2);
          const v4u a = src[0], b2 = src[1];
          *(LAS v4u*)(Cs + row * 256 + ((ch2 ^ (row & 15)) << 4)) = a; *(LAS v4u*)(Cs + row * 256 + (((ch2 + 1) ^ (row & 15)) << 4)) = b2; }
        {
            const float Af = -__expf(F.in[7][h]), Ab = -__expf(F.in[8][h]);
            const int l0 = 2 * lane;
            const float df0 = DT[(size_t)(m0 + l0) * 32 + h], df1 = DT[(size_t)(m0 + l0 + 1) * 32 + h], db0 = DT[(size_t)(m0 + l0) * 32 + 16 + h], db1 = DT[(size_t)(m0 + l0 + 1) * 32 + 16 + h];
            const float a0 = df0 * Af, a1 = df1 * Af, b0 = db0 * Ab, b1 = db1 * Ab;
            float x = a0 + a1, y = b0 + b1;
#pragma unroll
            for (int off = 1; off < 64; off <<= 1) { const float t = __shfl_up(x, off), u = __shfl_down(y, off); if (lane >= off) x += t; if (lane + off < 64) y += u; }
            const float acf0 = x - a1, acf1 = x, rcb0 = y, rcb1 = y - b0;
            vecs[V_ACF + l0] = acf0; vecs[V_ACF + l0 + 1] = acf1; vecs[V_RCB + l0] = rcb0; vecs[V_RCB + l0 + 1] = rcb1;
            vecs[V_DTF + l0] = df0; vecs[V_DTF + l0 + 1] = df1; vecs[V_DTB + l0] = db0; vecs[V_DTB + l0 + 1] = db1;
            vecs[V_EF + l0] = __expf(acf0); vecs[V_EF + l0 + 1] = __expf(acf1); vecs[V_EB + l0] = __expf(rcb0); vecs[V_EB + l0 + 1] = __expf(rcb1);
            LDS_WAIT(); asm volatile("" ::: "memory");
            const int kb = l0 >> 4; const float Rf = vecs[V_ACF + 16 * kb + 15], Rb = vecs[V_RCB + 16 * kb];
            vecs[V_CFF + l0] = __expf(Rf - acf0) * df0; vecs[V_CFF + l0 + 1] = __expf(Rf - acf1) * df1;
            vecs[V_CFB + l0] = __expf(Rb - rcb0) * db0; vecs[V_CFB + l0 + 1] = __expf(Rb - rcb1) * db1;
        }
        {
            const int lt = w >> 2, st = w & 3, crow = 32 * lt + r;
            __syncthreads();
            f32x16 c = {};
#pragma unroll
            for (int ks = 0; ks < 8; ++ks) { const bf16x8 a = *(const LAS bf16x8*)(Cs + crow * 256 + (((2 * ks + hp) ^ (crow & 15)) << 4)); c = __builtin_amdgcn_mfma_f32_32x32x16_bf16(a, bfr[ks], c, 0, 0, 0); }
            const int s = 32 * st + r;
#pragma unroll
            for (int reg = 0; reg < 16; ++reg) { const int l = 32 * lt + (reg & 3) + 8 * (reg >> 2) + 4 * hp;
                *(LAS bf16*)(CBs + l * 256 + ((((s >> 3) ^ (l & 15))) << 4) + (s & 7) * 2) = (bf16)pk2(c[reg], 0.f); }
        }
        __syncthreads();
        f32x16 acc[2][2];
#pragma unroll
        for (int a = 0; a < 2; ++a)
#pragma unroll
            for (int b = 0; b < 2; ++b) acc[a][b] = (f32x16){};
        bf16x8 hbA[8], hbB[8];
#define SSD_HLOAD(HB, dir, pt) do { const bf16* hrow_ = ((dir) ? SB : SF) + sbase + (size_t)(32 * (pt) + r) * NST + 8 * hp; \
            _Pragma("unroll") for (int ks = 0; ks < 8; ++ks) HB[ks] = *(const bf16x8*)(hrow_ + 16 * ks); } while (0)
        SSD_HLOAD(hbA, 0, 0);
        __builtin_amdgcn_sched_barrier(0);
        {
            float acl[2], rcl[2];
#pragma unroll
            for (int lt = 0; lt < 2; ++lt) { acl[lt] = vecs[V_ACF + L0 + 32 * lt + r]; rcl[lt] = vecs[V_RCB + L0 + 32 * lt + r]; }
#pragma unroll
            for (int ks = 0; ks < 8; ++ks) {
                const int s0 = 16 * ks + 8 * hp;
#pragma unroll
                for (int lt = 0; lt < 2; ++lt) {
                    const int lrow = 32 * lt + r, l = L0 + lrow, kd = 4 * half + 2 * lt;
                    const v4u cbv = *(const LAS v4u*)(CBs + lrow * 256 + (((2 * ks + hp) ^ (lrow & 15)) << 4));
                    float gv[8];
#pragma unroll
                    for (int e = 0; e < 4; ++e) { gv[2 * e] = bflo(cbv[e]); gv[2 * e + 1] = bfhi(cbv[e]); }
                    if (ks < kd) {
                        const float rf = __expf(acl[lt] - vecs[V_ACF + 16 * ks + 15]);
                        const f32x4 c0 = *(const LAS f32x4*)(vecs + V_CFF + s0), c1 = *(const LAS f32x4*)(vecs + V_CFF + s0 + 4);
#pragma unroll
                        for (int j = 0; j < 4; ++j) { gv[j] *= c0[j] * rf; gv[4 + j] *= c1[j] * rf; }
                    } else if (ks > kd + 1) {
                        const float rb = __expf(rcl[lt] - vecs[V_RCB + 16 * ks]);
                        const f32x4 c0 = *(const LAS f32x4*)(vecs + V_CFB + s0), c1 = *(const LAS f32x4*)(vecs + V_CFB + s0 + 4);
#pragma unroll
                        for (int j = 0; j < 4; ++j) { gv[j] *= c0[j] * rb; gv[4 + j] *= c1[j] * rb; }
                    } else {
#pragma unroll
                        for (int q = 0; q < 2; ++q) {
                            const f32x4 af = *(const LAS f32x4*)(vecs + V_ACF + s0 + 4 * q), rb = *(const LAS f32x4*)(vecs + V_RCB + s0 + 4 * q);
                            const f32x4 df = *(const LAS f32x4*)(vecs + V_DTF + s0 + 4 * q), db = *(const LAS f32x4*)(vecs + V_DTB + s0 + 4 * q);
#pragma unroll
                            for (int j = 0; j < 4; ++j) { const int s = s0 + 4 * q + j;
                                const float tf = __expf(fminf(acl[lt] - af[j], 0.f)) * df[j], tb = __expf(fminf(rcl[lt] - rb[j], 0.f)) * db[j];
                                const float mm = (l >= s ? tf : 0.f) + (l <= s ? tb : 0.f);
                                gv[4 * q + j] *= mm; }
                        }
                    }
                    v4u gp; gp.x = pk2(gv[0], gv[1]); gp.y = pk2(gv[2], gv[3]); gp.z = pk2(gv[4], gv[5]); gp.w = pk2(gv[6], gv[7]);
                    const bf16x8 ga = __builtin_bit_cast(bf16x8, gp);
#pragma unroll
                    for (int pt = 0; pt < 2; ++pt) acc[lt][pt] = __builtin_amdgcn_mfma_f32_32x32x16_bf16(ga, xsf[pt][ks], acc[lt][pt], 0, 0, 0);
                }
            }
        }
        __builtin_amdgcn_sched_barrier(0);
        SSD_HLOAD(hbB, 0, 1);
        __builtin_amdgcn_sched_barrier(0);
        {
#define SSD_YOFF(HB, dir, pt) do { f32x16 t0 = {}, t1 = {}; \
            _Pragma("unroll") for (int ks = 0; ks < 8; ++ks) { \
                const bf16x8 c0 = *(const LAS bf16x8*)(Cs + r * 256 + (((2 * ks + hp) ^ (r & 15)) << 4)), c1 = *(const LAS bf16x8*)(Cs + (32 + r) * 256 + (((2 * ks + hp) ^ (r & 15)) << 4)); \
                t0 = __builtin_amdgcn_mfma_f32_32x32x16_bf16(c0, HB[ks], t0, 0, 0, 0); t1 = __builtin_amdgcn_mfma_f32_32x32x16_bf16(c1, HB[ks], t1, 0, 0, 0); } \
            _Pragma("unroll") for (int q = 0; q < 4; ++q) { \
                const f32x4 e0 = *(const LAS f32x4*)(vecs + ((dir) ? V_EB : V_EF) + L0 + 8 * q + 4 * hp), e1 = *(const LAS f32x4*)(vecs + ((dir) ? V_EB : V_EF) + L0 + 32 + 8 * q + 4 * hp); \
                _Pragma("unroll") for (int i = 0; i < 4; ++i) { acc[0][pt][4 * q + i] += e0[i] * t0[4 * q + i]; acc[1][pt][4 * q + i] += e1[i] * t1[4 * q + i]; } } \
            asm volatile("" : "+v"(acc[0][pt]), "+v"(acc[1][pt])); __builtin_amdgcn_sched_barrier(0); } while (0)
            SSD_YOFF(hbA, 0, 0); SSD_HLOAD(hbA, 1, 0); __builtin_amdgcn_sched_barrier(0);
            SSD_YOFF(hbB, 0, 1); SSD_HLOAD(hbB, 1, 1); __builtin_amdgcn_sched_barrier(0);
            SSD_YOFF(hbA, 1, 0);
            SSD_YOFF(hbB, 1, 1);
#undef SSD_YOFF
#undef SSD_HLOAD
            const float Dh = F.in[9][h];
#pragma unroll
            for (int lt = 0; lt < 2; ++lt)
#pragma unroll
                for (int pt = 0; pt < 2; ++pt)
#pragma unroll
                    for (int q = 0; q < 4; ++q) { const u32x2v xv = *(const u32x2v*)(xst + (size_t)(32 * pt + r) * CH + L0 + 32 * lt + 8 * q + 4 * hp);
                        acc[lt][pt][4 * q] += Dh * bflo(xv.x); acc[lt][pt][4 * q + 1] += Dh * bfhi(xv.x); acc[lt][pt][4 * q + 2] += Dh * bflo(xv.y); acc[lt][pt][4 * q + 3] += Dh * bfhi(xv.y); }
        }
        {
            __syncthreads();
            LAS float* stg = (LAS float*)(F.lds) + w * (32 * 68);
            const int row = lane >> 1, pc = (lane & 1) * 32;
            float gt[2][32];
#pragma unroll
            for (int lt = 0; lt < 2; ++lt) {
#pragma unroll
                for (int reg = 0; reg < 16; ++reg) { const int rr = (reg & 3) + 8 * (reg >> 2) + 4 * hp; stg[rr * 68 + r] = acc[lt][0][reg]; stg[rr * 68 + 32 + r] = acc[lt][1][reg]; }
                LDS_WAIT(); asm volatile("" ::: "memory");
                const bf16* zr = ZQ + (size_t)(m0 + L0 + 32 * lt + row) * 2048 + h * HD + pc;
                float ss = 0.f;
#pragma unroll
                for (int c = 0; c < 4; ++c) { const v4u zv = *(const v4u*)(zr + 8 * c); const f32x4 y0 = *(const LAS f32x4*)(stg + row * 68 + pc + 8 * c), y1 = *(const LAS f32x4*)(stg + row * 68 + pc + 8 * c + 4);
#pragma unroll
                    for (int e = 0; e < 4; ++e) { const float ya = e < 2 ? y0[2 * e] : y1[2 * e - 4], yb = e < 2 ? y0[2 * e + 1] : y1[2 * e - 3];
                        const float ga = ya * silu_f(bflo(zv[e])), gb = yb * silu_f(bfhi(zv[e])); gt[lt][8 * c + 2 * e] = ga; gt[lt][8 * c + 2 * e + 1] = gb; ss += ga * ga + gb * gb; } }
                ss += __shfl_xor(ss, 1);
                if ((lane & 1) == 0) rowss[(32 * lt + row) * 8 + w] = ss;
                LDS_WAIT(); asm volatile("" ::: "memory");
            }
            __syncthreads();
            if (F.tid < 64) { const f32x4 a = *(const LAS f32x4*)(rowss + F.tid * 8), b = *(const LAS f32x4*)(rowss + F.tid * 8 + 4);
                rstdv[F.tid] = 1.0f / sqrtf(((a[0] + a[1]) + (a[2] + a[3]) + (b[0] + b[1]) + (b[2] + b[3])) * (1.0f / 512.0f) + EPS); }
            __syncthreads();
            const float* nwp = F.in[10] + h * HD + pc;
#pragma unroll
            for (int lt = 0; lt < 2; ++lt) { const float rs = rstdv[32 * lt + row]; bf16* zo = ZQ + (size_t)(m0 + L0 + 32 * lt + row) * 2048 + h * HD + pc;
#pragma unroll
                for (int c = 0; c < 4; ++c) { const f32x4 w0 = *(const f32x4*)(nwp + 8 * c), w1 = *(const f32x4*)(nwp + 8 * c + 4); v4u o;
                    o.x = pk2(gt[lt][8 * c] * rs * w0[0], gt[lt][8 * c + 1] * rs * w0[1]); o.y = pk2(gt[lt][8 * c + 2] * rs * w0[2], gt[lt][8 * c + 3] * rs * w0[3]);
                    o.z = pk2(gt[lt][8 * c + 4] * rs * w1[0], gt[lt][8 * c + 5] * rs * w1[1]); o.w = pk2(gt[lt][8 * c + 6] * rs * w1[2], gt[lt][8 * c + 7] * rs * w1[3]);
                    if (!dry) *(v4u*)(zo + 8 * c) = o; } }
        }
        __syncthreads();
    }
}


__device__ __forceinline__ void ssd_states_mfma(Frame& F) {
    LAS unsigned char* BT = F.lds;
    LAS unsigned char* XT = F.lds + 32768;
    LAS float* wv = (LAS float*)(F.lds + 98304) + F.wave * 128;
    const bf16* XBC = (const bf16*)(F.ws + WS_XBC); const float* DT = (const float*)(F.ws + WS_DT);
    const float* cw = F.in[3]; const float* cbias = F.in[4];
    bf16* XST = (bf16*)((unsigned char*)F.out + SC_XST); bf16* BN = (bf16*)((unsigned char*)F.out + SC_BN); bf16* CN = (bf16*)((unsigned char*)F.out + SC_CN);
    float* DEC = (float*)(F.ws + WS_DEC);
    const int w = F.wave;
    for (int item = F.vcu; item < BATCH * NCH * NGRP * 2; item += F.G) {
        const int quad = item & 1, g = (item >> 1) & 1, bc = item >> 2, m0 = bc * CH, tbase = m0 & (T - 1);
        __syncthreads();
        int lane = F.lane; asm volatile("" : "+v"(lane));
        const int r = lane & 31, hp = lane >> 5, hq = w >> 1, dir = w & 1, h = HPG * g + 4 * quad + hq;
        const float Adec = -__expf((dir ? F.in[8] : F.in[7])[h]);
        const float d0 = DT[(size_t)(m0 + 2 * lane) * 32 + 16 * dir + h], d1 = DT[(size_t)(m0 + 2 * lane + 1) * 32 + 16 * dir + h];
        {
            int tid = F.tid; asm volatile("" : "+v"(tid));
            const int rb = tid & 7, cgi = tid >> 3;
            const int kind = cgi < 16 ? 0 : (cgi < 48 ? 1 : 2);
            const int ch0 = kind == 0 ? 1024 + NST * g + 8 * cgi : (kind == 1 ? HD * (HPG * g + 4 * quad) + 8 * (cgi - 16) : 1280 + NST * g + 8 * (cgi - 48));
            if (kind != 2 || quad == 0) {
                v4u in[20];
#pragma unroll
                for (int i = 0; i < 20; ++i) { const int t = tbase + 16 * rb - 2 + i; v4u z = {0u, 0u, 0u, 0u};
                    in[i] = (t >= 0 && t < T) ? *(const v4u*)(XBC + (size_t)(m0 + 16 * rb - 2 + i) * CONVD + ch0) : z; }
                f32x4 wk[5][2], bb[2];
#pragma unroll
                for (int k = 0; k < 5; ++k) { wk[k][0] = *(const f32x4*)(cw + k * CONVD + ch0); wk[k][1] = *(const f32x4*)(cw + k * CONVD + ch0 + 4); }
                bb[0] = *(const f32x4*)(cbias + ch0); bb[1] = *(const f32x4*)(cbias + ch0 + 4);
#pragma unroll
                for (int hf = 0; hf < 2; ++hf) {
                    const int lr0 = 16 * rb + 8 * hf;
                    unsigned tp[8][4];
                    f32x4 prev[2];
#pragma unroll
                    for (int o = 0; o < 8; ++o) {
                        f32x4 y0 = bb[0], y1 = bb[1];
#pragma unroll
                        for (int k = 0; k < 5; ++k) { const v4u xv = in[8 * hf + o + k];
                            const f32x4 x0 = {bflo(xv.x), bfhi(xv.x), bflo(xv.y), bfhi(xv.y)}, x1 = {bflo(xv.z), bfhi(xv.z), bflo(xv.w), bfhi(xv.w)};
                            y0 += wk[k][0] * x0; y1 += wk[k][1] * x1; }
#pragma unroll
                        for (int e = 0; e < 4; ++e) { y0[e] = silu_f(y0[e]); y1[e] = silu_f(y1[e]); }
                        if (kind != 1 && quad == 0) {
                            v4u o4; o4.x = pk2(y0[0], y0[1]); o4.y = pk2(y0[2], y0[3]); o4.z = pk2(y1[0], y1[1]); o4.w = pk2(y1[2], y1[3]);
                            bf16* dst = (kind == 0 ? BN : CN) + ((size_t)(bc * NGRP + g) * CH + lr0 + o) * NST + 8 * (kind == 0 ? cgi : cgi - 48);
                            *(v4u*)dst = o4; }
                        if (o & 1) {
#pragma unroll
                            for (int e = 0; e < 4; ++e) { tp[e][o >> 1] = pk2(prev[0][e], y0[e]); tp[4 + e][o >> 1] = pk2(prev[1][e], y1[e]); }
                        } else { prev[0] = y0; prev[1] = y1; }
                    }
                    const int chunk = 2 * rb + hf;
                    if (kind == 0) {
#pragma unroll
                        for (int c = 0; c < 8; ++c) { const int n = 8 * cgi + c; v4u v = {tp[c][0], tp[c][1], tp[c][2], tp[c][3]}; *(LAS v4u*)(BT + n * 256 + ((chunk ^ (n & 15)) << 4)) = v; }
                    } else if (kind == 1) {
#pragma unroll
                        for (int c = 0; c < 8; ++c) { const int pp = 8 * (cgi - 16) + c; v4u v = {tp[c][0], tp[c][1], tp[c][2], tp[c][3]}; *(LAS v4u*)(XT + pp * 256 + ((chunk ^ (pp & 15)) << 4)) = v;
                            *(v4u*)(XST + ((size_t)(bc * NH + HPG * g + 4 * quad) * HD + pp) * CH + lr0) = v; }
                    }
                }
            }
        }
        float total;
        {
            const int l0 = 2 * lane; const float a0 = d0 * Adec, a1 = d1 * Adec;
            float x = a0 + a1, y = x;
#pragma unroll
            for (int off = 1; off < 64; off <<= 1) { const float t = __shfl_up(x, off), u = __shfl_down(y, off); if (lane >= off) x += t; if (lane + off < 64) y += u; }
            total = __shfl(x, 63);
            const float e0 = dir ? y : x - a1, e1 = dir ? y - a0 : x;
            wv[l0] = d0 * __expf(total - e0); wv[l0 + 1] = d1 * __expf(total - e1);
        }
        __syncthreads();
        f32x16 acc[4][2];
#pragma unroll
        for (int a = 0; a < 4; ++a)
#pragma unroll
            for (int b = 0; b < 2; ++b) acc[a][b] = (f32x16){};
#pragma unroll 2
        for (int ks = 0; ks < 8; ++ks) {
            const int chunk = 2 * ks + hp;
            bf16x8 af[4], bfr[2];
#pragma unroll
            for (int nt = 0; nt < 4; ++nt) { const int n = 32 * nt + r; af[nt] = *(const LAS bf16x8*)(BT + n * 256 + ((chunk ^ (n & 15)) << 4)); }
            const f32x4 w0 = *(const LAS f32x4*)(wv + 16 * ks + 8 * hp), w1 = *(const LAS f32x4*)(wv + 16 * ks + 8 * hp + 4);
#pragma unroll
            for (int pt = 0; pt < 2; ++pt) { const int pp = 64 * hq + 32 * pt + r; const v4u xv = *(const LAS v4u*)(XT + pp * 256 + ((chunk ^ (pp & 15)) << 4));
                v4u sv; sv.x = pk2(bflo(xv.x) * w0[0], bfhi(xv.x) * w0[1]); sv.y = pk2(bflo(xv.y) * w0[2], bfhi(xv.y) * w0[3]);
                sv.z = pk2(bflo(xv.z) * w1[0], bfhi(xv.z) * w1[1]); sv.w = pk2(bflo(xv.w) * w1[2], bfhi(xv.w) * w1[3]);
                bfr[pt] = __builtin_bit_cast(bf16x8, sv); }
#pragma unroll
            for (int nt = 0; nt < 4; ++nt)
#pragma unroll
                for (int pt = 0; pt < 2; ++pt) acc[nt][pt] = __builtin_amdgcn_mfma_f32_32x32x16_bf16(af[nt], bfr[pt], acc[nt][pt], 0, 0, 0);
        }
        asm volatile("s_waitcnt lgkmcnt(0)" ::: "memory"); __syncthreads();
        {
            LAS unsigned char* stg = F.lds + w * (64 * 264);
#pragma unroll
            for (int nt = 0; nt < 4; ++nt)
#pragma unroll
                for (int pt = 0; pt < 2; ++pt)
#pragma unroll
                    for (int q = 0; q < 4; ++q) { u32x2v o; o.x = pk2(acc[nt][pt][4 * q], acc[nt][pt][4 * q + 1]); o.y = pk2(acc[nt][pt][4 * q + 2], acc[nt][pt][4 * q + 3]);
                        *(LAS u32x2v*)(stg + (32 * pt + r) * 264 + (32 * nt + 8 * q + 4 * hp) * 2) = o; }
            asm volatile("s_waitcnt lgkmcnt(0)" ::: "memory");
            bf16* Sp = (bf16*)(F.ws + (dir ? WS_SB : WS_SF)) + (size_t)(bc * NH + h) * (HD * NST);
#pragma unroll
            for (int j = 0; j < 16; ++j) { const int row = 4 * j + (lane >> 4), ch = lane & 15;
                const u32x2v a = *(const LAS u32x2v*)(stg + row * 264 + ch * 16), b2 = *(const LAS u32x2v*)(stg + row * 264 + ch * 16 + 8);
                v4u o; o.x = a.x; o.y = a.y; o.z = b2.x; o.w = b2.y; *(v4u*)(Sp + (size_t)row * NST + ch * 8) = o; }
            if (lane == 0) DEC[dir * (BATCH * NCH * NH) + bc * NH + h] = __expf(total);
        }
    }
    __syncthreads();
}

struct NaTile { float m, l; f32x4 o[4]; };
__device__ __forceinline__ void na_tile(NaTile& S, const bf16x8 (&kf)[4], const u32x2v (&vl)[4], const u32x2v (&vh)[4], const bf16x8 qf0, const bf16x8 qf1,
                                        const float (&be)[8]) {
    const f32x4 z = {0.f, 0.f, 0.f, 0.f};
    f32x4 s0 = __builtin_amdgcn_mfma_f32_16x16x32_bf16(kf[0], qf0, z, 0, 0, 0); s0 = __builtin_amdgcn_mfma_f32_16x16x32_bf16(kf[1], qf1, s0, 0, 0, 0);
    f32x4 s1 = __builtin_amdgcn_mfma_f32_16x16x32_bf16(kf[2], qf0, z, 0, 0, 0); s1 = __builtin_amdgcn_mfma_f32_16x16x32_bf16(kf[3], qf1, s1, 0, 0, 0);
    float sv[8]; float mx = -1e30f;
#pragma unroll
    for (int ct = 0; ct < 2; ++ct)
#pragma unroll
        for (int reg = 0; reg < 4; ++reg) { const float s = (ct ? s1[reg] : s0[reg]) + be[4 * ct + reg]; sv[4 * ct + reg] = s; mx = fmaxf(mx, s); }
    mx = red32_max(red16_max(mx));
    const float mn = fmaxf(S.m, mx), alpha = __builtin_amdgcn_exp2f(S.m - mn); S.m = mn;
    float ps = 0.f;
#pragma unroll
    for (int e = 0; e < 8; ++e) { sv[e] = __builtin_amdgcn_exp2f(sv[e] - mn); ps += sv[e]; }
    S.l = S.l * alpha + ps;
    v4u pb; pb.x = pk2(sv[0], sv[1]); pb.y = pk2(sv[2], sv[3]); pb.z = pk2(sv[4], sv[5]); pb.w = pk2(sv[6], sv[7]);
    const bf16x8 pf = __builtin_bit_cast(bf16x8, pb);
#pragma unroll
    for (int dt = 0; dt < 4; ++dt) { v4u vv; vv.x = vl[dt].x; vv.y = vl[dt].y; vv.z = vh[dt].x; vv.w = vh[dt].y;
        S.o[dt] = __builtin_amdgcn_mfma_f32_16x16x32_bf16(__builtin_bit_cast(bf16x8, vv), pf, S.o[dt] * alpha, 0, 0, 0); }
}
constexpr int NA_SLOT = 16384, NA_NSLOT = 9, NA_BIAS_OFF = NA_SLOT * NA_NSLOT;
__device__ __forceinline__ int na_r0(int i) { int r = i - KH / 2; return r < 0 ? 0 : (r > GROWS - KH ? GROWS - KH : r); }
__device__ __forceinline__ void na_mfma(Frame& F, const int dry) {
    LAS unsigned char* ring = F.lds;
    LAS float* bias = (LAS float*)(F.lds + NA_BIAS_OFF);
    bf16* ZQ = (bf16*)(F.ws + WS_ZQ); const bf16* KB = (const bf16*)(F.ws + WS_K); const bf16* VT = (const bf16*)(F.ws + WS_V);
    const int w = F.wave;
    constexpr int NITEM = BATCH * NH * (GROWS / 16);
    for (int item = F.vcu; item < NITEM; item += F.G) {
        const int bh = item >> 3, band = item & 7, b = bh / NH, hh = bh % NH;
        __syncthreads();
        for (int u = F.tid; u < 15 * 31; u += NWAVES * 64) bias[u] = F.in[13][hh * 465 + u];
        int lane = F.lane; asm volatile("" : "+v"(lane));
        const int c = lane & 15, g4 = lane >> 4, qrow = w >> 2, jb = w & 3, j0 = 16 * jb, j = j0 + c;
        int cs = j0 - 8; cs = cs < 0 ? 0 : (cs > 32 ? 32 : cs);
        int c0 = j - 8; c0 = c0 < 0 ? 0 : (c0 > GW - KW ? GW - KW : c0);
        const int kc0 = cs + 4 * g4, bcol = kc0 - j + 15;
        const int prow = 8 * w + (lane >> 3), lchunk = (lane & 7) ^ ((prow >> 1) & 7);
        const bf16* ksrc = KB + ((size_t)b * T + prow) * 1024 + hh * HD + 8 * lchunk;
        const bf16* vsrc = VT + (size_t)(hh * HD + prow) * M + (size_t)b * T + 8 * lchunk;
#define NA_DMA(kr) do { const int kr_ = (kr); LAS unsigned char* sl_ = ring + (kr_ % NA_NSLOT) * NA_SLOT + w * 1024; \
            __builtin_amdgcn_global_load_lds((const unsigned*)(ksrc + (size_t)kr_ * GW * 1024), (LAS unsigned*)(sl_), 16, 0, 0); \
            __builtin_amdgcn_global_load_lds((const unsigned*)(vsrc + (size_t)kr_ * GW), (LAS unsigned*)(sl_ + 8192), 16, 0, 0); } while (0)
        int koff[4], voff[4], voffh[4];
#pragma unroll
        for (int ct = 0; ct < 2; ++ct)
#pragma unroll
            for (int ks = 0; ks < 2; ++ks) { const int tok = cs + 16 * ct + c; koff[2 * ct + ks] = tok * 128 + (((4 * ks + g4) ^ ((tok >> 1) & 7)) << 4); }
        const int vob = ((cs + 4 * g4) * 2) & 15, vlc = ((cs + 4 * g4) * 2) >> 4;
#pragma unroll
        for (int dt = 0; dt < 4; ++dt) { const int d = 16 * dt + c; voff[dt] = 8192 + d * 128 + vob + ((vlc ^ ((d >> 1) & 7)) << 4); voffh[dt] = 8192 + d * 128 + vob + (((vlc + 2) ^ ((d >> 1) & 7)) << 4); }
        const int i00 = 16 * band;
        { const int rA = na_r0(i00), rB = na_r0(i00 + 1); for (int kr = rA; kr < rB + KH; ++kr) NA_DMA(kr); }
        bf16* qp = ZQ + ((size_t)b * T + (i00 + qrow) * GW + j) * 2048 + 1024 + hh * HD;
        bf16x8 qf0 = *(const bf16x8*)(qp + 8 * g4), qf1 = *(const bf16x8*)(qp + 32 + 8 * g4);
        asm volatile("s_waitcnt vmcnt(0)" ::: "memory"); __syncthreads();
        float be[8][8]; int cur_rel = 1000;
        u32x2v pend[4]; bf16* pendp = qp; bool have_pend = false;
#pragma unroll
        for (int dt = 0; dt < 4; ++dt) pend[dt] = (u32x2v){0u, 0u};
#pragma unroll 1
        for (int it = 0; it < 8; ++it) {
            const int i0 = i00 + 2 * it, i = i0 + qrow, r0 = na_r0(i);
            if (r0 - i != cur_rel) { cur_rel = r0 - i;
#pragma unroll
                for (int s_ = 0; s_ < 8; ++s_)
#pragma unroll
                    for (int ct = 0; ct < 2; ++ct)
#pragma unroll
                        for (int reg = 0; reg < 4; ++reg) { const int kc = kc0 + 16 * ct + reg; const bool ok = (kc >= c0) && (kc < c0 + KW);
                            const float bv = bias[ok ? (cur_rel + s_ + 7) * 31 + bcol + 16 * ct + reg : 0]; be[s_][4 * ct + reg] = ok ? bv * 1.4426950408889634f : -1e30f; } }
            NaTile t; t.m = -1e30f; t.l = 0.f;
#pragma unroll
            for (int dt = 0; dt < 4; ++dt) t.o[dt] = (f32x4){0.f, 0.f, 0.f, 0.f};
#define NA_STEP(s) do { const int kr_ = r0 + (s); const LAS unsigned char* sl_ = ring + (kr_ % NA_NSLOT) * NA_SLOT; bf16x8 kf_[4]; u32x2v vl_[4], vh_[4]; \
                _Pragma("unroll") for (int q_ = 0; q_ < 4; ++q_) kf_[q_] = *(const LAS bf16x8*)(sl_ + koff[q_]); \
                _Pragma("unroll") for (int q_ = 0; q_ < 4; ++q_) { vl_[q_] = *(const LAS u32x2v*)(sl_ + voff[q_]); vh_[q_] = *(const LAS u32x2v*)(sl_ + voffh[q_]); } \
                na_tile(t, kf_, vl_, vh_, qf0, qf1, be[s]); } while (0)
            NA_STEP(0); NA_STEP(1);
            asm volatile("s_waitcnt lgkmcnt(0)" ::: "memory"); __syncthreads();
            if (have_pend && !dry) {
#pragma unroll
                for (int dt = 0; dt < 4; ++dt) *(u32x2v*)(pendp + 16 * dt + 4 * g4) = pend[dt]; }
            bf16x8 nq0 = qf0, nq1 = qf1; bf16* nqp = qp + (size_t)2 * GW * 2048;
            if (it < 7) { const int rB = na_r0(i0 + 1), rB2 = na_r0(i0 + 3); for (int kr = rB + KH; kr < rB2 + KH; ++kr) NA_DMA(kr);
                nq0 = *(const bf16x8*)(nqp + 8 * g4); nq1 = *(const bf16x8*)(nqp + 32 + 8 * g4); }
            NA_STEP(2); NA_STEP(3); NA_STEP(4); NA_STEP(5); NA_STEP(6); NA_STEP(7);
#undef NA_STEP
            { const float l = red32_add(red16_add(t.l)); const float inv = __builtin_amdgcn_rcpf(l);
#pragma unroll
              for (int dt = 0; dt < 4; ++dt) { pend[dt].x = pk2(t.o[dt][0] * inv, t.o[dt][1] * inv); pend[dt].y = pk2(t.o[dt][2] * inv, t.o[dt][3] * inv); } }
            pendp = qp; have_pend = true;
            qp = nqp; qf0 = nq0; qf1 = nq1;
            asm volatile("s_waitcnt vmcnt(0) lgkmcnt(0)" ::: "memory"); __syncthreads();
        }
        if (!dry) {
#pragma unroll
            for (int dt = 0; dt < 4; ++dt) *(u32x2v*)(pendp + 16 * dt + 4 * g4) = pend[dt]; }
#undef NA_DMA
    }
    __syncthreads();
}

struct Args { const float* in[18]; float* out; unsigned char* ws; int ph_lo, ph_hi, li, pad; };
__global__ void __launch_bounds__(NWAVES * 64, 2) skel_fwd(Args args) {
    extern __shared__ __attribute__((aligned(16))) unsigned char lds[];
    Frame F;
    F.lds = (LAS unsigned char*)lds;
    F.MISC = (volatile LAS unsigned*)(F.lds + MISC_OFF);
    F.tid = threadIdx.x; F.lane = F.tid & 63; F.wave = __builtin_amdgcn_readfirstlane(F.tid >> 6);
    F.G = gridDim.x; { const int bx = blockIdx.x; F.vcu = (F.G % 8 == 0) ? (bx % 8) * (F.G / 8) + bx / 8 : bx; }
    F.ws = args.ws; F.out = args.out;
#pragma unroll
    for (int i = 0; i < 18; ++i) F.in[i] = args.in[i];
    F.ctl = (gu32*)(F.ws + WS_CTL);
#define GRID_BAR(seam) do { if (N_LAUNCHES == PER_PHASE) { if (F.tid == 0) __hip_atomic_store(F.ctl + CW_TMO, 0xBADBA0u | (unsigned)(seam), RLX_AGENT); } \
    else { xcd_barrier(bar); } } while (0)
    for (int u = F.tid; u < (LDS_BYTES - LDSCTL_OFF) / 4; u += NWAVES * 64) ((LAS unsigned*)(F.lds + LDSCTL_OFF))[u] = 0u;
    __syncthreads();
    XcdBarrier bar; bar.bar = (unsigned*)(F.ctl + CW_BAR); bar.x = 0; bar.st = nullptr;
    if (N_LAUNCHES != PER_PHASE) bar = xcd_barrier_post((unsigned*)(F.ctl + CW_BAR), F.MISC + 8);
    const int lo = args.ph_lo, hi = args.ph_hi;
#define IN(k) (lo <= (k) && (k) < hi)
#define BOTH(k) (IN(k) && IN((k) + 1))
    unsigned char* ws = F.ws;
#ifndef PROBE_PHASE
#define PROBE_PHASE -1
#endif
    const int dry0 = (PROBE_PHASE < 0) ? 0 : args.pad, dry1 = args.pad + 1;
#define RUN2(k, DRYCALL, CALL) do { if (PROBE_PHASE == (k)) { DRYCALL; __syncthreads(); } CALL; } while (0)
    if (IN(0)) { RUN2(0, p0_prologue(F), p0_prologue(F)); if (BOTH(0)) GRID_BAR(0); }
    if (IN(1)) {
#define P1_BODY do { \
        pg8::Gemm g{(const bf16*)(ws + WS_WIN), (const bf16*)(ws + WS_WIN), M, NMAIN, D}; pg8::P1Order S; S.init(M, NMAIN, F.G, (int)blockIdx.x); \
        pg8::EpiInProj E{(bf16*)(ws + WS_ZQ), (bf16*)(ws + WS_XBC), (bf16*)(ws + WS_K), (bf16*)(ws + WS_V), (float*)(ws + WS_DT), F.in[11], F.in[12], F.in[5], F.in[6]}; \
        pg8::gemm_phase<pg8::EpiInProj, pg8::P1Order, PG8_ALIGN, PG8_SP2>(F.lds + RING_OFF, g, S, E); } while (0)
        RUN2(1, P1_BODY, P1_BODY);
        if (BOTH(1)) GRID_BAR(1);
    }
    if (IN(2)) { RUN2(2, ssd_states_mfma(F), ssd_states_mfma(F)); RUN2(3, na_mfma(F, dry1), na_mfma(F, dry0)); if (BOTH(2)) GRID_BAR(2); }
    if (IN(3)) { RUN2(4, ssd_scan(F, dry1), ssd_scan(F, dry0)); RUN2(5, p_weights_late(F), p_weights_late(F)); if (BOTH(3)) GRID_BAR(3); }
    if (IN(4)) { RUN2(6, ssd_out_mfma(F, dry1), ssd_out_mfma(F, dry0)); if (BOTH(4)) GRID_BAR(4); }
    if (IN(5)) {
#define P5_BODY do { pg8::Gemm g{(const bf16*)(ws + WS_ZQ), (const bf16*)(ws + WS_WOUT), M, D, 2048}; pg8::StaticOrder S; S.init(M, D, F.G, (int)blockIdx.x); \
        pg8::EpiOutProj E{F.in[0], F.out, (bf16*)(ws + WS_XW), F.in[15], (float*)(ws + WS_SS)}; \
        pg8::gemm_phase<pg8::EpiOutProj, pg8::StaticOrder, false, PG8_SP2>(F.lds + RING_OFF, g, S, E); } while (0)
        RUN2(7, P5_BODY, P5_BODY);
        if (BOTH(5)) GRID_BAR(5);
    }
    if (IN(6)) {
#define P6_BODY do { pg8::Gemm g{(const bf16*)(ws + WS_XW), (const bf16*)(ws + WS_W1), M, FF, D}; pg8::StaticOrder S; S.init(M, FF, F.G, (int)blockIdx.x); \
        pg8::EpiMlpIn E{(bf16*)(ws + WS_H), (const float*)(ws + WS_SS)}; \
        pg8::gemm_phase<pg8::EpiMlpIn, pg8::StaticOrder, PG8_ALIGN, PG8_SP2>(F.lds + RING_OFF, g, S, E); } while (0)
        RUN2(8, P6_BODY, P6_BODY);
        if (BOTH(6)) GRID_BAR(6);
    }
    if (IN(7)) {
#define P7_BODY(DRY) do { pg8::Gemm g{(const bf16*)(ws + WS_H), (const bf16*)(ws + WS_W2), M, D, FF}; pg8::StaticOrder S; S.init(M, D, F.G, (int)blockIdx.x); \
        pg8::EpiMlpOut E{F.out, DRY}; \
        pg8::gemm_phase<pg8::EpiMlpOut, pg8::StaticOrder, false, PG8_SP2>(F.lds + RING_OFF, g, S, E); } while (0)
        RUN2(9, P7_BODY(dry1), P7_BODY(dry0));
    }
#undef IN
#undef BOTH
}

extern "C" void kernel_launch(void* const* d_in, const int* in_sizes, int n_in, void* d_out, int out_size, void* d_ws, size_t ws_size, hipStream_t stream) {
    static int grid = 0;
    if (grid == 0) {
        if (n_in != 18 || in_sizes[0] != M * D || out_size != M * D || ws_size < WS_END) { fprintf(stderr, "kernel_launch: unexpected shapes (n_in %d, in0 %d, out %d, ws %zu); nothing launched\n", n_in, n_in > 0 ? in_sizes[0] : -1, out_size, ws_size); grid = -1; return; }
        int dev = 0, cus = 0, per_cu = 0;
        if (hipGetDevice(&dev) != hipSuccess || hipDeviceGetAttribute(&cus, hipDeviceAttributeMultiprocessorCount, dev) != hipSuccess) { grid = -1; return; }
        if (hipFuncSetAttribute((const void*)skel_fwd, hipFuncAttributeMaxDynamicSharedMemorySize, LDS_BYTES) != hipSuccess) { fprintf(stderr, "kernel_launch: hipFuncSetAttribute failed\n"); grid = -1; return; }
        if (hipOccupancyMaxActiveBlocksPerMultiprocessor(&per_cu, (const void*)skel_fwd, NWAVES * 64, LDS_BYTES) != hipSuccess || per_cu < 1)
            fprintf(stderr, "kernel_launch: note: occupancy query reports %d workgroups per CU\n", per_cu);
        (void)hipGetLastError();
        grid = cus;
    }
    if (grid < 0) return;
    if (hipMemsetAsync((char*)d_ws + WS_CTL, 0, CTL_ZERO_BYTES, stream) != hipSuccess) { fprintf(stderr, "kernel_launch: hipMemsetAsync failed\n"); return; }
    Args a{};
    for (int i = 0; i < 18; ++i) a.in[i] = (const float*)d_in[i];
    a.out = (float*)d_out; a.ws = (unsigned char*)d_ws;
    if (N_LAUNCHES == 1) { a.ph_lo = 0; a.ph_hi = PER_PHASE; a.li = 0; hipLaunchKernelGGL(skel_fwd, dim3(grid), dim3(NWAVES * 64), LDS_BYTES, stream, a); }
    else for (int li = 0; li < PER_PHASE; ++li) { a.ph_lo = li; a.ph_hi = li + 1; a.li = li; hipLaunchKernelGGL(skel_fwd, dim3(grid), dim3(NWAVES * 64), LDS_BYTES, stream, a); }
}
```

```cpp
#include <hip/hip_runtime.h>
#include <cstdio>
#include <cstdint>
namespace pg8 {
#define PG8_LAS __attribute__((address_space(3)))
typedef unsigned short bf16_t;
typedef short bf16x8 __attribute__((ext_vector_type(8)));
typedef float f32x4 __attribute__((ext_vector_type(4)));
typedef unsigned u32x4 __attribute__((ext_vector_type(4)));
constexpr int BM = 256, BK = 64, HALF = 128, HTB = HALF * BK * 2  , STAGE_BYTES = 8 * HTB, NXCD = 8, WGM = 4;

__host__ __device__ __forceinline__ int lds_byte(int r, int c) { const int st = (r >> 4) * 2 + (c >> 5), rr = r & 15, cc = c & 31, ob = rr * 64 + cc * 2; return st * 1024 + (ob ^ (((ob >> 9) & 1) << 5)); }
__host__ __device__ __forceinline__ void stage_rc(int b, int& R, int& C) { const int st = b / 1024, sb = b % 1024, swz = sb ^ (((sb >> 9) & 1) << 5); R = (st >> 1) * 16 + swz / 64; C = (st & 1) * 32 + (swz % 64) / 2; }
__host__ __device__ __forceinline__ int perm32(int rho) { const int n = rho >> 4, i = rho & 15; return 8 * (i >> 2) + 4 * n + (i & 3); }

struct Unit { int pm, pn; };
struct Gemm { const bf16_t* A; const bf16_t* Bt; int M, N, K; };

struct StaticOrder {
    int nM, nN, nwg, G, c;
    __host__ __device__ void init(int M, int N, int G_, int c_) { nM = M / BM; nN = N / BM; nwg = nM * nN; G = G_; c = c_; }
    __host__ __device__ bool next(int i, Unit& u) const {
        const long L = (long)i * G + c; if (L >= nwg) return false;
        int wgid = (int)L; { const int q = nwg / NXCD, r = nwg % NXCD, xcd = wgid % NXCD, off = wgid / NXCD; wgid = (xcd < r ? xcd * (q + 1) : r * (q + 1) + (xcd - r) * q) + off; }
        const int nig = WGM * nN, gid = wgid / nig, fm = gid * WGM, gsz = (nM - fm) < WGM ? (nM - fm) : WGM;
        u.pm = fm + ((wgid % nig) % gsz); u.pn = (wgid % nig) / gsz; return true;
    }
    __device__ __forceinline__ void a_ready(const Unit&) const {}
    __device__ __forceinline__ void done(const Unit&) const {}
};

typedef float f32x2_cv __attribute__((ext_vector_type(2))); typedef __bf16 bf16x2_cv __attribute__((ext_vector_type(2)));
__device__ __forceinline__ unsigned cvt_pk_bf16(float lo, float hi) { const f32x2_cv v = {lo, hi}; const bf16x2_cv b = __builtin_convertvector(v, bf16x2_cv); return __builtin_bit_cast(unsigned, b); }
typedef float f32x2 __attribute__((ext_vector_type(2)));
__device__ __forceinline__ f32x2 gelu_pk(f32x2 v) {
    const f32x2 av = __builtin_elementwise_abs(v), d = av * 0.2316418882f + 1.0f;
    f32x2 t; t.x = __builtin_amdgcn_rcpf(d.x); t.y = __builtin_amdgcn_rcpf(d.y);
    f32x2 q = t * 0.5307027145f + (-0.7265760135f); q = q * t + 0.7107068705f; q = q * t + (-0.142248368f); q = q * t + 0.127414796f; q = q * t;
    const f32x2 s = (v * v) * (-0.72134752044f);
    f32x2 e; e.x = __builtin_amdgcn_exp2f(s.x); e.y = __builtin_amdgcn_exp2f(s.y);
    const f32x2 m = v * (q * e), r = v - m;
    f32x2 o; o.x = v.x < 0.f ? m.x : r.x; o.y = v.y < 0.f ? m.y : r.y; return o;
}

template <int ACT  > struct EpiBf16 {
    static constexpr bool PERM = true, AFTER_DRAIN = false; static_assert(ACT == 0 || ACT == 1, "EpiBf16: ACT is 0 (none) or 1 (gelu_pk)");
    bf16_t* O; int ldc; const float* bias; int split_cols; size_t split_stride; float scale0;
    __device__ __forceinline__ void operator()(const f32x4 (&acc)[2][2][4][2], const Unit& u, int wr, int wc, int fr, int fq) const {
        const int row0 = u.pm * BM + wr * 64 + fr; int colt = u.pn * BM; bf16_t* base = O;
        float sc = 1.f; if (split_cols) { const int t = colt / split_cols; base += (size_t)t * split_stride; colt -= t * split_cols; if (t == 0) sc = scale0; }
        const int col0 = colt + wc * 32 + 8 * fq, bcol0 = u.pn * BM + wc * 32 + 8 * fq;
        f32x4 bv[2][2];
#pragma unroll
        for (int bj = 0; bj < 2; ++bj)
#pragma unroll
            for (int n = 0; n < 2; ++n) bv[bj][n] = bias ? *(const f32x4*)(bias + bcol0 + bj * HALF + 4 * n) : (f32x4){0.f, 0.f, 0.f, 0.f};
#pragma unroll
        for (int ai = 0; ai < 2; ++ai)
#pragma unroll
            for (int m = 0; m < 4; ++m) { bf16_t* rowp = base + (size_t)(row0 + ai * HALF + m * 16) * ldc + col0;
#pragma unroll
                for (int bj = 0; bj < 2; ++bj) { f32x4 v0 = acc[ai][bj][m][0] + bv[bj][0], v1 = acc[ai][bj][m][1] + bv[bj][1];
                    if (ACT == 1) { f32x2 a = gelu_pk((f32x2){v0[0], v0[1]}), b = gelu_pk((f32x2){v0[2], v0[3]}), c = gelu_pk((f32x2){v1[0], v1[1]}), d = gelu_pk((f32x2){v1[2], v1[3]});
                        v0 = (f32x4){a.x, a.y, b.x, b.y}; v1 = (f32x4){c.x, c.y, d.x, d.y}; }
                    v0 = v0 * sc; v1 = v1 * sc; u32x4 w; w.x = cvt_pk_bf16(v0[0], v0[1]); w.y = cvt_pk_bf16(v0[2], v0[3]); w.z = cvt_pk_bf16(v1[0], v1[1]); w.w = cvt_pk_bf16(v1[2], v1[3]);
                    *(u32x4*)(rowp + bj * HALF) = w; } }
    }
};
template <class Epi, class Sched, bool ALIGN_EPI = false, bool SP2 = false>
__device__ __forceinline__ void gemm_phase(PG8_LAS unsigned char* lds, const Gemm g, const Sched& S, const Epi& E) {
    const int tid = threadIdx.x, wid = __builtin_amdgcn_readfirstlane(tid >> 6), lane = tid & 63, wr = wid >> 2, wc = wid & 3, fr = lane & 15, fq = lane >> 4;
    const int K = g.K, nt = K / BK;
    unsigned voffA[2], voffB[2];
#pragma unroll
    for (int i = 0; i < 2; ++i) { int R, C; stage_rc(tid * 16 + i * 8192, R, C); const int Rb = Epi::PERM ? ((R & ~31) + perm32(R & 31)) : R;
        voffA[i] = (unsigned)(R * K + C) * 2u; voffB[i] = (unsigned)(Rb * K + C) * 2u; }
    const size_t kstep = (size_t)(BK * 2);
    const size_t hstep = (size_t)HALF * K * 2;
    const size_t tstep = 2 * hstep;
    const unsigned ldsw = (unsigned)wid * 1024u;
    const int aoff = lds_byte(wr * 64 + fr, fq * 8), boff = lds_byte(wc * 32 + fr, fq * 8);
#define PG8_SA(b, h) (((b) * 2 + (h)) * HTB)
#define PG8_SB(b, h) ((4 + (b) * 2 + (h)) * HTB)
#define PG8_STAGE(bufoff, gbase, voff) do { _Pragma("unroll") for (int _i = 0; _i < 2; ++_i) \
        __builtin_amdgcn_global_load_lds((const unsigned*)((const char*)(gbase) + (voff)[_i]), (PG8_LAS unsigned*)(lds + (bufoff) + ldsw + _i * 8192), 16, 0, 0); } while (0)
#define PG8_LDA(dst, b, h) do { _Pragma("unroll") for (int m = 0; m < 4; ++m) _Pragma("unroll") for (int k = 0; k < 2; ++k) dst[m][k] = *(const PG8_LAS bf16x8*)(lds + PG8_SA(b, h) + aoff + m * 2048 + k * 1024); } while (0)
#define PG8_LDB(dst, b, h) do { _Pragma("unroll") for (int n = 0; n < 2; ++n) _Pragma("unroll") for (int k = 0; k < 2; ++k) dst[n][k] = *(const PG8_LAS bf16x8*)(lds + PG8_SB(b, h) + boff + n * 2048 + k * 1024); } while (0)
#define PG8_MMA(ai, bj, At, Bt) do { __builtin_amdgcn_s_setprio(1); _Pragma("unroll") for (int m = 0; m < 4; ++m) _Pragma("unroll") for (int n = 0; n < 2; ++n) _Pragma("unroll") for (int k = 0; k < 2; ++k) \
        acc[ai][bj][m][n] = __builtin_amdgcn_mfma_f32_16x16x32_bf16(Bt[n][k], At[m][k], acc[ai][bj][m][n], 0, 0, 0); __builtin_amdgcn_s_setprio(0); } while (0)
#define PG8_WAIT_V(n) asm volatile("s_waitcnt vmcnt(" #n ")" ::: "memory")
#define PG8_WAIT_L(n) asm volatile("s_waitcnt lgkmcnt(" #n ")" ::: "memory")
#define PG8_BAR __builtin_amdgcn_s_barrier()
#define PG8_SCHED __builtin_amdgcn_sched_barrier(0)
    Unit cur, nxt; int ui = 0;
    if (!S.next(0, cur)) return;
    f32x4 acc[2][2][4][2];
#pragma unroll
    for (int a = 0; a < 2; ++a)
#pragma unroll
        for (int b = 0; b < 2; ++b)
#pragma unroll
            for (int m = 0; m < 4; ++m)
#pragma unroll
                for (int n = 0; n < 2; ++n) acc[a][b][m][n] = (f32x4){0.f, 0.f, 0.f, 0.f};
    bf16x8 At[4][2], B0[2][2], B1[2][2];
    const char* cA = (const char*)g.A + (size_t)cur.pm * tstep; const char* cB = (const char*)g.Bt + (size_t)cur.pn * tstep;
    S.a_ready(cur);
    if constexpr (SP2) {
        PG8_STAGE(PG8_SB(0, 0), cB, voffB); PG8_STAGE(PG8_SB(0, 1), cB + hstep, voffB); PG8_STAGE(PG8_SA(0, 0), cA, voffA); PG8_STAGE(PG8_SA(0, 1), cA + hstep, voffA);
        if (wr == 1) PG8_BAR;
        PG8_WAIT_V(2); PG8_BAR;
        PG8_STAGE(PG8_SB(1, 0), cB + kstep, voffB); PG8_STAGE(PG8_SA(1, 0), cA + kstep, voffA); PG8_STAGE(PG8_SB(1, 1), cB + hstep + kstep, voffB);
        PG8_WAIT_V(6); PG8_BAR;
    } else {
        PG8_STAGE(PG8_SB(0, 0), cB, voffB); PG8_STAGE(PG8_SA(0, 0), cA, voffA); PG8_STAGE(PG8_SB(0, 1), cB + hstep, voffB); PG8_STAGE(PG8_SA(0, 1), cA + hstep, voffA);
        if (wr == 1) PG8_BAR;
        PG8_WAIT_V(4); PG8_BAR;
        PG8_STAGE(PG8_SB(1, 0), cB + kstep, voffB); PG8_STAGE(PG8_SA(1, 0), cA + kstep, voffA); PG8_STAGE(PG8_SB(1, 1), cB + hstep + kstep, voffB);
        PG8_WAIT_V(6); PG8_BAR;
    }
    for (;;) {
        const bool has_next = S.next(ui + 1, nxt);
        const char* nA = has_next ? (const char*)g.A + (size_t)nxt.pm * tstep : cA; const char* nB = has_next ? (const char*)g.Bt + (size_t)nxt.pn * tstep : cB;
        for (int t = 0; t < nt; t += 2) {
            const bool last = (t == nt - 2);
            const char* a1 = cA + (size_t)(t + 1) * kstep;
            const char* a2 = last ? nA : cA + (size_t)(t + 2) * kstep; const char* b2 = last ? nB : cB + (size_t)(t + 2) * kstep;
            const char* a3 = a2 + kstep; const char* b3 = b2 + kstep;
            if (last && has_next) S.a_ready(nxt);
            if constexpr (SP2) {
            PG8_LDB(B0, 0, 0); PG8_LDB(B1, 0, 1); PG8_SCHED; PG8_LDA(At, 0, 0); PG8_STAGE(PG8_SA(1, 1), a1 + hstep, voffA);
            PG8_WAIT_V(8); PG8_WAIT_L(0); PG8_BAR; PG8_MMA(0, 0, At, B0); PG8_MMA(0, 1, At, B1); PG8_BAR; PG8_SCHED;
            PG8_LDA(At, 0, 1); PG8_STAGE(PG8_SB(0, 0), b2, voffB); PG8_STAGE(PG8_SB(0, 1), b2 + hstep, voffB); PG8_STAGE(PG8_SA(0, 0), a2, voffA);
            PG8_WAIT_V(8); PG8_WAIT_L(0); PG8_BAR; PG8_MMA(1, 0, At, B0); PG8_MMA(1, 1, At, B1); PG8_BAR; PG8_SCHED;
            PG8_LDB(B0, 1, 0); PG8_LDB(B1, 1, 1); PG8_SCHED; PG8_LDA(At, 1, 0); PG8_STAGE(PG8_SA(0, 1), a2 + hstep, voffA);
            PG8_WAIT_V(8); PG8_WAIT_L(0); PG8_BAR; PG8_MMA(0, 0, At, B0); PG8_MMA(0, 1, At, B1); PG8_BAR; PG8_SCHED;
            PG8_LDA(At, 1, 1); PG8_STAGE(PG8_SB(1, 0), b3, voffB); PG8_STAGE(PG8_SB(1, 1), b3 + hstep, voffB); PG8_STAGE(PG8_SA(1, 0), a3, voffA);
            PG8_WAIT_V(8); PG8_WAIT_L(0); PG8_BAR; PG8_MMA(1, 0, At, B0); PG8_MMA(1, 1, At, B1); PG8_BAR; PG8_SCHED;
            } else {
            PG8_LDB(B0, 0, 0); PG8_SCHED; PG8_LDA(At, 0, 0); PG8_STAGE(PG8_SA(1, 1), a1 + hstep, voffA);
            PG8_WAIT_L(8); PG8_BAR; PG8_WAIT_L(0); PG8_MMA(0, 0, At, B0); PG8_BAR; PG8_SCHED;
            PG8_LDB(B1, 0, 1); PG8_STAGE(PG8_SB(0, 0), b2, voffB);
            PG8_BAR; PG8_WAIT_L(0); PG8_MMA(0, 1, At, B1); PG8_BAR;
            PG8_LDA(At, 0, 1); PG8_STAGE(PG8_SA(0, 0), a2, voffA);
            PG8_BAR; PG8_WAIT_L(0); PG8_MMA(1, 0, At, B0); PG8_BAR; PG8_SCHED;
            PG8_STAGE(PG8_SB(0, 1), b2 + hstep, voffB);
            PG8_WAIT_V(6); PG8_BAR; PG8_MMA(1, 1, At, B1); PG8_BAR;
            PG8_LDB(B0, 1, 0); PG8_SCHED; PG8_LDA(At, 1, 0); PG8_STAGE(PG8_SA(0, 1), a2 + hstep, voffA);
            PG8_WAIT_L(8); PG8_BAR; PG8_WAIT_L(0); PG8_MMA(0, 0, At, B0); PG8_BAR; PG8_SCHED;
            PG8_LDB(B1, 1, 1); PG8_STAGE(PG8_SB(1, 0), b3, voffB);
            PG8_BAR; PG8_WAIT_L(0); PG8_MMA(0, 1, At, B1); PG8_BAR;
            PG8_LDA(At, 1, 1); PG8_STAGE(PG8_SA(1, 0), a3, voffA);
            PG8_BAR; PG8_WAIT_L(0); PG8_MMA(1, 0, At, B0); PG8_BAR; PG8_SCHED;
            PG8_STAGE(PG8_SB(1, 1), b3 + hstep, voffB);
            PG8_WAIT_V(6); PG8_BAR; PG8_MMA(1, 1, At, B1); PG8_BAR;
            }
        }
        if constexpr (ALIGN_EPI) { if (wr == 0) PG8_BAR; }
        if constexpr (!Epi::AFTER_DRAIN) { E(acc, cur, wr, wc, fr, fq); S.done(cur); }
        if (!has_next) break;
#pragma unroll
        for (int a = 0; a < 2; ++a)
#pragma unroll
            for (int b = 0; b < 2; ++b)
#pragma unroll
                for (int m = 0; m < 4; ++m)
#pragma unroll
                    for (int n = 0; n < 2; ++n) acc[a][b][m][n] = (f32x4){0.f, 0.f, 0.f, 0.f};
        cur = nxt; cA = nA; cB = nB; ++ui;
        if constexpr (ALIGN_EPI) { if (wr == 1) PG8_BAR; }
    }
    PG8_WAIT_V(0);
    if constexpr (!ALIGN_EPI) { if (wr == 0) PG8_BAR; }
    PG8_BAR;
    if constexpr (Epi::AFTER_DRAIN) { E.fused(acc, cur, wr, wc, fr, fq, lds, wid, lane); S.done(cur); }
#undef PG8_SA
#undef PG8_SB
#undef PG8_STAGE
#undef PG8_LDA
#undef PG8_LDB
#undef PG8_MMA
#undef PG8_WAIT_V
#undef PG8_WAIT_L
#undef PG8_BAR
#undef PG8_SCHED
}
}
namespace pg8 {
struct P1Order {
    StaticOrder main; int G, c;
    __host__ __device__ void init(int M_, int Nmain, int G_, int c_) { main.init(M_, Nmain, G_, c_); G = G_; c = c_; }
    __host__ __device__ bool next(int i, Unit& u) const {
        if (main.next(i, u)) { u.pm += 24; return true; }
        const long L = (long)i * G + c - main.nwg; if (L >= 256) return false;
        u.pm = 19 + (int)(L & 3); u.pn = 24 + (int)(L >> 2); return true;
    }
    __device__ __forceinline__ void a_ready(const Unit&) const {}
    __device__ __forceinline__ void done(const Unit&) const {}
};
typedef unsigned u32x2 __attribute__((ext_vector_type(2)));
__device__ __forceinline__ float softplus_f(float x) { const float e = __expf(-fabsf(x)); return fmaxf(x, 0.f) + (e < 1e-4f ? e * (1.0f - 0.5f * e) : __logf(1.0f + e)); }
struct EpiInProj {
    static constexpr bool PERM = true, AFTER_DRAIN = false;
    bf16_t* ZQ; bf16_t* XBC; bf16_t* KB; bf16_t* VB; float* DT; const float* qw; const float* kw; const float* dbf; const float* dbb;
    __device__ __forceinline__ void plain(const f32x4 (&acc)[2][2][4][2], bf16_t* base, int ldc, int row0, int col0) const {
#pragma unroll
        for (int ai = 0; ai < 2; ++ai)
#pragma unroll
            for (int m = 0; m < 4; ++m) { bf16_t* rowp = base + (size_t)(row0 + ai * HALF + m * 16) * ldc + col0;
#pragma unroll
                for (int bj = 0; bj < 2; ++bj) { const f32x4 v0 = acc[ai][bj][m][0], v1 = acc[ai][bj][m][1];
                    u32x4 w; w.x = cvt_pk_bf16(v0[0], v0[1]); w.y = cvt_pk_bf16(v0[2], v0[3]); w.z = cvt_pk_bf16(v1[0], v1[1]); w.w = cvt_pk_bf16(v1[2], v1[3]);
                    *(u32x4*)(rowp + bj * HALF) = w; } }
    }
    __device__ __forceinline__ void headnorm(const f32x4 (&acc)[2][2][4][2], bf16_t* base, int ldc, int row0, int colh, const float* w, float scale, int fq) const {
        f32x4 wv[2][2];
#pragma unroll
        for (int bj = 0; bj < 2; ++bj)
#pragma unroll
            for (int n = 0; n < 2; ++n) wv[bj][n] = *(const f32x4*)(w + 32 * bj + 8 * fq + 4 * n) * scale;
#pragma unroll
        for (int ai = 0; ai < 2; ++ai)
#pragma unroll
            for (int m = 0; m < 4; ++m) {
                float ss = 0.f;
#pragma unroll
                for (int bj = 0; bj < 2; ++bj)
#pragma unroll
                    for (int n = 0; n < 2; ++n) { const f32x4 x = acc[ai][bj][m][n]; ss += (x[0] * x[0] + x[1] * x[1]) + (x[2] * x[2] + x[3] * x[3]); }
                ss += __shfl_xor(ss, 16); ss += __shfl_xor(ss, 32);
                const float rstd = 1.0f / sqrtf(ss * (1.0f / 64.0f) + 1e-5f);
                bf16_t* rowp = base + (size_t)(row0 + ai * HALF + m * 16) * ldc + colh + 8 * fq;
#pragma unroll
                for (int bj = 0; bj < 2; ++bj) { const f32x4 v0 = acc[ai][bj][m][0] * rstd * wv[bj][0], v1 = acc[ai][bj][m][1] * rstd * wv[bj][1];
                    u32x4 o; o.x = cvt_pk_bf16(v0[0], v0[1]); o.y = cvt_pk_bf16(v0[2], v0[3]); o.z = cvt_pk_bf16(v1[0], v1[1]); o.w = cvt_pk_bf16(v1[2], v1[3]);
                    *(u32x4*)(rowp + 32 * bj) = o; } }
    }
    __device__ __forceinline__ void operator()(const f32x4 (&acc)[2][2][4][2], const Unit& u, int wr, int wc, int fr, int fq) const {
        asm volatile("" : "+v"(fr), "+v"(fq));
        const int colw = wc * 32 + 8 * fq;
        if (u.pn >= 24) { plain(acc, VB, 16384, (u.pm - 19) * BM + wr * 64 + fr, (u.pn - 24) * BM + colw); return; }
        const int row0 = (u.pm - 24) * BM + wr * 64 + fr, pn = u.pn;
        if (pn < 4) plain(acc, ZQ, 2048, row0, pn * 256 + colw);
        else if (pn < 10) plain(acc, XBC, 1536, row0, (pn - 4) * 256 + colw);
        else if (pn < 14) headnorm(acc, ZQ, 2048, row0, 1024 + 64 * (4 * (pn - 10) + wc), qw, 0.125f * 1.4426950408889634f, fq);
        else if (pn < 18) headnorm(acc, KB, 1024, row0, 64 * (4 * (pn - 14) + wc), kw, 1.0f, fq);
        else if (wc == 0) {
            f32x4 bv[2];
#pragma unroll
            for (int n = 0; n < 2; ++n) { const int c = 8 * fq + 4 * n; bv[n] = (c < 16) ? *(const f32x4*)(dbf + c) : *(const f32x4*)(dbb + c - 16); }
#pragma unroll
            for (int ai = 0; ai < 2; ++ai)
#pragma unroll
                for (int m = 0; m < 4; ++m) { float* rowp = DT + (size_t)(row0 + ai * HALF + m * 16) * 32 + 8 * fq;
#pragma unroll
                    for (int n = 0; n < 2; ++n) { const f32x4 x = acc[ai][0][m][n] + bv[n]; f32x4 o; o[0] = softplus_f(x[0]); o[1] = softplus_f(x[1]); o[2] = softplus_f(x[2]); o[3] = softplus_f(x[3]);
                        *(f32x4*)(rowp + 4 * n) = o; } }
        }
    }
};
struct EpiOutProj {
    static constexpr bool PERM = true, AFTER_DRAIN = false;
    const float* X; float* OUT; bf16_t* XW; const float* wn; float* SS;
    __device__ __forceinline__ void operator()(const f32x4 (&acc)[2][2][4][2], const Unit& u, int wr, int wc, int fr, int fq) const {
        const int row0 = u.pm * BM + wr * 64 + fr, col0 = u.pn * BM + wc * 32 + 8 * fq;
        f32x4 wv[2][2];
#pragma unroll
        for (int bj = 0; bj < 2; ++bj)
#pragma unroll
            for (int n = 0; n < 2; ++n) wv[bj][n] = *(const f32x4*)(wn + col0 + bj * HALF + 4 * n);
#pragma unroll
        for (int ai = 0; ai < 2; ++ai) {
            f32x4 xr[4][2][2];
#pragma unroll
            for (int m = 0; m < 4; ++m)
#pragma unroll
                for (int bj = 0; bj < 2; ++bj) { const size_t off = (size_t)(row0 + ai * HALF + m * 16) * 1024 + col0 + bj * HALF;
                    xr[m][bj][0] = *(const f32x4*)(X + off); xr[m][bj][1] = *(const f32x4*)(X + off + 4); }
            asm volatile("" ::: "memory");
#pragma unroll
            for (int m = 0; m < 4; ++m) { const int row = row0 + ai * HALF + m * 16; const size_t off = (size_t)row * 1024 + col0; float ss = 0.f;
#pragma unroll
                for (int bj = 0; bj < 2; ++bj) {
                    const f32x4 v0 = acc[ai][bj][m][0] + xr[m][bj][0], v1 = acc[ai][bj][m][1] + xr[m][bj][1];
                    *(f32x4*)(OUT + off + bj * HALF) = v0; *(f32x4*)(OUT + off + bj * HALF + 4) = v1;
                    ss += (v0[0] * v0[0] + v0[1] * v0[1]) + (v0[2] * v0[2] + v0[3] * v0[3]) + (v1[0] * v1[0] + v1[1] * v1[1]) + (v1[2] * v1[2] + v1[3] * v1[3]);
                    const f32x4 y0 = v0 * wv[bj][0], y1 = v1 * wv[bj][1];
                    u32x4 o; o.x = cvt_pk_bf16(y0[0], y0[1]); o.y = cvt_pk_bf16(y0[2], y0[3]); o.z = cvt_pk_bf16(y1[0], y1[1]); o.w = cvt_pk_bf16(y1[2], y1[3]);
                    *(u32x4*)(XW + off + bj * HALF) = o; }
                ss += __shfl_xor(ss, 16); ss += __shfl_xor(ss, 32);
                if (fq == 0) SS[(size_t)row * 16 + 4 * u.pn + wc] = ss; }
            asm volatile("" ::: "memory");
        }
    }
};
struct EpiMlpIn {
    static constexpr bool PERM = true, AFTER_DRAIN = false;
    bf16_t* H; const float* SS;
    __device__ __forceinline__ void operator()(const f32x4 (&acc)[2][2][4][2], const Unit& u, int wr, int wc, int fr, int fq) const {
        const int row0 = u.pm * BM + wr * 64 + fr, col0 = u.pn * BM + wc * 32 + 8 * fq;
        float rs2[2][4];
#pragma unroll
        for (int ai = 0; ai < 2; ++ai) { f32x4 sp[4][4];
#pragma unroll
            for (int m = 0; m < 4; ++m)
#pragma unroll
                for (int k = 0; k < 4; ++k) sp[m][k] = *(const f32x4*)(SS + (size_t)(row0 + ai * HALF + m * 16) * 16 + 4 * k);
#pragma unroll
            for (int m = 0; m < 4; ++m) { const f32x4 st = (sp[m][0] + sp[m][1]) + (sp[m][2] + sp[m][3]); rs2[ai][m] = __builtin_amdgcn_rcpf(((st[0] + st[1]) + (st[2] + st[3])) * (1.0f / 1024.0f) + 1e-5f); } }
        asm volatile("" ::: "memory");
#pragma unroll
        for (int ai = 0; ai < 2; ++ai)
#pragma unroll
            for (int m = 0; m < 4; ++m) { bf16_t* rowp = H + (size_t)(row0 + ai * HALF + m * 16) * 4096 + col0; const float r2 = rs2[ai][m];
#pragma unroll
                for (int bj = 0; bj < 2; ++bj) { f32x4 v0 = acc[ai][bj][m][0], v1 = acc[ai][bj][m][1];
#pragma unroll
                    for (int j = 0; j < 4; ++j) { const float a = fmaxf(v0[j], 0.f), b = fmaxf(v1[j], 0.f); v0[j] = a * a * r2; v1[j] = b * b * r2; }
                    u32x4 o; o.x = cvt_pk_bf16(v0[0], v0[1]); o.y = cvt_pk_bf16(v0[2], v0[3]); o.z = cvt_pk_bf16(v1[0], v1[1]); o.w = cvt_pk_bf16(v1[2], v1[3]);
                    *(u32x4*)(rowp + bj * HALF) = o; } }
    }
};
struct EpiMlpOut {
    static constexpr bool PERM = true, AFTER_DRAIN = false;
    float* OUT; int dry;
    __device__ __forceinline__ void operator()(const f32x4 (&acc)[2][2][4][2], const Unit& u, int wr, int wc, int fr, int fq) const {
        const int row0 = u.pm * BM + wr * 64 + fr, col0 = u.pn * BM + wc * 32 + 8 * fq;
#pragma unroll
        for (int ai = 0; ai < 2; ++ai) {
            f32x4 xr[4][2][2];
#pragma unroll
            for (int m = 0; m < 4; ++m)
#pragma unroll
                for (int bj = 0; bj < 2; ++bj) { const float* rowp = OUT + (size_t)(row0 + ai * HALF + m * 16) * 1024 + col0 + bj * HALF; xr[m][bj][0] = *(const f32x4*)(rowp); xr[m][bj][1] = *(const f32x4*)(rowp + 4); }
            asm volatile("" ::: "memory");
#pragma unroll
            for (int m = 0; m < 4; ++m)
#pragma unroll
                for (int bj = 0; bj < 2; ++bj) { float* rowp = OUT + (size_t)(row0 + ai * HALF + m * 16) * 1024 + col0 + bj * HALF;
                    if (!dry) { *(f32x4*)(rowp) = acc[ai][bj][m][0] + xr[m][bj][0]; *(f32x4*)(rowp + 4) = acc[ai][bj][m][1] + xr[m][bj][1]; } }
            asm volatile("" ::: "memory");
        }
    }
};
}
#ifndef PG8_SP2
#define PG8_SP2 true
#endif
#ifndef PG8_ALIGN
#define PG8_ALIGN true
#endif
#define GAS __attribute__((address_space(1)))
#define LAS __attribute__((address_space(3)))
typedef unsigned short bf16;
typedef unsigned v4u __attribute__((ext_vector_type(4)));
typedef float f32x4 __attribute__((ext_vector_type(4)));
typedef short bf16x8 __attribute__((ext_vector_type(8)));
typedef GAS unsigned gu32;
typedef GAS unsigned long long gu64;
#define RLX_AGENT __ATOMIC_RELAXED, __HIP_MEMORY_SCOPE_AGENT
#define LDS_WAIT() asm volatile("s_waitcnt lgkmcnt(0)" ::: "memory")
#define VM_WAIT() asm volatile("s_waitcnt vmcnt(0)" ::: "memory")
__device__ __forceinline__ unsigned long long rt() { return __builtin_amdgcn_s_memrealtime(); }
__device__ __forceinline__ unsigned f2bf(float f) { unsigned u = __builtin_bit_cast(unsigned, f); return (u + 0x7fffu + ((u >> 16) & 1u)) >> 16; }
typedef float f32x2_hw __attribute__((ext_vector_type(2))); typedef __bf16 bf16x2_hw __attribute__((ext_vector_type(2)));
__device__ __forceinline__ unsigned pk2(float lo, float hi) { const f32x2_hw v = {lo, hi}; const bf16x2_hw b = __builtin_convertvector(v, bf16x2_hw); return __builtin_bit_cast(unsigned, b); }

#define XB_TMO      128
#define XB_XCNT(j)  (256  + 64 * (j))
#define XB_XSUB(j)  (1280 + 64 * (j))
#define XB_XGEN(j)  (2304 + 64 * (j))
#define XB_TOP      3328
#define XB_TOPGEN   3392
#define XCD_BAR_WORDS 3456
#define XB_SPIN_CAP (1u << 18)

__device__ __forceinline__ unsigned xb_ld(unsigned* p)              { return __hip_atomic_load(p, __ATOMIC_RELAXED, __HIP_MEMORY_SCOPE_AGENT); }
__device__ __forceinline__ unsigned xb_add(unsigned* p, unsigned v) { return __hip_atomic_fetch_add(p, v, __ATOMIC_RELAXED, __HIP_MEMORY_SCOPE_AGENT); }
__device__ __forceinline__ unsigned xb_xcc_id() { return (unsigned)__builtin_amdgcn_s_getreg((3 << 11) | 20) & 0xFu; }
#define XB_SPIN(cond, bar) do { unsigned _sp = 0; while (cond) { __builtin_amdgcn_s_sleep(1); \
    if ((++_sp & 255u) == 0u) { if (xb_ld(&(bar)[XB_TMO])) break; if (_sp > XB_SPIN_CAP) { atomicAdd(&(bar)[XB_TMO], 1u); break; } } } } while (0)

struct XcdBarrier {
    unsigned* bar; unsigned x;
    volatile LAS unsigned* st;
};

__device__ __forceinline__ XcdBarrier xcd_barrier_post(unsigned* bar, volatile LAS unsigned* st) {
    XcdBarrier b; b.bar = bar; b.x = xb_xcc_id(); b.st = st;
    if (threadIdx.x == 0) (void)xb_add(&bar[XB_XCNT(b.x)], 1u);
    return b;
}
__device__ __forceinline__ void xcd_barrier_complete(unsigned* bar, unsigned x, unsigned& nloc, unsigned& nx) {
    const unsigned G = gridDim.x * gridDim.y * gridDim.z;
    unsigned sum, cnt, mine, sp = 0u;
    for (;;) {
        sum = 0u; cnt = 0u; mine = 0u;
#pragma unroll
        for (unsigned j = 0; j < 16; ++j) { const unsigned c = xb_ld(&bar[XB_XCNT(j)]); sum += c; cnt += (c > 0u) ? 1u : 0u; mine = (j == x) ? c : mine; }
        if (sum == G) break;
        __builtin_amdgcn_s_sleep(1);
        if ((++sp & 255u) == 0u) { if (xb_ld(&bar[XB_TMO])) break; if (sp > XB_SPIN_CAP) { atomicAdd(&bar[XB_TMO], 1u); break; } }
    }
    nloc = mine > 0u ? mine : 1u; nx = cnt > 0u ? cnt : 1u;
}

__device__ __forceinline__ void xcd_barrier(const XcdBarrier& b) {
    asm volatile("s_waitcnt vmcnt(0)" ::: "memory");
    __syncthreads();
    if (threadIdx.x == 0) {
        unsigned* bar = b.bar;
        __builtin_amdgcn_s_waitcnt(0);
        unsigned nloc = b.st[0], nx = b.st[1];
        if (nloc == 0u) { xcd_barrier_complete(bar, b.x, nloc, nx); b.st[0] = nloc; b.st[1] = nx; }
        const unsigned old = xb_add(&bar[XB_XSUB(b.x)], 1u);
        const unsigned gen = old / nloc;
        if (old + 1u == (gen + 1u) * nloc) {
            __builtin_amdgcn_fence(__ATOMIC_RELEASE, "agent");
            asm volatile("s_waitcnt vmcnt(0)" ::: "memory");
            const unsigned og = xb_add(&bar[XB_TOP], 1u);
            const unsigned tg = og / nx;
            if (og + 1u == (tg + 1u) * nx) xb_add(&bar[XB_TOPGEN], 1u);
            else XB_SPIN(xb_ld(&bar[XB_TOPGEN]) == tg, bar);
            __builtin_amdgcn_fence(__ATOMIC_ACQUIRE, "agent");
            xb_add(&bar[XB_XGEN(b.x)], 1u);
            asm volatile("s_waitcnt vmcnt(0)" ::: "memory");
        } else {
            XB_SPIN(xb_ld(&bar[XB_XGEN(b.x)]) == gen, bar);
            __builtin_amdgcn_fence(__ATOMIC_ACQUIRE, "agent");
            asm volatile("s_waitcnt vmcnt(0)" ::: "memory");
        }
    }
    __syncthreads();
}

constexpr int NWAVES = 8;
#ifndef MK_N_LAUNCHES
#define MK_N_LAUNCHES 1
#endif
constexpr int PER_PHASE = 8;
constexpr int N_LAUNCHES = MK_N_LAUNCHES;

constexpr int BATCH = 2, T = 8192, D = 1024, M = BATCH * T, FF = 4096;
constexpr int NH = 16, HD = 64, NGRP = 2, HPG = 8, NST = 128, CONVD = 1536, CH = 128, NCH = T / CH;
constexpr int GW = 64, GROWS = T / GW, KH = 8, KW = 16;
constexpr int PROJ = 5664, NPROJ = 5888, NMAIN = 4864;
constexpr float EPS = 1e-5f;

constexpr size_t MiB = 1u << 20;
constexpr size_t WS_CTL = 0, CTL_ZERO_BYTES = 65536;
constexpr size_t WS_WIN = 1 * MiB;
constexpr size_t WS_XN = 13 * MiB;
static_assert(WS_XN - WS_WIN == 24u * 256u * 1024u * 2u, "P1Order: XN must start 24 row panels above the weight copy");
constexpr size_t WS_SF = 1 * MiB;
constexpr size_t WS_SB = 33 * MiB;
constexpr size_t WS_ZQ = 65 * MiB;
constexpr size_t WS_XBC = 129 * MiB;
constexpr size_t WS_K = 177 * MiB;
constexpr size_t WS_V = 209 * MiB;
constexpr size_t WS_DT = 241 * MiB;
constexpr size_t WS_DEC = 255 * MiB;
constexpr size_t WS_WOUT = 243 * MiB;
constexpr size_t WS_W1 = 247 * MiB;
constexpr size_t WS_W2 = 189 * MiB;
constexpr size_t WS_XW = 1 * MiB;
constexpr size_t WS_SS = 33 * MiB;
constexpr size_t WS_H = 40 * MiB;
constexpr size_t WS_END = 256 * MiB;
constexpr size_t SC_XST = 0, SC_BN = 32 * MiB, SC_CN = 40 * MiB;
constexpr int CW_TMO = 0, CW_CODE = 1, CW_BAR = 4096;

constexpr int RING_OFF = 0, RING_BYTES = 131072;
constexpr int LDS_BYTES = 163840;
constexpr int LDSCTL_OFF = LDS_BYTES - 512, MISC_OFF = LDSCTL_OFF + 320;
static_assert(MISC_OFF + 128 <= LDS_BYTES, "LDS map");

struct Frame {
    LAS unsigned char* lds;
    volatile LAS unsigned* MISC;
    gu32* ctl;
    int tid, lane, wave;
    int vcu, G;
    const float* in[18]; float* out; unsigned char* ws;
};
#define PL_SWAP(W, m) unsigned a_ = __builtin_bit_cast(unsigned, m), b_ = a_; asm volatile("" : "+v"(b_)); const auto r_ = __builtin_amdgcn_permlane##W##_swap(a_, b_, false, false); \
    unsigned r0_ = r_[0], r1_ = r_[1]; asm volatile("" : "+v"(r0_), "+v"(r1_)); const float x0_ = __builtin_bit_cast(float, r0_), x1_ = __builtin_bit_cast(float, r1_)
__device__ __forceinline__ float red16_max(float m) { PL_SWAP(16, m); return fmaxf(x0_, x1_); }
__device__ __forceinline__ float red32_max(float m) { PL_SWAP(32, m); return fmaxf(x0_, x1_); }
__device__ __forceinline__ float red16_add(float m) { PL_SWAP(16, m); return x0_ + x1_; }
__device__ __forceinline__ float red32_add(float m) { PL_SWAP(32, m); return x0_ + x1_; }
__device__ __forceinline__ float bf2f(bf16 v) { return __builtin_bit_cast(float, (unsigned)v << 16); }
__device__ __forceinline__ float wave_sum(float v) {
#pragma unroll
    for (int o = 1; o < 64; o <<= 1) v += __shfl_xor(v, o);
    return v;
}
__device__ __forceinline__ float silu_f(float x) { return x * __builtin_amdgcn_rcpf(1.0f + __expf(-x)); }

__device__ __forceinline__ void p0_transpose_item(const float* W, int K, int N, bf16* WT, int kb, int src0, int dst0, LAS float* scr, int lane) {
    const int k0 = 64 * kb;
    if (src0 >= 0) {
#pragma unroll 8
        for (int i = 0; i < 32; ++i) { const int kk = 2 * i + (lane >> 5); scr[kk * 33 + (lane & 31)] = W[(size_t)(k0 + kk) * N + src0 + (lane & 31)]; }
    } else {
#pragma unroll 8
        for (int i = 0; i < 32; ++i) { const int kk = 2 * i + (lane >> 5); scr[kk * 33 + (lane & 31)] = 0.f; }
    }
    LDS_WAIT(); asm volatile("" ::: "memory");
    const int c = lane & 7;
#pragma unroll
    for (int j = 0; j < 4; ++j) { const int n = (lane >> 3) + 8 * j; const LAS float* s = scr + (8 * c) * 33 + n;
        v4u o; o.x = pk2(s[0 * 33], s[1 * 33]); o.y = pk2(s[2 * 33], s[3 * 33]); o.z = pk2(s[4 * 33], s[5 * 33]); o.w = pk2(s[6 * 33], s[7 * 33]);
        *(GAS v4u*)(WT + (size_t)(dst0 + n) * K + k0 + 8 * c) = o; }
    LDS_WAIT(); asm volatile("" ::: "memory");
}
__device__ __forceinline__ int inproj_src(int nb) {
    const int gc = 32 * nb;
    if (gc < 2560) return gc;
    if (gc < 4608) { const int r = gc - 2560, sel = r >> 10, rr = r & 1023, t = rr >> 8, c = rr & 255, bj = c >> 7, wc = (c >> 5) & 3;
        return 2592 + 1024 * sel + 64 * (4 * t + wc) + 32 * bj; }
    if (gc < 4640) return 2560;
    if (gc < 4864) return -1;
    return 4640 + (gc - 4864);
}
__device__ __forceinline__ void rms_row_to_bf16(int lane, const float* xrow, const float* w, bf16* orow) {
    const GAS f32x4* xr = (const GAS f32x4*)xrow + lane; const GAS f32x4* wr = (const GAS f32x4*)w + lane;
    f32x4 v[4]; float s = 0.f;
#pragma unroll
    for (int j = 0; j < 4; ++j) { v[j] = xr[64 * j]; s += (v[j].x * v[j].x + v[j].y * v[j].y) + (v[j].z * v[j].z + v[j].w * v[j].w); }
    const float rstd = 1.f / sqrtf(wave_sum(s) * (1.f / D) + EPS);
    GAS unsigned long long* o8 = (GAS unsigned long long*)orow + lane;
#pragma unroll
    for (int j = 0; j < 4; ++j) { const f32x4 ww = wr[64 * j];
        o8[64 * j] = (unsigned long long)pk2(v[j].x * rstd * ww.x, v[j].y * rstd * ww.y) | ((unsigned long long)pk2(v[j].z * rstd * ww.z, v[j].w * rstd * ww.w) << 32); }
}
__device__ __forceinline__ void p0_prologue(Frame& F) {
    LAS float* scr = (LAS float*)(F.lds + RING_OFF + F.wave * 16384);
    const int gw = F.vcu * NWAVES + F.wave, NGW = F.G * NWAVES;
    bf16* WinT = (bf16*)(F.ws + WS_WIN);
    constexpr int NITEMS = (D / 64) * (NPROJ / 32);
    for (int it = gw; it < NITEMS; it += NGW) { const int kb = it / (NPROJ / 32), nb = it % (NPROJ / 32);
        p0_transpose_item(F.in[2], D, PROJ, WinT, kb, inproj_src(nb), 32 * nb, scr, F.lane); }
    bf16* XN = (bf16*)(F.ws + WS_XN);
    for (int m = gw; m < M; m += NGW) rms_row_to_bf16(F.lane, F.in[0] + (size_t)m * D, F.in[1], XN + (size_t)m * D);
}
constexpr int WL_IO = (2048 / 64) * (1024 / 32), WL_I1 = (1024 / 64) * (4096 / 32), WL_I2 = (4096 / 64) * (1024 / 32);
__device__ __forceinline__ int skew_n(int G) { return (G >> 4) * 8 + ((G & 15) > 8 ? (G & 15) - 8 : 0); }
__device__ __forceinline__ bool skew_on(int G) { return skew_n(G) >= 32; }
__device__ __forceinline__ void p_weights_late(Frame& F, int lo, int hi, int rank, int nworkers) {
    LAS float* scr = (LAS float*)(F.lds + RING_OFF + F.wave * 16384);
    const int gw = rank * NWAVES + F.wave, NGW = nworkers * NWAVES;
    constexpr int I_O = WL_IO, I_1 = WL_I1;
    for (int it = lo + gw; it < hi; it += NGW) {
        int r = it;
        if (r < I_O) { p0_transpose_item(F.in[14], 2048, 1024, (bf16*)(F.ws + WS_WOUT), r / 32, 32 * (r % 32), 32 * (r % 32), scr, F.lane); continue; } r -= I_O;
        if (r < I_1) { p0_transpose_item(F.in[16], 1024, 4096, (bf16*)(F.ws + WS_W1), r / 128, 32 * (r % 128), 32 * (r % 128), scr, F.lane); continue; } r -= I_1;
        p0_transpose_item(F.in[17], 4096, 1024, (bf16*)(F.ws + WS_W2), r / 32, 32 * (r % 32), 32 * (r % 32), scr, F.lane);
    }
}

__device__ __forceinline__ void ssd_scan(Frame& F, const int dry) {
    const float* DEC = (const float*)(F.ws + WS_DEC);
    for (int gid = F.vcu * 512 + F.tid; gid < 2 * BATCH * NH * 2048; gid += F.G * 512) {
        const int dir = gid >> 16, rem = gid & 65535, b = rem >> 15, h = (rem >> 11) & 15, e4 = rem & 2047;
        unsigned long long* S = (unsigned long long*)(F.ws + (dir ? WS_SB : WS_SF)) + e4;
        const float* dec = DEC + dir * (BATCH * NCH * NH);
        float h0 = 0.f, h1 = 0.f, h2 = 0.f, h3 = 0.f;
        unsigned long long va[16], vb[16]; float da[16], db[16];
#define SCAN_ITEM(cc) ((b * NCH + (dir ? NCH - 1 - (cc) : (cc))) * NH + h)
#define SCAN_LOAD(V, Dv, bt) do { _Pragma("unroll") for (int i = 0; i < 16; ++i) { const int it_ = SCAN_ITEM(16 * (bt) + i); V[i] = S[(size_t)it_ * 2048]; Dv[i] = dec[it_]; } } while (0)
#define SCAN_PROC(V, Dv, bt) do { _Pragma("unroll") for (int i = 0; i < 16; ++i) { const int it_ = SCAN_ITEM(16 * (bt) + i); const unsigned long long v = V[i]; const float d = Dv[i]; \
            if (!dry) S[(size_t)it_ * 2048] = (unsigned long long)pk2(h0, h1) | ((unsigned long long)pk2(h2, h3) << 32); \
            h0 = d * h0 + __builtin_bit_cast(float, (unsigned)v << 16); h1 = d * h1 + __builtin_bit_cast(float, (unsigned)v & 0xffff0000u); \
            h2 = d * h2 + __builtin_bit_cast(float, (unsigned)(v >> 32) << 16); h3 = d * h3 + __builtin_bit_cast(float, (unsigned)(v >> 32) & 0xffff0000u); } } while (0)
        SCAN_LOAD(va, da, 0);
        SCAN_LOAD(vb, db, 1); SCAN_PROC(va, da, 0);
        SCAN_LOAD(va, da, 2); SCAN_PROC(vb, db, 1);
        SCAN_LOAD(vb, db, 3); SCAN_PROC(va, da, 2);
        SCAN_PROC(vb, db, 3);
#undef SCAN_ITEM
#undef SCAN_LOAD
#undef SCAN_PROC
    }
}

typedef float f32x16 __attribute__((ext_vector_type(16)));
typedef unsigned u32x2v __attribute__((ext_vector_type(2)));
constexpr int V_ACF = 0, V_RCB = 128, V_DTF = 256, V_DTB = 384, V_CFF = 512, V_CFB = 640, V_EF = 768, V_EB = 896;
__device__ __forceinline__ float bflo(unsigned u) { return __builtin_bit_cast(float, u << 16); }
__device__ __forceinline__ float bfhi(unsigned u) { return __builtin_bit_cast(float, u & 0xffff0000u); }
__device__ __forceinline__ void ssd_out_mfma(Frame& F, const int dry) {
    LAS unsigned char* CBs = F.lds;
    LAS unsigned char* Cs = F.lds + 16384;
    LAS float* vecs = (LAS float*)(F.lds + 32768) + F.wave * 1024;
    LAS float* rowss = (LAS float*)(F.lds + 69632);
    LAS float* rstdv = rowss + 512;
    bf16* ZQ = (bf16*)(F.ws + WS_ZQ); const float* DT = (const float*)(F.ws + WS_DT);
    const bf16* SF = (const bf16*)(F.ws + WS_SF); const bf16* SB = (const bf16*)(F.ws + WS_SB);
    const bf16* XST = (const bf16*)((const unsigned char*)F.out + SC_XST); const bf16* BN = (const bf16*)((const unsigned char*)F.out + SC_BN); const bf16* CN = (const bf16*)((const unsigned char*)F.out + SC_CN);
    const int w = F.wave;
    for (int item = F.vcu; item < BATCH * NCH * NGRP * 2; item += F.G) {
        int lane = F.lane; asm volatile("" : "+v"(lane));
        const int r = lane & 31, hp = lane >> 5;
        const int half = item & 1, g = (item >> 1) & 1, bc = item >> 2, m0 = bc * CH, h = HPG * g + w, L0 = 64 * half;
        const bf16* xst = XST + (size_t)(bc * NH + h) * (HD * CH);
        const size_t sbase = (size_t)(bc * NH + h) * (HD * NST);
        bf16x8 xsf[2][8], bfr[8];
        { const bf16* bn = BN + ((size_t)(bc * NGRP + g) * CH + 32 * (w & 3) + r) * NST + 8 * hp;
#pragma unroll
          for (int ks = 0; ks < 8; ++ks) bfr[ks] = *(const bf16x8*)(bn + 16 * ks);
#pragma unroll
          for (int pt = 0; pt < 2; ++pt)
#pragma unroll
              for (int ks = 0; ks < 8; ++ks) xsf[pt][ks] = *(const bf16x8*)(xst + (size_t)(32 * pt + r) * CH + 16 * ks + 8 * hp); }
        { const int row = F.tid >> 3, ch2 = 2 * (F.tid & 7); const v4u* src = (const v4u*)(CN + ((size_t)(bc * NGRP + g) * CH + L0 + row) * NST + 8 * ch2);
          const v4u a = src[0], b2 = src[1];
          *(LAS v4u*)(Cs + row * 256 + ((ch2 ^ (row & 15)) << 4)) = a; *(LAS v4u*)(Cs + row * 256 + (((ch2 + 1) ^ (row & 15)) << 4)) = b2; }
        {
            const float Af = -__expf(F.in[7][h]), Ab = -__expf(F.in[8][h]);
            const int l0 = 2 * lane;
            const float df0 = DT[(size_t)(m0 + l0) * 32 + h], df1 = DT[(size_t)(m0 + l0 + 1) * 32 + h], db0 = DT[(size_t)(m0 + l0) * 32 + 16 + h], db1 = DT[(size_t)(m0 + l0 + 1) * 32 + 16 + h];
            const float a0 = df0 * Af, a1 = df1 * Af, b0 = db0 * Ab, b1 = db1 * Ab;
            float x = a0 + a1, y = b0 + b1;
#pragma unroll
            for (int off = 1; off < 64; off <<= 1) { const float t = __shfl_up(x, off), u = __shfl_down(y, off); if (lane >= off) x += t; if (lane + off < 64) y += u; }
            const float acf0 = x - a1, acf1 = x, rcb0 = y, rcb1 = y - b0;
            vecs[V_ACF + l0] = acf0; vecs[V_ACF + l0 + 1] = acf1; vecs[V_RCB + l0] = rcb0; vecs[V_RCB + l0 + 1] = rcb1;
            vecs[V_DTF + l0] = df0; vecs[V_DTF + l0 + 1] = df1; vecs[V_DTB + l0] = db0; vecs[V_DTB + l0 + 1] = db1;
            vecs[V_EF + l0] = __expf(acf0); vecs[V_EF + l0 + 1] = __expf(acf1); vecs[V_EB + l0] = __expf(rcb0); vecs[V_EB + l0 + 1] = __expf(rcb1);
            LDS_WAIT(); asm volatile("" ::: "memory");
            const int kb = l0 >> 4; const float Rf = vecs[V_ACF + 16 * kb + 15], Rb = vecs[V_RCB + 16 * kb];
            vecs[V_CFF + l0] = __expf(Rf - acf0) * df0; vecs[V_CFF + l0 + 1] = __expf(Rf - acf1) * df1;
            vecs[V_CFB + l0] = __expf(Rb - rcb0) * db0; vecs[V_CFB + l0 + 1] = __expf(Rb - rcb1) * db1;
        }
        {
            const int lt = w >> 2, st = w & 3, crow = 32 * lt + r;
            __syncthreads();
            f32x16 c = {};
#pragma unroll
            for (int ks = 0; ks < 8; ++ks) { const bf16x8 a = *(const LAS bf16x8*)(Cs + crow * 256 + (((2 * ks + hp) ^ (crow & 15)) << 4)); c = __builtin_amdgcn_mfma_f32_32x32x16_bf16(a, bfr[ks], c, 0, 0, 0); }
            const int s = 32 * st + r;
#pragma unroll
            for (int reg = 0; reg < 16; ++reg) { const int l = 32 * lt + (reg & 3) + 8 * (reg >> 2) + 4 * hp;
                *(LAS bf16*)(CBs + l * 256 + ((((s >> 3) ^ (l & 15))) << 4) + (s & 7) * 2) = (bf16)pk2(c[reg], 0.f); }
        }
        __syncthreads();
        f32x16 acc[2][2];
#pragma unroll
        for (int a = 0; a < 2; ++a)
#pragma unroll
            for (int b = 0; b < 2; ++b) acc[a][b] = (f32x16){};
        bf16x8 hbA[8], hbB[8];
#define SSD_HLOAD(HB, dir, pt) do { const bf16* hrow_ = ((dir) ? SB : SF) + sbase + (size_t)(32 * (pt) + r) * NST + 8 * hp; \
            _Pragma("unroll") for (int ks = 0; ks < 8; ++ks) HB[ks] = *(const bf16x8*)(hrow_ + 16 * ks); } while (0)
        SSD_HLOAD(hbA, 0, 0);
        __builtin_amdgcn_sched_barrier(0);
        {
            float acl[2], rcl[2];
#pragma unroll
            for (int lt = 0; lt < 2; ++lt) { acl[lt] = vecs[V_ACF + L0 + 32 * lt + r]; rcl[lt] = vecs[V_RCB + L0 + 32 * lt + r]; }
#pragma unroll
            for (int ks = 0; ks < 8; ++ks) {
                const int s0 = 16 * ks + 8 * hp;
#pragma unroll
                for (int lt = 0; lt < 2; ++lt) {
                    const int lrow = 32 * lt + r, l = L0 + lrow, kd = 4 * half + 2 * lt;
                    const v4u cbv = *(const LAS v4u*)(CBs + lrow * 256 + (((2 * ks + hp) ^ (lrow & 15)) << 4));
                    float gv[8];
#pragma unroll
                    for (int e = 0; e < 4; ++e) { gv[2 * e] = bflo(cbv[e]); gv[2 * e + 1] = bfhi(cbv[e]); }
                    if (ks < kd) {
                        const float rf = __expf(acl[lt] - vecs[V_ACF + 16 * ks + 15]);
                        const f32x4 c0 = *(const LAS f32x4*)(vecs + V_CFF + s0), c1 = *(const LAS f32x4*)(vecs + V_CFF + s0 + 4);
#pragma unroll
                        for (int j = 0; j < 4; ++j) { gv[j] *= c0[j] * rf; gv[4 + j] *= c1[j] * rf; }
                    } else if (ks > kd + 1) {
                        const float rb = __expf(rcl[lt] - vecs[V_RCB + 16 * ks]);
                        const f32x4 c0 = *(const LAS f32x4*)(vecs + V_CFB + s0), c1 = *(const LAS f32x4*)(vecs + V_CFB + s0 + 4);
#pragma unroll
                        for (int j = 0; j < 4; ++j) { gv[j] *= c0[j] * rb; gv[4 + j] *= c1[j] * rb; }
                    } else {
#pragma unroll
                        for (int q = 0; q < 2; ++q) {
                            const f32x4 af = *(const LAS f32x4*)(vecs + V_ACF + s0 + 4 * q), rb = *(const LAS f32x4*)(vecs + V_RCB + s0 + 4 * q);
                            const f32x4 df = *(const LAS f32x4*)(vecs + V_DTF + s0 + 4 * q), db = *(const LAS f32x4*)(vecs + V_DTB + s0 + 4 * q);
#pragma unroll
                            for (int j = 0; j < 4; ++j) { const int s = s0 + 4 * q + j;
                                const float tf = __expf(fminf(acl[lt] - af[j], 0.f)) * df[j], tb = __expf(fminf(rcl[lt] - rb[j], 0.f)) * db[j];
                                const float mm = (l >= s ? tf : 0.f) + (l <= s ? tb : 0.f);
                                gv[4 * q + j] *= mm; }
                        }
                    }
                    v4u gp; gp.x = pk2(gv[0], gv[1]); gp.y = pk2(gv[2], gv[3]); gp.z = pk2(gv[4], gv[5]); gp.w = pk2(gv[6], gv[7]);
                    const bf16x8 ga = __builtin_bit_cast(bf16x8, gp);
#pragma unroll
                    for (int pt = 0; pt < 2; ++pt) acc[lt][pt] = __builtin_amdgcn_mfma_f32_32x32x16_bf16(ga, xsf[pt][ks], acc[lt][pt], 0, 0, 0);
                }
            }
        }
        __builtin_amdgcn_sched_barrier(0);
        SSD_HLOAD(hbB, 0, 1);
        __builtin_amdgcn_sched_barrier(0);
        {
#define SSD_YOFF(HB, dir, pt) do { f32x16 t0 = {}, t1 = {}; \
            _Pragma("unroll") for (int ks = 0; ks < 8; ++ks) { \
                const bf16x8 c0 = *(const LAS bf16x8*)(Cs + r * 256 + (((2 * ks + hp) ^ (r & 15)) << 4)), c1 = *(const LAS bf16x8*)(Cs + (32 + r) * 256 + (((2 * ks + hp) ^ (r & 15)) << 4)); \
                t0 = __builtin_amdgcn_mfma_f32_32x32x16_bf16(c0, HB[ks], t0, 0, 0, 0); t1 = __builtin_amdgcn_mfma_f32_32x32x16_bf16(c1, HB[ks], t1, 0, 0, 0); } \
            _Pragma("unroll") for (int q = 0; q < 4; ++q) { \
                const f32x4 e0 = *(const LAS f32x4*)(vecs + ((dir) ? V_EB : V_EF) + L0 + 8 * q + 4 * hp), e1 = *(const LAS f32x4*)(vecs + ((dir) ? V_EB : V_EF) + L0 + 32 + 8 * q + 4 * hp); \
                _Pragma("unroll") for (int i = 0; i < 4; ++i) { acc[0][pt][4 * q + i] += e0[i] * t0[4 * q + i]; acc[1][pt][4 * q + i] += e1[i] * t1[4 * q + i]; } } \
            asm volatile("" : "+v"(acc[0][pt]), "+v"(acc[1][pt])); __builtin_amdgcn_sched_barrier(0); } while (0)
            SSD_YOFF(hbA, 0, 0); SSD_HLOAD(hbA, 1, 0); __builtin_amdgcn_sched_barrier(0);
            SSD_YOFF(hbB, 0, 1); SSD_HLOAD(hbB, 1, 1); __builtin_amdgcn_sched_barrier(0);
            SSD_YOFF(hbA, 1, 0);
            SSD_YOFF(hbB, 1, 1);
#undef SSD_YOFF
#undef SSD_HLOAD
            const float Dh = F.in[9][h];
#pragma unroll
            for (int lt = 0; lt < 2; ++lt)
#pragma unroll
                for (int pt = 0; pt < 2; ++pt)
#pragma unroll
                    for (int q = 0; q < 4; ++q) { const u32x2v xv = *(const u32x2v*)(xst + (size_t)(32 * pt + r) * CH + L0 + 32 * lt + 8 * q + 4 * hp);
                        acc[lt][pt][4 * q] += Dh * bflo(xv.x); acc[lt][pt][4 * q + 1] += Dh * bfhi(xv.x); acc[lt][pt][4 * q + 2] += Dh * bflo(xv.y); acc[lt][pt][4 * q + 3] += Dh * bfhi(xv.y); }
        }
        {
            __syncthreads();
            LAS float* stg = (LAS float*)(F.lds) + w * (32 * 68);
            const int row = lane >> 1, pc = (lane & 1) * 32;
            float gt[2][32];
#pragma unroll
            for (int lt = 0; lt < 2; ++lt) {
#pragma unroll
                for (int reg = 0; reg < 16; ++reg) { const int rr = (reg & 3) + 8 * (reg >> 2) + 4 * hp; stg[rr * 68 + r] = acc[lt][0][reg]; stg[rr * 68 + 32 + r] = acc[lt][1][reg]; }
                LDS_WAIT(); asm volatile("" ::: "memory");
                const bf16* zr = ZQ + (size_t)(m0 + L0 + 32 * lt + row) * 2048 + h * HD + pc;
                float ss = 0.f;
#pragma unroll
                for (int c = 0; c < 4; ++c) { const v4u zv = *(const v4u*)(zr + 8 * c); const f32x4 y0 = *(const LAS f32x4*)(stg + row * 68 + pc + 8 * c), y1 = *(const LAS f32x4*)(stg + row * 68 + pc + 8 * c + 4);
#pragma unroll
                    for (int e = 0; e < 4; ++e) { const float ya = e < 2 ? y0[2 * e] : y1[2 * e - 4], yb = e < 2 ? y0[2 * e + 1] : y1[2 * e - 3];
                        const float ga = ya * silu_f(bflo(zv[e])), gb = yb * silu_f(bfhi(zv[e])); gt[lt][8 * c + 2 * e] = ga; gt[lt][8 * c + 2 * e + 1] = gb; ss += ga * ga + gb * gb; } }
                ss += __shfl_xor(ss, 1);
                if ((lane & 1) == 0) rowss[(32 * lt + row) * 8 + w] = ss;
                LDS_WAIT(); asm volatile("" ::: "memory");
            }
            __syncthreads();
            if (F.tid < 64) { const f32x4 a = *(const LAS f32x4*)(rowss + F.tid * 8), b = *(const LAS f32x4*)(rowss + F.tid * 8 + 4);
                rstdv[F.tid] = 1.0f / sqrtf(((a[0] + a[1]) + (a[2] + a[3]) + (b[0] + b[1]) + (b[2] + b[3])) * (1.0f / 512.0f) + EPS); }
            __syncthreads();
            const float* nwp = F.in[10] + h * HD + pc;
#pragma unroll
            for (int lt = 0; lt < 2; ++lt) { const float rs = rstdv[32 * lt + row]; bf16* zo = ZQ + (size_t)(m0 + L0 + 32 * lt + row) * 2048 + h * HD + pc;
#pragma unroll
                for (int c = 0; c < 4; ++c) { const f32x4 w0 = *(const f32x4*)(nwp + 8 * c), w1 = *(const f32x4*)(nwp + 8 * c + 4); v4u o;
                    o.x = pk2(gt[lt][8 * c] * rs * w0[0], gt[lt][8 * c + 1] * rs * w0[1]); o.y = pk2(gt[lt][8 * c + 2] * rs * w0[2], gt[lt][8 * c + 3] * rs * w0[3]);
                    o.z = pk2(gt[lt][8 * c + 4] * rs * w1[0], gt[lt][8 * c + 5] * rs * w1[1]); o.w = pk2(gt[lt][8 * c + 6] * rs * w1[2], gt[lt][8 * c + 7] * rs * w1[3]);
                    if (!dry) *(v4u*)(zo + 8 * c) = o; } }
        }
        __syncthreads();
    }
}


__device__ __forceinline__ void ssd_states_mfma(Frame& F) {
    LAS unsigned char* BT = F.lds;
    LAS unsigned char* XT = F.lds + 32768;
    LAS float* wv = (LAS float*)(F.lds + 98304) + F.wave * 128;
    const bf16* XBC = (const bf16*)(F.ws + WS_XBC); const float* DT = (const float*)(F.ws + WS_DT);
    const float* cw = F.in[3]; const float* cbias = F.in[4];
    bf16* XST = (bf16*)((unsigned char*)F.out + SC_XST); bf16* BN = (bf16*)((unsigned char*)F.out + SC_BN); bf16* CN = (bf16*)((unsigned char*)F.out + SC_CN);
    float* DEC = (float*)(F.ws + WS_DEC);
    const int w = F.wave;
    for (int item = F.vcu; item < BATCH * NCH * NGRP * 2; item += F.G) {
        const int quad = item & 1, g = (item >> 1) & 1, bc = item >> 2, m0 = bc * CH, tbase = m0 & (T - 1);
        __syncthreads();
        int lane = F.lane; asm volatile("" : "+v"(lane));
        const int r = lane & 31, hp = lane >> 5, hq = w >> 1, dir = w & 1, h = HPG * g + 4 * quad + hq;
        const float Adec = -__expf((dir ? F.in[8] : F.in[7])[h]);
        const float d0 = DT[(size_t)(m0 + 2 * lane) * 32 + 16 * dir + h], d1 = DT[(size_t)(m0 + 2 * lane + 1) * 32 + 16 * dir + h];
        {
            int tid = F.tid; asm volatile("" : "+v"(tid));
            const int rb = tid & 7, cgi = tid >> 3;
            const int kind = cgi < 16 ? 0 : (cgi < 48 ? 1 : 2);
            const int ch0 = kind == 0 ? 1024 + NST * g + 8 * cgi : (kind == 1 ? HD * (HPG * g + 4 * quad) + 8 * (cgi - 16) : 1280 + NST * g + 8 * (cgi - 48));
            if (kind != 2 || quad == 0) {
                v4u in[20];
#pragma unroll
                for (int i = 0; i < 20; ++i) { const int t = tbase + 16 * rb - 2 + i; v4u z = {0u, 0u, 0u, 0u};
                    in[i] = (t >= 0 && t < T) ? *(const v4u*)(XBC + (size_t)(m0 + 16 * rb - 2 + i) * CONVD + ch0) : z; }
                f32x4 wk[5][2], bb[2];
#pragma unroll
                for (int k = 0; k < 5; ++k) { wk[k][0] = *(const f32x4*)(cw + k * CONVD + ch0); wk[k][1] = *(const f32x4*)(cw + k * CONVD + ch0 + 4); }
                bb[0] = *(const f32x4*)(cbias + ch0); bb[1] = *(const f32x4*)(cbias + ch0 + 4);
#pragma unroll
                for (int hf = 0; hf < 2; ++hf) {
                    const int lr0 = 16 * rb + 8 * hf;
                    unsigned tp[8][4];
                    f32x4 prev[2];
#pragma unroll
                    for (int o = 0; o < 8; ++o) {
                        f32x4 y0 = bb[0], y1 = bb[1];
#pragma unroll
                        for (int k = 0; k < 5; ++k) { const v4u xv = in[8 * hf + o + k];
                            const f32x4 x0 = {bflo(xv.x), bfhi(xv.x), bflo(xv.y), bfhi(xv.y)}, x1 = {bflo(xv.z), bfhi(xv.z), bflo(xv.w), bfhi(xv.w)};
                            y0 += wk[k][0] * x0; y1 += wk[k][1] * x1; }
#pragma unroll
                        for (int e = 0; e < 4; ++e) { y0[e] = silu_f(y0[e]); y1[e] = silu_f(y1[e]); }
                        if (kind != 1 && quad == 0) {
                            v4u o4; o4.x = pk2(y0[0], y0[1]); o4.y = pk2(y0[2], y0[3]); o4.z = pk2(y1[0], y1[1]); o4.w = pk2(y1[2], y1[3]);
                            bf16* dst = (kind == 0 ? BN : CN) + ((size_t)(bc * NGRP + g) * CH + lr0 + o) * NST + 8 * (kind == 0 ? cgi : cgi - 48);
                            *(v4u*)dst = o4; }
                        if (o & 1) {
#pragma unroll
                            for (int e = 0; e < 4; ++e) { tp[e][o >> 1] = pk2(prev[0][e], y0[e]); tp[4 + e][o >> 1] = pk2(prev[1][e], y1[e]); }
                        } else { prev[0] = y0; prev[1] = y1; }
                    }
                    const int chunk = 2 * rb + hf;
                    if (kind == 0) {
#pragma unroll
                        for (int c = 0; c < 8; ++c) { const int n = 8 * cgi + c; v4u v = {tp[c][0], tp[c][1], tp[c][2], tp[c][3]}; *(LAS v4u*)(BT + n * 256 + ((chunk ^ (n & 15)) << 4)) = v; }
                    } else if (kind == 1) {
#pragma unroll
                        for (int c = 0; c < 8; ++c) { const int pp = 8 * (cgi - 16) + c; v4u v = {tp[c][0], tp[c][1], tp[c][2], tp[c][3]}; *(LAS v4u*)(XT + pp * 256 + ((chunk ^ (pp & 15)) << 4)) = v;
                            *(v4u*)(XST + ((size_t)(bc * NH + HPG * g + 4 * quad) * HD + pp) * CH + lr0) = v; }
                    }
                }
            }
        }
        float total;
        {
            const int l0 = 2 * lane; const float a0 = d0 * Adec, a1 = d1 * Adec;
            float x = a0 + a1, y = x;
#pragma unroll
            for (int off = 1; off < 64; off <<= 1) { const float t = __shfl_up(x, off), u = __shfl_down(y, off); if (lane >= off) x += t; if (lane + off < 64) y += u; }
            total = __shfl(x, 63);
            const float e0 = dir ? y : x - a1, e1 = dir ? y - a0 : x;
            wv[l0] = d0 * __expf(total - e0); wv[l0 + 1] = d1 * __expf(total - e1);
        }
        __syncthreads();
        f32x16 acc[4][2];
#pragma unroll
        for (int a = 0; a < 4; ++a)
#pragma unroll
            for (int b = 0; b < 2; ++b) acc[a][b] = (f32x16){};
#pragma unroll 2
        for (int ks = 0; ks < 8; ++ks) {
            const int chunk = 2 * ks + hp;
            bf16x8 af[4], bfr[2];
#pragma unroll
            for (int nt = 0; nt < 4; ++nt) { const int n = 32 * nt + r; af[nt] = *(const LAS bf16x8*)(BT + n * 256 + ((chunk ^ (n & 15)) << 4)); }
            const f32x4 w0 = *(const LAS f32x4*)(wv + 16 * ks + 8 * hp), w1 = *(const LAS f32x4*)(wv + 16 * ks + 8 * hp + 4);
#pragma unroll
            for (int pt = 0; pt < 2; ++pt) { const int pp = 64 * hq + 32 * pt + r; const v4u xv = *(const LAS v4u*)(XT + pp * 256 + ((chunk ^ (pp & 15)) << 4));
                v4u sv; sv.x = pk2(bflo(xv.x) * w0[0], bfhi(xv.x) * w0[1]); sv.y = pk2(bflo(xv.y) * w0[2], bfhi(xv.y) * w0[3]);
                sv.z = pk2(bflo(xv.z) * w1[0], bfhi(xv.z) * w1[1]); sv.w = pk2(bflo(xv.w) * w1[2], bfhi(xv.w) * w1[3]);
                bfr[pt] = __builtin_bit_cast(bf16x8, sv); }
#pragma unroll
            for (int nt = 0; nt < 4; ++nt)
#pragma unroll
                for (int pt = 0; pt < 2; ++pt) acc[nt][pt] = __builtin_amdgcn_mfma_f32_32x32x16_bf16(af[nt], bfr[pt], acc[nt][pt], 0, 0, 0);
        }
        asm volatile("s_waitcnt lgkmcnt(0)" ::: "memory"); __syncthreads();
        {
            LAS unsigned char* stg = F.lds + w * (64 * 264);
#pragma unroll
            for (int nt = 0; nt < 4; ++nt)
#pragma unroll
                for (int pt = 0; pt < 2; ++pt)
#pragma unroll
                    for (int q = 0; q < 4; ++q) { u32x2v o; o.x = pk2(acc[nt][pt][4 * q], acc[nt][pt][4 * q + 1]); o.y = pk2(acc[nt][pt][4 * q + 2], acc[nt][pt][4 * q + 3]);
                        *(LAS u32x2v*)(stg + (32 * pt + r) * 264 + (32 * nt + 8 * q + 4 * hp) * 2) = o; }
            asm volatile("s_waitcnt lgkmcnt(0)" ::: "memory");
            bf16* Sp = (bf16*)(F.ws + (dir ? WS_SB : WS_SF)) + (size_t)(bc * NH + h) * (HD * NST);
#pragma unroll
            for (int j = 0; j < 16; ++j) { const int row = 4 * j + (lane >> 4), ch = lane & 15;
                const u32x2v a = *(const LAS u32x2v*)(stg + row * 264 + ch * 16), b2 = *(const LAS u32x2v*)(stg + row * 264 + ch * 16 + 8);
                v4u o; o.x = a.x; o.y = a.y; o.z = b2.x; o.w = b2.y; *(v4u*)(Sp + (size_t)row * NST + ch * 8) = o; }
            if (lane == 0) DEC[dir * (BATCH * NCH * NH) + bc * NH + h] = __expf(total);
        }
    }
    __syncthreads();
}

struct NaTile { float m, l; f32x4 o[4]; };
__device__ __forceinline__ void na_tile(NaTile& S, const bf16x8 (&kf)[4], const u32x2v (&vl)[4], const u32x2v (&vh)[4], const bf16x8 qf0, const bf16x8 qf1,
                                        const float (&be)[8]) {
    const f32x4 z = {0.f, 0.f, 0.f, 0.f};
    f32x4 s0 = __builtin_amdgcn_mfma_f32_16x16x32_bf16(kf[0], qf0, z, 0, 0, 0); s0 = __builtin_amdgcn_mfma_f32_16x16x32_bf16(kf[1], qf1, s0, 0, 0, 0);
    f32x4 s1 = __builtin_amdgcn_mfma_f32_16x16x32_bf16(kf[2], qf0, z, 0, 0, 0); s1 = __builtin_amdgcn_mfma_f32_16x16x32_bf16(kf[3], qf1, s1, 0, 0, 0);
    float sv[8]; float mx = -1e30f;
#pragma unroll
    for (int ct = 0; ct < 2; ++ct)
#pragma unroll
        for (int reg = 0; reg < 4; ++reg) { const float s = (ct ? s1[reg] : s0[reg]) + be[4 * ct + reg]; sv[4 * ct + reg] = s; mx = fmaxf(mx, s); }
    mx = red32_max(red16_max(mx));
    const float mn = fmaxf(S.m, mx), alpha = __builtin_amdgcn_exp2f(S.m - mn); S.m = mn;
    float ps = 0.f;
#pragma unroll
    for (int e = 0; e < 8; ++e) { sv[e] = __builtin_amdgcn_exp2f(sv[e] - mn); ps += sv[e]; }
    S.l = S.l * alpha + ps;
    v4u pb; pb.x = pk2(sv[0], sv[1]); pb.y = pk2(sv[2], sv[3]); pb.z = pk2(sv[4], sv[5]); pb.w = pk2(sv[6], sv[7]);
    const bf16x8 pf = __builtin_bit_cast(bf16x8, pb);
#pragma unroll
    for (int dt = 0; dt < 4; ++dt) { v4u vv; vv.x = vl[dt].x; vv.y = vl[dt].y; vv.z = vh[dt].x; vv.w = vh[dt].y;
        S.o[dt] = __builtin_amdgcn_mfma_f32_16x16x32_bf16(__builtin_bit_cast(bf16x8, vv), pf, S.o[dt] * alpha, 0, 0, 0); }
}
constexpr int NA_SLOT = 16384, NA_NSLOT = 9, NA_BIAS_OFF = NA_SLOT * NA_NSLOT;
__device__ __forceinline__ int na_r0(int i) { int r = i - KH / 2; return r < 0 ? 0 : (r > GROWS - KH ? GROWS - KH : r); }
__device__ __forceinline__ void na_mfma(Frame& F, const int dry) {
    LAS unsigned char* ring = F.lds;
    LAS float* bias = (LAS float*)(F.lds + NA_BIAS_OFF);
    bf16* ZQ = (bf16*)(F.ws + WS_ZQ); const bf16* KB = (const bf16*)(F.ws + WS_K); const bf16* VT = (const bf16*)(F.ws + WS_V);
    const int w = F.wave;
    constexpr int NITEM = BATCH * NH * (GROWS / 16);
    for (int item = F.vcu; item < NITEM; item += F.G) {
        const int bh = item >> 3, band = item & 7, b = bh / NH, hh = bh % NH;
        __syncthreads();
        for (int u = F.tid; u < 15 * 31; u += NWAVES * 64) bias[u] = F.in[13][hh * 465 + u];
        int lane = F.lane; asm volatile("" : "+v"(lane));
        const int c = lane & 15, g4 = lane >> 4, qrow = w >> 2, jb = w & 3, j0 = 16 * jb, j = j0 + c;
        int cs = j0 - 8; cs = cs < 0 ? 0 : (cs > 32 ? 32 : cs);
        int c0 = j - 8; c0 = c0 < 0 ? 0 : (c0 > GW - KW ? GW - KW : c0);
        const int kc0 = cs + 4 * g4, bcol = kc0 - j + 15;
        const int prow = 8 * w + (lane >> 3), lchunk = (lane & 7) ^ ((prow >> 1) & 7);
        const bf16* ksrc = KB + ((size_t)b * T + prow) * 1024 + hh * HD + 8 * lchunk;
        const bf16* vsrc = VT + (size_t)(hh * HD + prow) * M + (size_t)b * T + 8 * lchunk;
#define NA_DMA(kr) do { const int kr_ = (kr); LAS unsigned char* sl_ = ring + (kr_ % NA_NSLOT) * NA_SLOT + w * 1024; \
            __builtin_amdgcn_global_load_lds((const unsigned*)(ksrc + (size_t)kr_ * GW * 1024), (LAS unsigned*)(sl_), 16, 0, 0); \
            __builtin_amdgcn_global_load_lds((const unsigned*)(vsrc + (size_t)kr_ * GW), (LAS unsigned*)(sl_ + 8192), 16, 0, 0); } while (0)
        int koff[4], voff[4], voffh[4];
#pragma unroll
        for (int ct = 0; ct < 2; ++ct)
#pragma unroll
            for (int ks = 0; ks < 2; ++ks) { const int tok = cs + 16 * ct + c; koff[2 * ct + ks] = tok * 128 + (((4 * ks + g4) ^ ((tok >> 1) & 7)) << 4); }
        const int vob = ((cs + 4 * g4) * 2) & 15, vlc = ((cs + 4 * g4) * 2) >> 4;
#pragma unroll
        for (int dt = 0; dt < 4; ++dt) { const int d = 16 * dt + c; voff[dt] = 8192 + d * 128 + vob + ((vlc ^ ((d >> 1) & 7)) << 4); voffh[dt] = 8192 + d * 128 + vob + (((vlc + 2) ^ ((d >> 1) & 7)) << 4); }
        const int i00 = 16 * band;
        { const int rA = na_r0(i00), rB = na_r0(i00 + 1); for (int kr = rA; kr < rB + KH; ++kr) NA_DMA(kr); }
        bf16* qp = ZQ + ((size_t)b * T + (i00 + qrow) * GW + j) * 2048 + 1024 + hh * HD;
        bf16x8 qf0 = *(const bf16x8*)(qp + 8 * g4), qf1 = *(const bf16x8*)(qp + 32 + 8 * g4);
        asm volatile("s_waitcnt vmcnt(0)" ::: "memory"); __syncthreads();
        float be[8][8]; int cur_rel = 1000;
        u32x2v pend[4]; bf16* pendp = qp; bool have_pend = false;
#pragma unroll
        for (int dt = 0; dt < 4; ++dt) pend[dt] = (u32x2v){0u, 0u};
#pragma unroll 1
        for (int it = 0; it < 8; ++it) {
            const int i0 = i00 + 2 * it, i = i0 + qrow, r0 = na_r0(i);
            if (r0 - i != cur_rel) { cur_rel = r0 - i;
#pragma unroll
                for (int s_ = 0; s_ < 8; ++s_)
#pragma unroll
                    for (int ct = 0; ct < 2; ++ct)
#pragma unroll
                        for (int reg = 0; reg < 4; ++reg) { const int kc = kc0 + 16 * ct + reg; const bool ok = (kc >= c0) && (kc < c0 + KW);
                            const float bv = bias[ok ? (cur_rel + s_ + 7) * 31 + bcol + 16 * ct + reg : 0]; be[s_][4 * ct + reg] = ok ? bv * 1.4426950408889634f : -1e30f; } }
            NaTile t; t.m = -1e30f; t.l = 0.f;
#pragma unroll
            for (int dt = 0; dt < 4; ++dt) t.o[dt] = (f32x4){0.f, 0.f, 0.f, 0.f};
#define NA_STEP(s) do { const int kr_ = r0 + (s); const LAS unsigned char* sl_ = ring + (kr_ % NA_NSLOT) * NA_SLOT; bf16x8 kf_[4]; u32x2v vl_[4], vh_[4]; \
                _Pragma("unroll") for (int q_ = 0; q_ < 4; ++q_) kf_[q_] = *(const LAS bf16x8*)(sl_ + koff[q_]); \
                _Pragma("unroll") for (int q_ = 0; q_ < 4; ++q_) { vl_[q_] = *(const LAS u32x2v*)(sl_ + voff[q_]); vh_[q_] = *(const LAS u32x2v*)(sl_ + voffh[q_]); } \
                na_tile(t, kf_, vl_, vh_, qf0, qf1, be[s]); } while (0)
            NA_STEP(0); NA_STEP(1);
            asm volatile("s_waitcnt lgkmcnt(0)" ::: "memory"); __syncthreads();
            if (have_pend && !dry) {
#pragma unroll
                for (int dt = 0; dt < 4; ++dt) *(u32x2v*)(pendp + 16 * dt + 4 * g4) = pend[dt]; }
            bf16x8 nq0 = qf0, nq1 = qf1; bf16* nqp = qp + (size_t)2 * GW * 2048;
            if (it < 7) { const int rB = na_r0(i0 + 1), rB2 = na_r0(i0 + 3); for (int kr = rB + KH; kr < rB2 + KH; ++kr) NA_DMA(kr);
                nq0 = *(const bf16x8*)(nqp + 8 * g4); nq1 = *(const bf16x8*)(nqp + 32 + 8 * g4); }
            NA_STEP(2); NA_STEP(3); NA_STEP(4); NA_STEP(5); NA_STEP(6); NA_STEP(7);
#undef NA_STEP
            { const float l = red32_add(red16_add(t.l)); const float inv = __builtin_amdgcn_rcpf(l);
#pragma unroll
              for (int dt = 0; dt < 4; ++dt) { pend[dt].x = pk2(t.o[dt][0] * inv, t.o[dt][1] * inv); pend[dt].y = pk2(t.o[dt][2] * inv, t.o[dt][3] * inv); } }
            pendp = qp; have_pend = true;
            qp = nqp; qf0 = nq0; qf1 = nq1;
            asm volatile("s_waitcnt vmcnt(0) lgkmcnt(0)" ::: "memory"); __syncthreads();
        }
        if (!dry) {
#pragma unroll
            for (int dt = 0; dt < 4; ++dt) *(u32x2v*)(pendp + 16 * dt + 4 * g4) = pend[dt]; }
#undef NA_DMA
    }
    __syncthreads();
}

struct Args { const float* in[18]; float* out; unsigned char* ws; int ph_lo, ph_hi, li, pad; };
__global__ void __launch_bounds__(NWAVES * 64, 2) skel_fwd(Args args) {
    extern __shared__ __attribute__((aligned(16))) unsigned char lds[];
    Frame F;
    F.lds = (LAS unsigned char*)lds;
    F.MISC = (volatile LAS unsigned*)(F.lds + MISC_OFF);
    F.tid = threadIdx.x; F.lane = F.tid & 63; F.wave = __builtin_amdgcn_readfirstlane(F.tid >> 6);
    F.G = gridDim.x; { const int bx = blockIdx.x; F.vcu = (F.G % 8 == 0) ? (bx % 8) * (F.G / 8) + bx / 8 : bx; }
    F.ws = args.ws; F.out = args.out;
#pragma unroll
    for (int i = 0; i < 18; ++i) F.in[i] = args.in[i];
    F.ctl = (gu32*)(F.ws + WS_CTL);
#define GRID_BAR(seam) do { if (N_LAUNCHES == PER_PHASE) { if (F.tid == 0) __hip_atomic_store(F.ctl + CW_TMO, 0xBADBA0u | (unsigned)(seam), RLX_AGENT); } \
    else { xcd_barrier(bar); } } while (0)
    for (int u = F.tid; u < (LDS_BYTES - LDSCTL_OFF) / 4; u += NWAVES * 64) ((LAS unsigned*)(F.lds + LDSCTL_OFF))[u] = 0u;
    __syncthreads();
    XcdBarrier bar; bar.bar = (unsigned*)(F.ctl + CW_BAR); bar.x = 0; bar.st = nullptr;
    if (N_LAUNCHES != PER_PHASE) bar = xcd_barrier_post((unsigned*)(F.ctl + CW_BAR), F.MISC + 8);
    const int lo = args.ph_lo, hi = args.ph_hi;
#define IN(k) (lo <= (k) && (k) < hi)
#define BOTH(k) (IN(k) && IN((k) + 1))
    unsigned char* ws = F.ws;
#ifndef PROBE_PHASE
#define PROBE_PHASE -1
#endif
    const int dry0 = (PROBE_PHASE < 0) ? 0 : args.pad, dry1 = args.pad + 1;
#define RUN2(k, DRYCALL, CALL) do { if (PROBE_PHASE == (k)) { DRYCALL; __syncthreads(); } CALL; } while (0)
    if (IN(0)) { RUN2(0, p0_prologue(F), p0_prologue(F)); if (BOTH(0)) GRID_BAR(0); }
    if (IN(1)) {
#define P1_BODY do { \
        pg8::Gemm g{(const bf16*)(ws + WS_WIN), (const bf16*)(ws + WS_WIN), M, NMAIN, D}; pg8::P1Order S; S.init(M, NMAIN, F.G, (int)blockIdx.x); \
        pg8::EpiInProj E{(bf16*)(ws + WS_ZQ), (bf16*)(ws + WS_XBC), (bf16*)(ws + WS_K), (bf16*)(ws + WS_V), (float*)(ws + WS_DT), F.in[11], F.in[12], F.in[5], F.in[6]}; \
        pg8::gemm_phase<pg8::EpiInProj, pg8::P1Order, PG8_ALIGN, PG8_SP2>(F.lds + RING_OFF, g, S, E); } while (0)
        { const int c = (int)blockIdx.x; if (skew_on(F.G) && ((c >> 3) & 1)) { p_weights_late(F, 0, WL_IO + WL_I1, (c >> 4) * 8 + (c & 7), skew_n(F.G)); __syncthreads(); } }
        RUN2(1, P1_BODY, P1_BODY);
        if (BOTH(1)) GRID_BAR(1);
    }
    if (IN(2)) { RUN2(2, ssd_states_mfma(F), ssd_states_mfma(F)); RUN2(3, na_mfma(F, dry1), na_mfma(F, dry0)); if (BOTH(2)) GRID_BAR(2); }
    if (IN(3)) { RUN2(4, ssd_scan(F, dry1), ssd_scan(F, dry0)); if (!skew_on(F.G)) p_weights_late(F, 0, WL_IO + WL_I1 + WL_I2, F.vcu, F.G); if (BOTH(3)) GRID_BAR(3); }
    if (IN(4)) { RUN2(6, ssd_out_mfma(F, dry1), ssd_out_mfma(F, dry0)); if (BOTH(4)) GRID_BAR(4); }
    if (IN(5)) {
#define P5_BODY do { pg8::Gemm g{(const bf16*)(ws + WS_ZQ), (const bf16*)(ws + WS_WOUT), M, D, 2048}; pg8::StaticOrder S; S.init(M, D, F.G, (int)blockIdx.x); \
        pg8::EpiOutProj E{F.in[0], F.out, (bf16*)(ws + WS_XW), F.in[15], (float*)(ws + WS_SS)}; \
        pg8::gemm_phase<pg8::EpiOutProj, pg8::StaticOrder, false, PG8_SP2>(F.lds + RING_OFF, g, S, E); } while (0)
        RUN2(7, P5_BODY, P5_BODY);
        if (BOTH(5)) GRID_BAR(5);
    }
    if (IN(6)) {
#define P6_BODY do { pg8::Gemm g{(const bf16*)(ws + WS_XW), (const bf16*)(ws + WS_W1), M, FF, D}; pg8::StaticOrder S; S.init(M, FF, F.G, (int)blockIdx.x); \
        pg8::EpiMlpIn E{(bf16*)(ws + WS_H), (const float*)(ws + WS_SS)}; \
        pg8::gemm_phase<pg8::EpiMlpIn, pg8::StaticOrder, PG8_ALIGN, PG8_SP2>(F.lds + RING_OFF, g, S, E); } while (0)
        { const int c = (int)blockIdx.x; if (skew_on(F.G) && ((c >> 3) & 1)) { p_weights_late(F, WL_IO + WL_I1, WL_IO + WL_I1 + WL_I2, (c >> 4) * 8 + (c & 7), skew_n(F.G)); __syncthreads(); } }
        RUN2(8, P6_BODY, P6_BODY);
        if (BOTH(6)) GRID_BAR(6);
    }
    if (IN(7)) {
#define P7_BODY(DRY) do { pg8::Gemm g{(const bf16*)(ws + WS_H), (const bf16*)(ws + WS_W2), M, D, FF}; pg8::StaticOrder S; S.init(M, D, F.G, (int)blockIdx.x); \
        pg8::EpiMlpOut E{F.out, DRY}; \
        pg8::gemm_phase<pg8::EpiMlpOut, pg8::StaticOrder, false, PG8_SP2>(F.lds + RING_OFF, g, S, E); } while (0)
        RUN2(9, P7_BODY(dry1), P7_BODY(dry0));
    }
#undef IN
#undef BOTH
}

extern "C" void kernel_launch(void* const* d_in, const int* in_sizes, int n_in, void* d_out, int out_size, void* d_ws, size_t ws_size, hipStream_t stream) {
    static int grid = 0;
    if (grid == 0) {
        if (n_in != 18 || in_sizes[0] != M * D || out_size != M * D || ws_size < WS_END) { fprintf(stderr, "kernel_launch: unexpected shapes (n_in %d, in0 %d, out %d, ws %zu); nothing launched\n", n_in, n_in > 0 ? in_sizes[0] : -1, out_size, ws_size); grid = -1; return; }
        int dev = 0, cus = 0, per_cu = 0;
        if (hipGetDevice(&dev) != hipSuccess || hipDeviceGetAttribute(&cus, hipDeviceAttributeMultiprocessorCount, dev) != hipSuccess) { grid = -1; return; }
        if (hipFuncSetAttribute((const void*)skel_fwd, hipFuncAttributeMaxDynamicSharedMemorySize, LDS_BYTES) != hipSuccess) { fprintf(stderr, "kernel_launch: hipFuncSetAttribute failed\n"); grid = -1; return; }
        if (hipOccupancyMaxActiveBlocksPerMultiprocessor(&per_cu, (const void*)skel_fwd, NWAVES * 64, LDS_BYTES) != hipSuccess || per_cu < 1)
            fprintf(stderr, "kernel_launch: note: occupancy query reports %d workgroups per CU\n", per_cu);
        (void)hipGetLastError();
        grid = cus;
    }
    if (grid < 0) return;
    if (hipMemsetAsync((char*)d_ws + WS_CTL, 0, CTL_ZERO_BYTES, stream) != hipSuccess) { fprintf(stderr, "kernel_launch: hipMemsetAsync failed\n"); return; }
    Args a{};
    for (int i = 0; i < 18; ++i) a.in[i] = (const float*)d_in[i];
    a.out = (float*)d_out; a.ws = (unsigned char*)d_ws;
    if (N_LAUNCHES == 1) { a.ph_lo = 0; a.ph_hi = PER_PHASE; a.li = 0; hipLaunchKernelGGL(skel_fwd, dim3(grid), dim3(NWAVES * 64), LDS_BYTES, stream, a); }
    else for (int li = 0; li < PER_PHASE; ++li) { a.ph_lo = li; a.ph_hi = li + 1; a.li = li; hipLaunchKernelGGL(skel_fwd, dim3(grid), dim3(NWAVES * 64), LDS_BYTES, stream, a); }
}
```

```cpp
#include <hip/hip_runtime.h>
#include <cstdio>
#include <cstdint>
namespace pg8 {
#define PG8_LAS __attribute__((address_space(3)))
typedef unsigned short bf16_t;
typedef short bf16x8 __attribute__((ext_vector_type(8)));
typedef float f32x4 __attribute__((ext_vector_type(4)));
typedef unsigned u32x4 __attribute__((ext_vector_type(4)));
constexpr int BM = 256, BK = 64, HALF = 128, HTB = HALF * BK * 2  , STAGE_BYTES = 8 * HTB, NXCD = 8, WGM = 4;

__host__ __device__ __forceinline__ int lds_byte(int r, int c) { const int st = (r >> 4) * 2 + (c >> 5), rr = r & 15, cc = c & 31, ob = rr * 64 + cc * 2; return st * 1024 + (ob ^ (((ob >> 9) & 1) << 5)); }
__host__ __device__ __forceinline__ void stage_rc(int b, int& R, int& C) { const int st = b / 1024, sb = b % 1024, swz = sb ^ (((sb >> 9) & 1) << 5); R = (st >> 1) * 16 + swz / 64; C = (st & 1) * 32 + (swz % 64) / 2; }
__host__ __device__ __forceinline__ int perm32(int rho) { const int n = rho >> 4, i = rho & 15; return 8 * (i >> 2) + 4 * n + (i & 3); }

struct Unit { int pm, pn; };
struct Gemm { const bf16_t* A; const bf16_t* Bt; int M, N, K; };

struct StaticOrder {
    int nM, nN, nwg, G, c;
    __host__ __device__ void init(int M, int N, int G_, int c_) { nM = M / BM; nN = N / BM; nwg = nM * nN; G = G_; c = c_; }
    __host__ __device__ bool next(int i, Unit& u) const {
        const long L = (long)i * G + c; if (L >= nwg) return false;
        int wgid = (int)L; { const int q = nwg / NXCD, r = nwg % NXCD, xcd = wgid % NXCD, off = wgid / NXCD; wgid = (xcd < r ? xcd * (q + 1) : r * (q + 1) + (xcd - r) * q) + off; }
        const int nig = WGM * nN, gid = wgid / nig, fm = gid * WGM, gsz = (nM - fm) < WGM ? (nM - fm) : WGM;
        u.pm = fm + ((wgid % nig) % gsz); u.pn = (wgid % nig) / gsz; return true;
    }
    __device__ __forceinline__ void a_ready(const Unit&) const {}
    __device__ __forceinline__ void done(const Unit&) const {}
};

typedef float f32x2_cv __attribute__((ext_vector_type(2))); typedef __bf16 bf16x2_cv __attribute__((ext_vector_type(2)));
__device__ __forceinline__ unsigned cvt_pk_bf16(float lo, float hi) { const f32x2_cv v = {lo, hi}; const bf16x2_cv b = __builtin_convertvector(v, bf16x2_cv); return __builtin_bit_cast(unsigned, b); }
typedef float f32x2 __attribute__((ext_vector_type(2)));
__device__ __forceinline__ f32x2 gelu_pk(f32x2 v) {
    const f32x2 av = __builtin_elementwise_abs(v), d = av * 0.2316418882f + 1.0f;
    f32x2 t; t.x = __builtin_amdgcn_rcpf(d.x); t.y = __builtin_amdgcn_rcpf(d.y);
    f32x2 q = t * 0.5307027145f + (-0.7265760135f); q = q * t + 0.7107068705f; q = q * t + (-0.142248368f); q = q * t + 0.127414796f; q = q * t;
    const f32x2 s = (v * v) * (-0.72134752044f);
    f32x2 e; e.x = __builtin_amdgcn_exp2f(s.x); e.y = __builtin_amdgcn_exp2f(s.y);
    const f32x2 m = v * (q * e), r = v - m;
    f32x2 o; o.x = v.x < 0.f ? m.x : r.x; o.y = v.y < 0.f ? m.y : r.y; return o;
}

template <int ACT  > struct EpiBf16 {
    static constexpr bool PERM = true, AFTER_DRAIN = false; static_assert(ACT == 0 || ACT == 1, "EpiBf16: ACT is 0 (none) or 1 (gelu_pk)");
    bf16_t* O; int ldc; const float* bias; int split_cols; size_t split_stride; float scale0;
    __device__ __forceinline__ void operator()(const f32x4 (&acc)[2][2][4][2], const Unit& u, int wr, int wc, int fr, int fq) const {
        const int row0 = u.pm * BM + wr * 64 + fr; int colt = u.pn * BM; bf16_t* base = O;
        float sc = 1.f; if (split_cols) { const int t = colt / split_cols; base += (size_t)t * split_stride; colt -= t * split_cols; if (t == 0) sc = scale0; }
        const int col0 = colt + wc * 32 + 8 * fq, bcol0 = u.pn * BM + wc * 32 + 8 * fq;
        f32x4 bv[2][2];
#pragma unroll
        for (int bj = 0; bj < 2; ++bj)
#pragma unroll
            for (int n = 0; n < 2; ++n) bv[bj][n] = bias ? *(const f32x4*)(bias + bcol0 + bj * HALF + 4 * n) : (f32x4){0.f, 0.f, 0.f, 0.f};
#pragma unroll
        for (int ai = 0; ai < 2; ++ai)
#pragma unroll
            for (int m = 0; m < 4; ++m) { bf16_t* rowp = base + (size_t)(row0 + ai * HALF + m * 16) * ldc + col0;
#pragma unroll
                for (int bj = 0; bj < 2; ++bj) { f32x4 v0 = acc[ai][bj][m][0] + bv[bj][0], v1 = acc[ai][bj][m][1] + bv[bj][1];
                    if (ACT == 1) { f32x2 a = gelu_pk((f32x2){v0[0], v0[1]}), b = gelu_pk((f32x2){v0[2], v0[3]}), c = gelu_pk((f32x2){v1[0], v1[1]}), d = gelu_pk((f32x2){v1[2], v1[3]});
                        v0 = (f32x4){a.x, a.y, b.x, b.y}; v1 = (f32x4){c.x, c.y, d.x, d.y}; }
                    v0 = v0 * sc; v1 = v1 * sc; u32x4 w; w.x = cvt_pk_bf16(v0[0], v0[1]); w.y = cvt_pk_bf16(v0[2], v0[3]); w.z = cvt_pk_bf16(v1[0], v1[1]); w.w = cvt_pk_bf16(v1[2], v1[3]);
                    *(u32x4*)(rowp + bj * HALF) = w; } }
    }
};
template <class Epi, class Sched, bool ALIGN_EPI = false, bool SP2 = false>
__device__ __forceinline__ void gemm_phase(PG8_LAS unsigned char* lds, const Gemm g, const Sched& S, const Epi& E) {
    const int tid = threadIdx.x, wid = __builtin_amdgcn_readfirstlane(tid >> 6), lane = tid & 63, wr = wid >> 2, wc = wid & 3, fr = lane & 15, fq = lane >> 4;
    const int K = g.K, nt = K / BK;
    unsigned voffA[2], voffB[2];
#pragma unroll
    for (int i = 0; i < 2; ++i) { int R, C; stage_rc(tid * 16 + i * 8192, R, C); const int Rb = Epi::PERM ? ((R & ~31) + perm32(R & 31)) : R;
        voffA[i] = (unsigned)(R * K + C) * 2u; voffB[i] = (unsigned)(Rb * K + C) * 2u; }
    const size_t kstep = (size_t)(BK * 2);
    const size_t hstep = (size_t)HALF * K * 2;
    const size_t tstep = 2 * hstep;
    const unsigned ldsw = (unsigned)wid * 1024u;
    const int aoff = lds_byte(wr * 64 + fr, fq * 8), boff = lds_byte(wc * 32 + fr, fq * 8);
#define PG8_SA(b, h) (((b) * 2 + (h)) * HTB)
#define PG8_SB(b, h) ((4 + (b) * 2 + (h)) * HTB)
#define PG8_STAGE(bufoff, gbase, voff) do { _Pragma("unroll") for (int _i = 0; _i < 2; ++_i) \
        __builtin_amdgcn_global_load_lds((const unsigned*)((const char*)(gbase) + (voff)[_i]), (PG8_LAS unsigned*)(lds + (bufoff) + ldsw + _i * 8192), 16, 0, 0); } while (0)
#define PG8_LDA(dst, b, h) do { _Pragma("unroll") for (int m = 0; m < 4; ++m) _Pragma("unroll") for (int k = 0; k < 2; ++k) dst[m][k] = *(const PG8_LAS bf16x8*)(lds + PG8_SA(b, h) + aoff + m * 2048 + k * 1024); } while (0)
#define PG8_LDB(dst, b, h) do { _Pragma("unroll") for (int n = 0; n < 2; ++n) _Pragma("unroll") for (int k = 0; k < 2; ++k) dst[n][k] = *(const PG8_LAS bf16x8*)(lds + PG8_SB(b, h) + boff + n * 2048 + k * 1024); } while (0)
#define PG8_MMA(ai, bj, At, Bt) do { __builtin_amdgcn_s_setprio(1); _Pragma("unroll") for (int m = 0; m < 4; ++m) _Pragma("unroll") for (int n = 0; n < 2; ++n) _Pragma("unroll") for (int k = 0; k < 2; ++k) \
        acc[ai][bj][m][n] = __builtin_amdgcn_mfma_f32_16x16x32_bf16(Bt[n][k], At[m][k], acc[ai][bj][m][n], 0, 0, 0); __builtin_amdgcn_s_setprio(0); } while (0)
#define PG8_WAIT_V(n) asm volatile("s_waitcnt vmcnt(" #n ")" ::: "memory")
#define PG8_WAIT_L(n) asm volatile("s_waitcnt lgkmcnt(" #n ")" ::: "memory")
#define PG8_BAR __builtin_amdgcn_s_barrier()
#define PG8_SCHED __builtin_amdgcn_sched_barrier(0)
    Unit cur, nxt; int ui = 0;
    if (!S.next(0, cur)) return;
    f32x4 acc[2][2][4][2];
#pragma unroll
    for (int a = 0; a < 2; ++a)
#pragma unroll
        for (int b = 0; b < 2; ++b)
#pragma unroll
            for (int m = 0; m < 4; ++m)
#pragma unroll
                for (int n = 0; n < 2; ++n) acc[a][b][m][n] = (f32x4){0.f, 0.f, 0.f, 0.f};
    bf16x8 At[4][2], B0[2][2], B1[2][2];
    const char* cA = (const char*)g.A + (size_t)cur.pm * tstep; const char* cB = (const char*)g.Bt + (size_t)cur.pn * tstep;
    S.a_ready(cur);
    if constexpr (SP2) {
        PG8_STAGE(PG8_SB(0, 0), cB, voffB); PG8_STAGE(PG8_SB(0, 1), cB + hstep, voffB); PG8_STAGE(PG8_SA(0, 0), cA, voffA); PG8_STAGE(PG8_SA(0, 1), cA + hstep, voffA);
        if (wr == 1) PG8_BAR;
        PG8_WAIT_V(2); PG8_BAR;
        PG8_STAGE(PG8_SB(1, 0), cB + kstep, voffB); PG8_STAGE(PG8_SA(1, 0), cA + kstep, voffA); PG8_STAGE(PG8_SB(1, 1), cB + hstep + kstep, voffB);
        PG8_WAIT_V(6); PG8_BAR;
    } else {
        PG8_STAGE(PG8_SB(0, 0), cB, voffB); PG8_STAGE(PG8_SA(0, 0), cA, voffA); PG8_STAGE(PG8_SB(0, 1), cB + hstep, voffB); PG8_STAGE(PG8_SA(0, 1), cA + hstep, voffA);
        if (wr == 1) PG8_BAR;
        PG8_WAIT_V(4); PG8_BAR;
        PG8_STAGE(PG8_SB(1, 0), cB + kstep, voffB); PG8_STAGE(PG8_SA(1, 0), cA + kstep, voffA); PG8_STAGE(PG8_SB(1, 1), cB + hstep + kstep, voffB);
        PG8_WAIT_V(6); PG8_BAR;
    }
    for (;;) {
        const bool has_next = S.next(ui + 1, nxt);
        const char* nA = has_next ? (const char*)g.A + (size_t)nxt.pm * tstep : cA; const char* nB = has_next ? (const char*)g.Bt + (size_t)nxt.pn * tstep : cB;
        for (int t = 0; t < nt; t += 2) {
            const bool last = (t == nt - 2);
            const char* a1 = cA + (size_t)(t + 1) * kstep;
            const char* a2 = last ? nA : cA + (size_t)(t + 2) * kstep; const char* b2 = last ? nB : cB + (size_t)(t + 2) * kstep;
            const char* a3 = a2 + kstep; const char* b3 = b2 + kstep;
            if (last && has_next) S.a_ready(nxt);
            if constexpr (SP2) {
            PG8_LDB(B0, 0, 0); PG8_LDB(B1, 0, 1); PG8_SCHED; PG8_LDA(At, 0, 0); PG8_STAGE(PG8_SA(1, 1), a1 + hstep, voffA);
            PG8_WAIT_V(8); PG8_WAIT_L(0); PG8_BAR; PG8_MMA(0, 0, At, B0); PG8_MMA(0, 1, At, B1); PG8_BAR; PG8_SCHED;
            PG8_LDA(At, 0, 1); PG8_STAGE(PG8_SB(0, 0), b2, voffB); PG8_STAGE(PG8_SB(0, 1), b2 + hstep, voffB); PG8_STAGE(PG8_SA(0, 0), a2, voffA);
            PG8_WAIT_V(8); PG8_WAIT_L(0); PG8_BAR; PG8_MMA(1, 0, At, B0); PG8_MMA(1, 1, At, B1); PG8_BAR; PG8_SCHED;
            PG8_LDB(B0, 1, 0); PG8_LDB(B1, 1, 1); PG8_SCHED; PG8_LDA(At, 1, 0); PG8_STAGE(PG8_SA(0, 1), a2 + hstep, voffA);
            PG8_WAIT_V(8); PG8_WAIT_L(0); PG8_BAR; PG8_MMA(0, 0, At, B0); PG8_MMA(0, 1, At, B1); PG8_BAR; PG8_SCHED;
            PG8_LDA(At, 1, 1); PG8_STAGE(PG8_SB(1, 0), b3, voffB); PG8_STAGE(PG8_SB(1, 1), b3 + hstep, voffB); PG8_STAGE(PG8_SA(1, 0), a3, voffA);
            PG8_WAIT_V(8); PG8_WAIT_L(0); PG8_BAR; PG8_MMA(1, 0, At, B0); PG8_MMA(1, 1, At, B1); PG8_BAR; PG8_SCHED;
            } else {
            PG8_LDB(B0, 0, 0); PG8_SCHED; PG8_LDA(At, 0, 0); PG8_STAGE(PG8_SA(1, 1), a1 + hstep, voffA);
            PG8_WAIT_L(8); PG8_BAR; PG8_WAIT_L(0); PG8_MMA(0, 0, At, B0); PG8_BAR; PG8_SCHED;
            PG8_LDB(B1, 0, 1); PG8_STAGE(PG8_SB(0, 0), b2, voffB);
            PG8_BAR; PG8_WAIT_L(0); PG8_MMA(0, 1, At, B1); PG8_BAR;
            PG8_LDA(At, 0, 1); PG8_STAGE(PG8_SA(0, 0), a2, voffA);
            PG8_BAR; PG8_WAIT_L(0); PG8_MMA(1, 0, At, B0); PG8_BAR; PG8_SCHED;
            PG8_STAGE(PG8_SB(0, 1), b2 + hstep, voffB);
            PG8_WAIT_V(6); PG8_BAR; PG8_MMA(1, 1, At, B1); PG8_BAR;
            PG8_LDB(B0, 1, 0); PG8_SCHED; PG8_LDA(At, 1, 0); PG8_STAGE(PG8_SA(0, 1), a2 + hstep, voffA);
            PG8_WAIT_L(8); PG8_BAR; PG8_WAIT_L(0); PG8_MMA(0, 0, At, B0); PG8_BAR; PG8_SCHED;
            PG8_LDB(B1, 1, 1); PG8_STAGE(PG8_SB(1, 0), b3, voffB);
            PG8_BAR; PG8_WAIT_L(0); PG8_MMA(0, 1, At, B1); PG8_BAR;
            PG8_LDA(At, 1, 1); PG8_STAGE(PG8_SA(1, 0), a3, voffA);
            PG8_BAR; PG8_WAIT_L(0); PG8_MMA(1, 0, At, B0); PG8_BAR; PG8_SCHED;
            PG8_STAGE(PG8_SB(1, 1), b3 + hstep, voffB);
            PG8_WAIT_V(6); PG8_BAR; PG8_MMA(1, 1, At, B1); PG8_BAR;
            }
        }
        if constexpr (ALIGN_EPI) { if (wr == 0) PG8_BAR; }
        if constexpr (!Epi::AFTER_DRAIN) { E(acc, cur, wr, wc, fr, fq); S.done(cur); }
        if (!has_next) break;
#pragma unroll
        for (int a = 0; a < 2; ++a)
#pragma unroll
            for (int b = 0; b < 2; ++b)
#pragma unroll
                for (int m = 0; m < 4; ++m)
#pragma unroll
                    for (int n = 0; n < 2; ++n) acc[a][b][m][n] = (f32x4){0.f, 0.f, 0.f, 0.f};
        cur = nxt; cA = nA; cB = nB; ++ui;
        if constexpr (ALIGN_EPI) { if (wr == 1) PG8_BAR; }
    }
    PG8_WAIT_V(0);
    if constexpr (!ALIGN_EPI) { if (wr == 0) PG8_BAR; }
    PG8_BAR;
    if constexpr (Epi::AFTER_DRAIN) { E.fused(acc, cur, wr, wc, fr, fq, lds, wid, lane); S.done(cur); }
#undef PG8_SA
#undef PG8_SB
#undef PG8_STAGE
#undef PG8_LDA
#undef PG8_LDB
#undef PG8_MMA
#undef PG8_WAIT_V
#undef PG8_WAIT_L
#undef PG8_BAR
#undef PG8_SCHED
}
}
namespace pg8 {
struct P1Order {
    StaticOrder main; int G, c;
    __host__ __device__ void init(int M_, int Nmain, int G_, int c_) { main.init(M_, Nmain, G_, c_); G = G_; c = c_; }
    __host__ __device__ bool next(int i, Unit& u) const {
        if (main.next(i, u)) { u.pm += 24; return true; }
        const long L = (long)i * G + c - main.nwg; if (L >= 256) return false;
        u.pm = 19 + (int)(L & 3); u.pn = 24 + (int)(L >> 2); return true;
    }
    __device__ __forceinline__ void a_ready(const Unit&) const {}
    __device__ __forceinline__ void done(const Unit&) const {}
};
typedef unsigned u32x2 __attribute__((ext_vector_type(2)));
__device__ __forceinline__ float softplus_f(float x) { const float e = __expf(-fabsf(x)); return fmaxf(x, 0.f) + (e < 1e-4f ? e * (1.0f - 0.5f * e) : __logf(1.0f + e)); }
struct EpiInProj {
    static constexpr bool PERM = true, AFTER_DRAIN = false;
    bf16_t* ZQ; bf16_t* XBC; bf16_t* KB; bf16_t* VB; float* DT; const float* qw; const float* kw; const float* dbf; const float* dbb;
    __device__ __forceinline__ void plain(const f32x4 (&acc)[2][2][4][2], bf16_t* base, int ldc, int row0, int col0) const {
#pragma unroll
        for (int ai = 0; ai < 2; ++ai)
#pragma unroll
            for (int m = 0; m < 4; ++m) { bf16_t* rowp = base + (size_t)(row0 + ai * HALF + m * 16) * ldc + col0;
#pragma unroll
                for (int bj = 0; bj < 2; ++bj) { const f32x4 v0 = acc[ai][bj][m][0], v1 = acc[ai][bj][m][1];
                    u32x4 w; w.x = cvt_pk_bf16(v0[0], v0[1]); w.y = cvt_pk_bf16(v0[2], v0[3]); w.z = cvt_pk_bf16(v1[0], v1[1]); w.w = cvt_pk_bf16(v1[2], v1[3]);
                    *(u32x4*)(rowp + bj * HALF) = w; } }
    }
    __device__ __forceinline__ void headnorm(const f32x4 (&acc)[2][2][4][2], bf16_t* base, int ldc, int row0, int colh, const float* w, float scale, int fq) const {
        f32x4 wv[2][2];
#pragma unroll
        for (int bj = 0; bj < 2; ++bj)
#pragma unroll
            for (int n = 0; n < 2; ++n) wv[bj][n] = *(const f32x4*)(w + 32 * bj + 8 * fq + 4 * n) * scale;
#pragma unroll
        for (int ai = 0; ai < 2; ++ai)
#pragma unroll
            for (int m = 0; m < 4; ++m) {
                float ss = 0.f;
#pragma unroll
                for (int bj = 0; bj < 2; ++bj)
#pragma unroll
                    for (int n = 0; n < 2; ++n) { const f32x4 x = acc[ai][bj][m][n]; ss += (x[0] * x[0] + x[1] * x[1]) + (x[2] * x[2] + x[3] * x[3]); }
                ss += __shfl_xor(ss, 16); ss += __shfl_xor(ss, 32);
                const float rstd = 1.0f / sqrtf(ss * (1.0f / 64.0f) + 1e-5f);
                bf16_t* rowp = base + (size_t)(row0 + ai * HALF + m * 16) * ldc + colh + 8 * fq;
#pragma unroll
                for (int bj = 0; bj < 2; ++bj) { const f32x4 v0 = acc[ai][bj][m][0] * rstd * wv[bj][0], v1 = acc[ai][bj][m][1] * rstd * wv[bj][1];
                    u32x4 o; o.x = cvt_pk_bf16(v0[0], v0[1]); o.y = cvt_pk_bf16(v0[2], v0[3]); o.z = cvt_pk_bf16(v1[0], v1[1]); o.w = cvt_pk_bf16(v1[2], v1[3]);
                    *(u32x4*)(rowp + 32 * bj) = o; } }
    }
    __device__ __forceinline__ void operator()(const f32x4 (&acc)[2][2][4][2], const Unit& u, int wr, int wc, int fr, int fq) const {
        asm volatile("" : "+v"(fr), "+v"(fq));
        const int colw = wc * 32 + 8 * fq;
        if (u.pn >= 24) { plain(acc, VB, 16384, (u.pm - 19) * BM + wr * 64 + fr, (u.pn - 24) * BM + colw); return; }
        const int row0 = (u.pm - 24) * BM + wr * 64 + fr, pn = u.pn;
        if (pn < 4) plain(acc, ZQ, 2048, row0, pn * 256 + colw);
        else if (pn < 10) plain(acc, XBC, 1536, row0, (pn - 4) * 256 + colw);
        else if (pn < 14) headnorm(acc, ZQ, 2048, row0, 1024 + 64 * (4 * (pn - 10) + wc), qw, 0.125f * 1.4426950408889634f, fq);
        else if (pn < 18) headnorm(acc, KB, 1024, row0, 64 * (4 * (pn - 14) + wc), kw, 1.0f, fq);
        else if (wc == 0) {
            f32x4 bv[2];
#pragma unroll
            for (int n = 0; n < 2; ++n) { const int c = 8 * fq + 4 * n; bv[n] = (c < 16) ? *(const f32x4*)(dbf + c) : *(const f32x4*)(dbb + c - 16); }
#pragma unroll
            for (int ai = 0; ai < 2; ++ai)
#pragma unroll
                for (int m = 0; m < 4; ++m) { float* rowp = DT + (size_t)(row0 + ai * HALF + m * 16) * 32 + 8 * fq;
#pragma unroll
                    for (int n = 0; n < 2; ++n) { const f32x4 x = acc[ai][0][m][n] + bv[n]; f32x4 o; o[0] = softplus_f(x[0]); o[1] = softplus_f(x[1]); o[2] = softplus_f(x[2]); o[3] = softplus_f(x[3]);
                        *(f32x4*)(rowp + 4 * n) = o; } }
        }
    }
};
struct EpiOutProj {
    static constexpr bool PERM = true, AFTER_DRAIN = false;
    const float* X; float* OUT; bf16_t* XW; const float* wn; float* SS;
    __device__ __forceinline__ void operator()(const f32x4 (&acc)[2][2][4][2], const Unit& u, int wr, int wc, int fr, int fq) const {
        const int row0 = u.pm * BM + wr * 64 + fr, col0 = u.pn * BM + wc * 32 + 8 * fq;
        f32x4 wv[2][2];
#pragma unroll
        for (int bj = 0; bj < 2; ++bj)
#pragma unroll
            for (int n = 0; n < 2; ++n) wv[bj][n] = *(const f32x4*)(wn + col0 + bj * HALF + 4 * n);
#pragma unroll
        for (int ai = 0; ai < 2; ++ai) {
            f32x4 xr[4][2][2];
#pragma unroll
            for (int m = 0; m < 4; ++m)
#pragma unroll
                for (int bj = 0; bj < 2; ++bj) { const size_t off = (size_t)(row0 + ai * HALF + m * 16) * 1024 + col0 + bj * HALF;
                    xr[m][bj][0] = *(const f32x4*)(X + off); xr[m][bj][1] = *(const f32x4*)(X + off + 4); }
            asm volatile("" ::: "memory");
#pragma unroll
            for (int m = 0; m < 4; ++m) { const int row = row0 + ai * HALF + m * 16; const size_t off = (size_t)row * 1024 + col0; float ss = 0.f;
#pragma unroll
                for (int bj = 0; bj < 2; ++bj) {
                    const f32x4 v0 = acc[ai][bj][m][0] + xr[m][bj][0], v1 = acc[ai][bj][m][1] + xr[m][bj][1];
                    ss += (v0[0] * v0[0] + v0[1] * v0[1]) + (v0[2] * v0[2] + v0[3] * v0[3]) + (v1[0] * v1[0] + v1[1] * v1[1]) + (v1[2] * v1[2] + v1[3] * v1[3]);
                    const f32x4 y0 = v0 * wv[bj][0], y1 = v1 * wv[bj][1];
                    u32x4 o; o.x = cvt_pk_bf16(y0[0], y0[1]); o.y = cvt_pk_bf16(y0[2], y0[3]); o.z = cvt_pk_bf16(y1[0], y1[1]); o.w = cvt_pk_bf16(y1[2], y1[3]);
                    *(u32x4*)(XW + off + bj * HALF) = o; }
                ss += __shfl_xor(ss, 16); ss += __shfl_xor(ss, 32);
                if (fq == 0) SS[(size_t)row * 16 + 4 * u.pn + wc] = ss; }
            asm volatile("" ::: "memory");
        }
    }
};
struct EpiMlpIn {
    static constexpr bool PERM = true, AFTER_DRAIN = false;
    bf16_t* H; const float* SS;
    __device__ __forceinline__ void operator()(const f32x4 (&acc)[2][2][4][2], const Unit& u, int wr, int wc, int fr, int fq) const {
        const int row0 = u.pm * BM + wr * 64 + fr, col0 = u.pn * BM + wc * 32 + 8 * fq;
        float rs2[2][4];
#pragma unroll
        for (int ai = 0; ai < 2; ++ai) { f32x4 sp[4][4];
#pragma unroll
            for (int m = 0; m < 4; ++m)
#pragma unroll
                for (int k = 0; k < 4; ++k) sp[m][k] = *(const f32x4*)(SS + (size_t)(row0 + ai * HALF + m * 16) * 16 + 4 * k);
#pragma unroll
            for (int m = 0; m < 4; ++m) { const f32x4 st = (sp[m][0] + sp[m][1]) + (sp[m][2] + sp[m][3]); rs2[ai][m] = __builtin_amdgcn_rcpf(((st[0] + st[1]) + (st[2] + st[3])) * (1.0f / 1024.0f) + 1e-5f); } }
        asm volatile("" ::: "memory");
#pragma unroll
        for (int ai = 0; ai < 2; ++ai)
#pragma unroll
            for (int m = 0; m < 4; ++m) { bf16_t* rowp = H + (size_t)(row0 + ai * HALF + m * 16) * 4096 + col0; const float r2 = rs2[ai][m];
#pragma unroll
                for (int bj = 0; bj < 2; ++bj) { f32x4 v0 = acc[ai][bj][m][0], v1 = acc[ai][bj][m][1];
#pragma unroll
                    for (int j = 0; j < 4; ++j) { const float a = fmaxf(v0[j], 0.f), b = fmaxf(v1[j], 0.f); v0[j] = a * a * r2; v1[j] = b * b * r2; }
                    u32x4 o; o.x = cvt_pk_bf16(v0[0], v0[1]); o.y = cvt_pk_bf16(v0[2], v0[3]); o.z = cvt_pk_bf16(v1[0], v1[1]); o.w = cvt_pk_bf16(v1[2], v1[3]);
                    *(u32x4*)(rowp + bj * HALF) = o; } }
    }
};
struct EpiMlpOut {
    static constexpr bool PERM = true, AFTER_DRAIN = false;
    float* OUT; const bf16_t* XW; const float* wn; int dry;
    __device__ __forceinline__ void operator()(const f32x4 (&acc)[2][2][4][2], const Unit& u, int wr, int wc, int fr, int fq) const {
        const int row0 = u.pm * BM + wr * 64 + fr, col0 = u.pn * BM + wc * 32 + 8 * fq;
        f32x4 rw[2][2];
#pragma unroll
        for (int bj = 0; bj < 2; ++bj)
#pragma unroll
            for (int n = 0; n < 2; ++n) { const f32x4 w = *(const f32x4*)(wn + col0 + bj * HALF + 4 * n); rw[bj][n] = (f32x4){__builtin_amdgcn_rcpf(w[0]), __builtin_amdgcn_rcpf(w[1]), __builtin_amdgcn_rcpf(w[2]), __builtin_amdgcn_rcpf(w[3])}; }
#pragma unroll
        for (int ai = 0; ai < 2; ++ai) {
            u32x4 xr[4][2];
#pragma unroll
            for (int m = 0; m < 4; ++m)
#pragma unroll
                for (int bj = 0; bj < 2; ++bj) xr[m][bj] = *(const u32x4*)(XW + (size_t)(row0 + ai * HALF + m * 16) * 1024 + col0 + bj * HALF);
            asm volatile("" ::: "memory");
#pragma unroll
            for (int m = 0; m < 4; ++m)
#pragma unroll
                for (int bj = 0; bj < 2; ++bj) { float* rowp = OUT + (size_t)(row0 + ai * HALF + m * 16) * 1024 + col0 + bj * HALF; const u32x4 x = xr[m][bj];
                    const f32x4 x0 = {__builtin_bit_cast(float, x.x << 16), __builtin_bit_cast(float, x.x & 0xffff0000u), __builtin_bit_cast(float, x.y << 16), __builtin_bit_cast(float, x.y & 0xffff0000u)};
                    const f32x4 x1 = {__builtin_bit_cast(float, x.z << 16), __builtin_bit_cast(float, x.z & 0xffff0000u), __builtin_bit_cast(float, x.w << 16), __builtin_bit_cast(float, x.w & 0xffff0000u)};
                    if (!dry) { *(f32x4*)(rowp) = acc[ai][bj][m][0] + x0 * rw[bj][0]; *(f32x4*)(rowp + 4) = acc[ai][bj][m][1] + x1 * rw[bj][1]; } }
            asm volatile("" ::: "memory");
        }
    }
};
}
#ifndef PG8_SP2
#define PG8_SP2 true
#endif
#ifndef PG8_ALIGN
#define PG8_ALIGN true
#endif
#define GAS __attribute__((address_space(1)))
#define LAS __attribute__((address_space(3)))
typedef unsigned short bf16;
typedef unsigned v4u __attribute__((ext_vector_type(4)));
typedef float f32x4 __attribute__((ext_vector_type(4)));
typedef short bf16x8 __attribute__((ext_vector_type(8)));
typedef GAS unsigned gu32;
typedef GAS unsigned long long gu64;
#define RLX_AGENT __ATOMIC_RELAXED, __HIP_MEMORY_SCOPE_AGENT
#define LDS_WAIT() asm volatile("s_waitcnt lgkmcnt(0)" ::: "memory")
#define VM_WAIT() asm volatile("s_waitcnt vmcnt(0)" ::: "memory")
__device__ __forceinline__ unsigned long long rt() { return __builtin_amdgcn_s_memrealtime(); }
__device__ __forceinline__ unsigned f2bf(float f) { unsigned u = __builtin_bit_cast(unsigned, f); return (u + 0x7fffu + ((u >> 16) & 1u)) >> 16; }
typedef float f32x2_hw __attribute__((ext_vector_type(2))); typedef __bf16 bf16x2_hw __attribute__((ext_vector_type(2)));
__device__ __forceinline__ unsigned pk2(float lo, float hi) { const f32x2_hw v = {lo, hi}; const bf16x2_hw b = __builtin_convertvector(v, bf16x2_hw); return __builtin_bit_cast(unsigned, b); }

#define XB_TMO      128
#define XB_XCNT(j)  (256  + 64 * (j))
#define XB_XSUB(j)  (1280 + 64 * (j))
#define XB_XGEN(j)  (2304 + 64 * (j))
#define XB_TOP      3328
#define XB_TOPGEN   3392
#define XCD_BAR_WORDS 3456
#define XB_SPIN_CAP (1u << 18)

__device__ __forceinline__ unsigned xb_ld(unsigned* p)              { return __hip_atomic_load(p, __ATOMIC_RELAXED, __HIP_MEMORY_SCOPE_AGENT); }
__device__ __forceinline__ unsigned xb_add(unsigned* p, unsigned v) { return __hip_atomic_fetch_add(p, v, __ATOMIC_RELAXED, __HIP_MEMORY_SCOPE_AGENT); }
__device__ __forceinline__ unsigned xb_xcc_id() { return (unsigned)__builtin_amdgcn_s_getreg((3 << 11) | 20) & 0xFu; }
#define XB_SPIN(cond, bar) do { unsigned _sp = 0; while (cond) { __builtin_amdgcn_s_sleep(1); \
    if ((++_sp & 255u) == 0u) { if (xb_ld(&(bar)[XB_TMO])) break; if (_sp > XB_SPIN_CAP) { atomicAdd(&(bar)[XB_TMO], 1u); break; } } } } while (0)

struct XcdBarrier {
    unsigned* bar; unsigned x;
    volatile LAS unsigned* st;
};

__device__ __forceinline__ XcdBarrier xcd_barrier_post(unsigned* bar, volatile LAS unsigned* st) {
    XcdBarrier b; b.bar = bar; b.x = xb_xcc_id(); b.st = st;
    if (threadIdx.x == 0) (void)xb_add(&bar[XB_XCNT(b.x)], 1u);
    return b;
}
__device__ __forceinline__ void xcd_barrier_complete(unsigned* bar, unsigned x, unsigned& nloc, unsigned& nx) {
    const unsigned G = gridDim.x * gridDim.y * gridDim.z;
    unsigned sum, cnt, mine, sp = 0u;
    for (;;) {
        sum = 0u; cnt = 0u; mine = 0u;
#pragma unroll
        for (unsigned j = 0; j < 16; ++j) { const unsigned c = xb_ld(&bar[XB_XCNT(j)]); sum += c; cnt += (c > 0u) ? 1u : 0u; mine = (j == x) ? c : mine; }
        if (sum == G) break;
        __builtin_amdgcn_s_sleep(1);
        if ((++sp & 255u) == 0u) { if (xb_ld(&bar[XB_TMO])) break; if (sp > XB_SPIN_CAP) { atomicAdd(&bar[XB_TMO], 1u); break; } }
    }
    nloc = mine > 0u ? mine : 1u; nx = cnt > 0u ? cnt : 1u;
}

__device__ __forceinline__ void xcd_barrier(const XcdBarrier& b) {
    asm volatile("s_waitcnt vmcnt(0)" ::: "memory");
    __syncthreads();
    if (threadIdx.x == 0) {
        unsigned* bar = b.bar;
        __builtin_amdgcn_s_waitcnt(0);
        unsigned nloc = b.st[0], nx = b.st[1];
        if (nloc == 0u) { xcd_barrier_complete(bar, b.x, nloc, nx); b.st[0] = nloc; b.st[1] = nx; }
        const unsigned old = xb_add(&bar[XB_XSUB(b.x)], 1u);
        const unsigned gen = old / nloc;
        if (old + 1u == (gen + 1u) * nloc) {
            __builtin_amdgcn_fence(__ATOMIC_RELEASE, "agent");
            asm volatile("s_waitcnt vmcnt(0)" ::: "memory");
            const unsigned og = xb_add(&bar[XB_TOP], 1u);
            const unsigned tg = og / nx;
            if (og + 1u == (tg + 1u) * nx) xb_add(&bar[XB_TOPGEN], 1u);
            else XB_SPIN(xb_ld(&bar[XB_TOPGEN]) == tg, bar);
            __builtin_amdgcn_fence(__ATOMIC_ACQUIRE, "agent");
            xb_add(&bar[XB_XGEN(b.x)], 1u);
            asm volatile("s_waitcnt vmcnt(0)" ::: "memory");
        } else {
            XB_SPIN(xb_ld(&bar[XB_XGEN(b.x)]) == gen, bar);
            __builtin_amdgcn_fence(__ATOMIC_ACQUIRE, "agent");
            asm volatile("s_waitcnt vmcnt(0)" ::: "memory");
        }
    }
    __syncthreads();
}

constexpr int NWAVES = 8;
#ifndef MK_N_LAUNCHES
#define MK_N_LAUNCHES 1
#endif
constexpr int PER_PHASE = 8;
constexpr int N_LAUNCHES = MK_N_LAUNCHES;

constexpr int BATCH = 2, T = 8192, D = 1024, M = BATCH * T, FF = 4096;
constexpr int NH = 16, HD = 64, NGRP = 2, HPG = 8, NST = 128, CONVD = 1536, CH = 128, NCH = T / CH;
constexpr int GW = 64, GROWS = T / GW, KH = 8, KW = 16;
constexpr int PROJ = 5664, NPROJ = 5888, NMAIN = 4864;
constexpr float EPS = 1e-5f;

constexpr size_t MiB = 1u << 20;
constexpr size_t WS_CTL = 0, CTL_ZERO_BYTES = 65536;
constexpr size_t WS_WIN = 1 * MiB;
constexpr size_t WS_XN = 13 * MiB;
static_assert(WS_XN - WS_WIN == 24u * 256u * 1024u * 2u, "P1Order: XN must start 24 row panels above the weight copy");
constexpr size_t WS_SF = 1 * MiB;
constexpr size_t WS_SB = 33 * MiB;
constexpr size_t WS_ZQ = 65 * MiB;
constexpr size_t WS_XBC = 129 * MiB;
constexpr size_t WS_K = 177 * MiB;
constexpr size_t WS_V = 209 * MiB;
constexpr size_t WS_DT = 241 * MiB;
constexpr size_t WS_DEC = 255 * MiB;
constexpr size_t WS_WOUT = 243 * MiB;
constexpr size_t WS_W1 = 247 * MiB;
constexpr size_t WS_W2 = 189 * MiB;
constexpr size_t WS_XW = 1 * MiB;
constexpr size_t WS_SS = 33 * MiB;
constexpr size_t WS_H = 40 * MiB;
constexpr size_t WS_END = 256 * MiB;
constexpr size_t SC_XST = 0, SC_BN = 32 * MiB, SC_CN = 40 * MiB;
constexpr int CW_TMO = 0, CW_CODE = 1, CW_BAR = 4096;

constexpr int RING_OFF = 0, RING_BYTES = 131072;
constexpr int LDS_BYTES = 163840;
constexpr int LDSCTL_OFF = LDS_BYTES - 512, MISC_OFF = LDSCTL_OFF + 320;
static_assert(MISC_OFF + 128 <= LDS_BYTES, "LDS map");

struct Frame {
    LAS unsigned char* lds;
    volatile LAS unsigned* MISC;
    gu32* ctl;
    int tid, lane, wave;
    int vcu, G;
    const float* in[18]; float* out; unsigned char* ws;
};
#define PL_SWAP(W, m) unsigned a_ = __builtin_bit_cast(unsigned, m), b_ = a_; asm volatile("" : "+v"(b_)); const auto r_ = __builtin_amdgcn_permlane##W##_swap(a_, b_, false, false); \
    unsigned r0_ = r_[0], r1_ = r_[1]; asm volatile("" : "+v"(r0_), "+v"(r1_)); const float x0_ = __builtin_bit_cast(float, r0_), x1_ = __builtin_bit_cast(float, r1_)
__device__ __forceinline__ float red16_max(float m) { PL_SWAP(16, m); return fmaxf(x0_, x1_); }
__device__ __forceinline__ float red32_max(float m) { PL_SWAP(32, m); return fmaxf(x0_, x1_); }
__device__ __forceinline__ float red16_add(float m) { PL_SWAP(16, m); return x0_ + x1_; }
__device__ __forceinline__ float red32_add(float m) { PL_SWAP(32, m); return x0_ + x1_; }
__device__ __forceinline__ float bf2f(bf16 v) { return __builtin_bit_cast(float, (unsigned)v << 16); }
__device__ __forceinline__ float wave_sum(float v) {
#pragma unroll
    for (int o = 1; o < 64; o <<= 1) v += __shfl_xor(v, o);
    return v;
}
__device__ __forceinline__ float silu_f(float x) { return x * __builtin_amdgcn_rcpf(1.0f + __expf(-x)); }

__device__ __forceinline__ void p0_transpose_item(const float* W, int K, int N, bf16* WT, int kb, int src0, int dst0, LAS float* scr, int lane) {
    const int k0 = 64 * kb;
    if (src0 >= 0) {
#pragma unroll 8
        for (int i = 0; i < 32; ++i) { const int kk = 2 * i + (lane >> 5); scr[kk * 33 + (lane & 31)] = W[(size_t)(k0 + kk) * N + src0 + (lane & 31)]; }
    } else {
#pragma unroll 8
        for (int i = 0; i < 32; ++i) { const int kk = 2 * i + (lane >> 5); scr[kk * 33 + (lane & 31)] = 0.f; }
    }
    LDS_WAIT(); asm volatile("" ::: "memory");
    const int c = lane & 7;
#pragma unroll
    for (int j = 0; j < 4; ++j) { const int n = (lane >> 3) + 8 * j; const LAS float* s = scr + (8 * c) * 33 + n;
        v4u o; o.x = pk2(s[0 * 33], s[1 * 33]); o.y = pk2(s[2 * 33], s[3 * 33]); o.z = pk2(s[4 * 33], s[5 * 33]); o.w = pk2(s[6 * 33], s[7 * 33]);
        *(GAS v4u*)(WT + (size_t)(dst0 + n) * K + k0 + 8 * c) = o; }
    LDS_WAIT(); asm volatile("" ::: "memory");
}
__device__ __forceinline__ int inproj_src(int nb) {
    const int gc = 32 * nb;
    if (gc < 2560) return gc;
    if (gc < 4608) { const int r = gc - 2560, sel = r >> 10, rr = r & 1023, t = rr >> 8, c = rr & 255, bj = c >> 7, wc = (c >> 5) & 3;
        return 2592 + 1024 * sel + 64 * (4 * t + wc) + 32 * bj; }
    if (gc < 4640) return 2560;
    if (gc < 4864) return -1;
    return 4640 + (gc - 4864);
}
__device__ __forceinline__ void rms_row_to_bf16(int lane, const float* xrow, const float* w, bf16* orow) {
    const GAS f32x4* xr = (const GAS f32x4*)xrow + lane; const GAS f32x4* wr = (const GAS f32x4*)w + lane;
    f32x4 v[4]; float s = 0.f;
#pragma unroll
    for (int j = 0; j < 4; ++j) { v[j] = xr[64 * j]; s += (v[j].x * v[j].x + v[j].y * v[j].y) + (v[j].z * v[j].z + v[j].w * v[j].w); }
    const float rstd = 1.f / sqrtf(wave_sum(s) * (1.f / D) + EPS);
    GAS unsigned long long* o8 = (GAS unsigned long long*)orow + lane;
#pragma unroll
    for (int j = 0; j < 4; ++j) { const f32x4 ww = wr[64 * j];
        o8[64 * j] = (unsigned long long)pk2(v[j].x * rstd * ww.x, v[j].y * rstd * ww.y) | ((unsigned long long)pk2(v[j].z * rstd * ww.z, v[j].w * rstd * ww.w) << 32); }
}
__device__ __forceinline__ void p0_prologue(Frame& F) {
    LAS float* scr = (LAS float*)(F.lds + RING_OFF + F.wave * 16384);
    const int gw = F.vcu * NWAVES + F.wave, NGW = F.G * NWAVES;
    bf16* WinT = (bf16*)(F.ws + WS_WIN);
    constexpr int NITEMS = (D / 64) * (NPROJ / 32);
    for (int it = gw; it < NITEMS; it += NGW) { const int kb = it / (NPROJ / 32), nb = it % (NPROJ / 32);
        p0_transpose_item(F.in[2], D, PROJ, WinT, kb, inproj_src(nb), 32 * nb, scr, F.lane); }
    bf16* XN = (bf16*)(F.ws + WS_XN);
    for (int m = gw; m < M; m += NGW) rms_row_to_bf16(F.lane, F.in[0] + (size_t)m * D, F.in[1], XN + (size_t)m * D);
}
constexpr int WL_IO = (2048 / 64) * (1024 / 32), WL_I1 = (1024 / 64) * (4096 / 32), WL_I2 = (4096 / 64) * (1024 / 32);
__device__ __forceinline__ int skew_n(int G) { return (G >> 4) * 8 + ((G & 15) > 8 ? (G & 15) - 8 : 0); }
__device__ __forceinline__ bool skew_on(int G) { return skew_n(G) >= 32; }
__device__ __forceinline__ void p_weights_late(Frame& F, int lo, int hi, int rank, int nworkers) {
    LAS float* scr = (LAS float*)(F.lds + RING_OFF + F.wave * 16384);
    const int gw = rank * NWAVES + F.wave, NGW = nworkers * NWAVES;
    constexpr int I_O = WL_IO, I_1 = WL_I1;
    for (int it = lo + gw; it < hi; it += NGW) {
        int r = it;
        if (r < I_O) { p0_transpose_item(F.in[14], 2048, 1024, (bf16*)(F.ws + WS_WOUT), r / 32, 32 * (r % 32), 32 * (r % 32), scr, F.lane); continue; } r -= I_O;
        if (r < I_1) { p0_transpose_item(F.in[16], 1024, 4096, (bf16*)(F.ws + WS_W1), r / 128, 32 * (r % 128), 32 * (r % 128), scr, F.lane); continue; } r -= I_1;
        p0_transpose_item(F.in[17], 4096, 1024, (bf16*)(F.ws + WS_W2), r / 32, 32 * (r % 32), 32 * (r % 32), scr, F.lane);
    }
}

__device__ __forceinline__ void ssd_scan(Frame& F, const int dry) {
    const float* DEC = (const float*)(F.ws + WS_DEC);
    for (int gid = F.vcu * 512 + F.tid; gid < 2 * BATCH * NH * 2048; gid += F.G * 512) {
        const int dir = gid >> 16, rem = gid & 65535, b = rem >> 15, h = (rem >> 11) & 15, e4 = rem & 2047;
        unsigned long long* S = (unsigned long long*)(F.ws + (dir ? WS_SB : WS_SF)) + e4;
        const float* dec = DEC + dir * (BATCH * NCH * NH);
        float h0 = 0.f, h1 = 0.f, h2 = 0.f, h3 = 0.f;
        unsigned long long va[16], vb[16]; float da[16], db[16];
#define SCAN_ITEM(cc) ((b * NCH + (dir ? NCH - 1 - (cc) : (cc))) * NH + h)
#define SCAN_LOAD(V, Dv, bt) do { _Pragma("unroll") for (int i = 0; i < 16; ++i) { const int it_ = SCAN_ITEM(16 * (bt) + i); V[i] = S[(size_t)it_ * 2048]; Dv[i] = dec[it_]; } } while (0)
#define SCAN_PROC(V, Dv, bt) do { _Pragma("unroll") for (int i = 0; i < 16; ++i) { const int it_ = SCAN_ITEM(16 * (bt) + i); const unsigned long long v = V[i]; const float d = Dv[i]; \
            if (!dry) S[(size_t)it_ * 2048] = (unsigned long long)pk2(h0, h1) | ((unsigned long long)pk2(h2, h3) << 32); \
            h0 = d * h0 + __builtin_bit_cast(float, (unsigned)v << 16); h1 = d * h1 + __builtin_bit_cast(float, (unsigned)v & 0xffff0000u); \
            h2 = d * h2 + __builtin_bit_cast(float, (unsigned)(v >> 32) << 16); h3 = d * h3 + __builtin_bit_cast(float, (unsigned)(v >> 32) & 0xffff0000u); } } while (0)
        SCAN_LOAD(va, da, 0);
        SCAN_LOAD(vb, db, 1); SCAN_PROC(va, da, 0);
        SCAN_LOAD(va, da, 2); SCAN_PROC(vb, db, 1);
        SCAN_LOAD(vb, db, 3); SCAN_PROC(va, da, 2);
        SCAN_PROC(vb, db, 3);
#undef SCAN_ITEM
#undef SCAN_LOAD
#undef SCAN_PROC
    }
}

typedef float f32x16 __attribute__((ext_vector_type(16)));
typedef unsigned u32x2v __attribute__((ext_vector_type(2)));
constexpr int V_ACF = 0, V_RCB = 128, V_DTF = 256, V_DTB = 384, V_CFF = 512, V_CFB = 640, V_EF = 768, V_EB = 896;
__device__ __forceinline__ float bflo(unsigned u) { return __builtin_bit_cast(float, u << 16); }
__device__ __forceinline__ float bfhi(unsigned u) { return __builtin_bit_cast(float, u & 0xffff0000u); }
__device__ __forceinline__ void ssd_out_mfma(Frame& F, const int dry) {
    LAS unsigned char* CBs = F.lds;
    LAS unsigned char* Cs = F.lds + 16384;
    LAS float* vecs = (LAS float*)(F.lds + 32768) + F.wave * 1024;
    LAS float* rowss = (LAS float*)(F.lds + 69632);
    LAS float* rstdv = rowss + 512;
    bf16* ZQ = (bf16*)(F.ws + WS_ZQ); const float* DT = (const float*)(F.ws + WS_DT);
    const bf16* SF = (const bf16*)(F.ws + WS_SF); const bf16* SB = (const bf16*)(F.ws + WS_SB);
    const bf16* XST = (const bf16*)((const unsigned char*)F.out + SC_XST); const bf16* BN = (const bf16*)((const unsigned char*)F.out + SC_BN); const bf16* CN = (const bf16*)((const unsigned char*)F.out + SC_CN);
    const int w = F.wave;
    for (int item = F.vcu; item < BATCH * NCH * NGRP * 2; item += F.G) {
        int lane = F.lane; asm volatile("" : "+v"(lane));
        const int r = lane & 31, hp = lane >> 5;
        const int half = item & 1, g = (item >> 1) & 1, bc = item >> 2, m0 = bc * CH, h = HPG * g + w, L0 = 64 * half;
        const bf16* xst = XST + (size_t)(bc * NH + h) * (HD * CH);
        const size_t sbase = (size_t)(bc * NH + h) * (HD * NST);
        bf16x8 xsf[2][8], bfr[8];
        { const bf16* bn = BN + ((size_t)(bc * NGRP + g) * CH + 32 * (w & 3) + r) * NST + 8 * hp;
#pragma unroll
          for (int ks = 0; ks < 8; ++ks) bfr[ks] = *(const bf16x8*)(bn + 16 * ks);
#pragma unroll
          for (int pt = 0; pt < 2; ++pt)
#pragma unroll
              for (int ks = 0; ks < 8; ++ks) xsf[pt][ks] = *(const bf16x8*)(xst + (size_t)(32 * pt + r) * CH + 16 * ks + 8 * hp); }
        { const int row = F.tid >> 3, ch2 = 2 * (F.tid & 7); const v4u* src = (const v4u*)(CN + ((size_t)(bc * NGRP + g) * CH + L0 + row) * NST + 8 * ch2);
          const v4u a = src[0], b2 = src[1];
          *(LAS v4u*)(Cs + row * 256 + ((ch2 ^ (row & 15)) << 4)) = a; *(LAS v4u*)(Cs + row * 256 + (((ch2 + 1) ^ (row & 15)) << 4)) = b2; }
        {
            const float Af = -__expf(F.in[7][h]), Ab = -__expf(F.in[8][h]);
            const int l0 = 2 * lane;
            const float df0 = DT[(size_t)(m0 + l0) * 32 + h], df1 = DT[(size_t)(m0 + l0 + 1) * 32 + h], db0 = DT[(size_t)(m0 + l0) * 32 + 16 + h], db1 = DT[(size_t)(m0 + l0 + 1) * 32 + 16 + h];
            const float a0 = df0 * Af, a1 = df1 * Af, b0 = db0 * Ab, b1 = db1 * Ab;
            float x = a0 + a1, y = b0 + b1;
#pragma unroll
            for (int off = 1; off < 64; off <<= 1) { const float t = __shfl_up(x, off), u = __shfl_down(y, off); if (lane >= off) x += t; if (lane + off < 64) y += u; }
            const float acf0 = x - a1, acf1 = x, rcb0 = y, rcb1 = y - b0;
            vecs[V_ACF + l0] = acf0; vecs[V_ACF + l0 + 1] = acf1; vecs[V_RCB + l0] = rcb0; vecs[V_RCB + l0 + 1] = rcb1;
            vecs[V_DTF + l0] = df0; vecs[V_DTF + l0 + 1] = df1; vecs[V_DTB + l0] = db0; vecs[V_DTB + l0 + 1] = db1;
            vecs[V_EF + l0] = __expf(acf0); vecs[V_EF + l0 + 1] = __expf(acf1); vecs[V_EB + l0] = __expf(rcb0); vecs[V_EB + l0 + 1] = __expf(rcb1);
            LDS_WAIT(); asm volatile("" ::: "memory");
            const int kb = l0 >> 4; const float Rf = vecs[V_ACF + 16 * kb + 15], Rb = vecs[V_RCB + 16 * kb];
            vecs[V_CFF + l0] = __expf(Rf - acf0) * df0; vecs[V_CFF + l0 + 1] = __expf(Rf - acf1) * df1;
            vecs[V_CFB + l0] = __expf(Rb - rcb0) * db0; vecs[V_CFB + l0 + 1] = __expf(Rb - rcb1) * db1;
        }
        {
            const int lt = w >> 2, st = w & 3, crow = 32 * lt + r;
            __syncthreads();
            f32x16 c = {};
#pragma unroll
            for (int ks = 0; ks < 8; ++ks) { const bf16x8 a = *(const LAS bf16x8*)(Cs + crow * 256 + (((2 * ks + hp) ^ (crow & 15)) << 4)); c = __builtin_amdgcn_mfma_f32_32x32x16_bf16(a, bfr[ks], c, 0, 0, 0); }
            const int s = 32 * st + r;
#pragma unroll
            for (int reg = 0; reg < 16; ++reg) { const int l = 32 * lt + (reg & 3) + 8 * (reg >> 2) + 4 * hp;
                *(LAS bf16*)(CBs + l * 256 + ((((s >> 3) ^ (l & 15))) << 4) + (s & 7) * 2) = (bf16)pk2(c[reg], 0.f); }
        }
        __syncthreads();
        f32x16 acc[2][2];
#pragma unroll
        for (int a = 0; a < 2; ++a)
#pragma unroll
            for (int b = 0; b < 2; ++b) acc[a][b] = (f32x16){};
        bf16x8 hbA[8], hbB[8];
#define SSD_HLOAD(HB, dir, pt) do { const bf16* hrow_ = ((dir) ? SB : SF) + sbase + (size_t)(32 * (pt) + r) * NST + 8 * hp; \
            _Pragma("unroll") for (int ks = 0; ks < 8; ++ks) HB[ks] = *(const bf16x8*)(hrow_ + 16 * ks); } while (0)
        SSD_HLOAD(hbA, 0, 0);
        __builtin_amdgcn_sched_barrier(0);
        {
            float acl[2], rcl[2];
#pragma unroll
            for (int lt = 0; lt < 2; ++lt) { acl[lt] = vecs[V_ACF + L0 + 32 * lt + r]; rcl[lt] = vecs[V_RCB + L0 + 32 * lt + r]; }
#pragma unroll
            for (int ks = 0; ks < 8; ++ks) {
                const int s0 = 16 * ks + 8 * hp;
#pragma unroll
                for (int lt = 0; lt < 2; ++lt) {
                    const int lrow = 32 * lt + r, l = L0 + lrow, kd = 4 * half + 2 * lt;
                    const v4u cbv = *(const LAS v4u*)(CBs + lrow * 256 + (((2 * ks + hp) ^ (lrow & 15)) << 4));
                    float gv[8];
#pragma unroll
                    for (int e = 0; e < 4; ++e) { gv[2 * e] = bflo(cbv[e]); gv[2 * e + 1] = bfhi(cbv[e]); }
                    if (ks < kd) {
                        const float rf = __expf(acl[lt] - vecs[V_ACF + 16 * ks + 15]);
                        const f32x4 c0 = *(const LAS f32x4*)(vecs + V_CFF + s0), c1 = *(const LAS f32x4*)(vecs + V_CFF + s0 + 4);
#pragma unroll
                        for (int j = 0; j < 4; ++j) { gv[j] *= c0[j] * rf; gv[4 + j] *= c1[j] * rf; }
                    } else if (ks > kd + 1) {
                        const float rb = __expf(rcl[lt] - vecs[V_RCB + 16 * ks]);
                        const f32x4 c0 = *(const LAS f32x4*)(vecs + V_CFB + s0), c1 = *(const LAS f32x4*)(vecs + V_CFB + s0 + 4);
#pragma unroll
                        for (int j = 0; j < 4; ++j) { gv[j] *= c0[j] * rb; gv[4 + j] *= c1[j] * rb; }
                    } else {
#pragma unroll
                        for (int q = 0; q < 2; ++q) {
                            const f32x4 af = *(const LAS f32x4*)(vecs + V_ACF + s0 + 4 * q), rb = *(const LAS f32x4*)(vecs + V_RCB + s0 + 4 * q);
                            const f32x4 df = *(const LAS f32x4*)(vecs + V_DTF + s0 + 4 * q), db = *(const LAS f32x4*)(vecs + V_DTB + s0 + 4 * q);
#pragma unroll
                            for (int j = 0; j < 4; ++j) { const int s = s0 + 4 * q + j;
                                const float tf = __expf(fminf(acl[lt] - af[j], 0.f)) * df[j], tb = __expf(fminf(rcl[lt] - rb[j], 0.f)) * db[j];
                                const float mm = (l >= s ? tf : 0.f) + (l <= s ? tb : 0.f);
                                gv[4 * q + j] *= mm; }
                        }
                    }
                    v4u gp; gp.x = pk2(gv[0], gv[1]); gp.y = pk2(gv[2], gv[3]); gp.z = pk2(gv[4], gv[5]); gp.w = pk2(gv[6], gv[7]);
                    const bf16x8 ga = __builtin_bit_cast(bf16x8, gp);
#pragma unroll
                    for (int pt = 0; pt < 2; ++pt) acc[lt][pt] = __builtin_amdgcn_mfma_f32_32x32x16_bf16(ga, xsf[pt][ks], acc[lt][pt], 0, 0, 0);
                }
            }
        }
        __builtin_amdgcn_sched_barrier(0);
        SSD_HLOAD(hbB, 0, 1);
        __builtin_amdgcn_sched_barrier(0);
        {
#define SSD_YOFF(HB, dir, pt) do { f32x16 t0 = {}, t1 = {}; \
            _Pragma("unroll") for (int ks = 0; ks < 8; ++ks) { \
                const bf16x8 c0 = *(const LAS bf16x8*)(Cs + r * 256 + (((2 * ks + hp) ^ (r & 15)) << 4)), c1 = *(const LAS bf16x8*)(Cs + (32 + r) * 256 + (((2 * ks + hp) ^ (r & 15)) << 4)); \
                t0 = __builtin_amdgcn_mfma_f32_32x32x16_bf16(c0, HB[ks], t0, 0, 0, 0); t1 = __builtin_amdgcn_mfma_f32_32x32x16_bf16(c1, HB[ks], t1, 0, 0, 0); } \
            _Pragma("unroll") for (int q = 0; q < 4; ++q) { \
                const f32x4 e0 = *(const LAS f32x4*)(vecs + ((dir) ? V_EB : V_EF) + L0 + 8 * q + 4 * hp), e1 = *(const LAS f32x4*)(vecs + ((dir) ? V_EB : V_EF) + L0 + 32 + 8 * q + 4 * hp); \
                _Pragma("unroll") for (int i = 0; i < 4; ++i) { acc[0][pt][4 * q + i] += e0[i] * t0[4 * q + i]; acc[1][pt][4 * q + i] += e1[i] * t1[4 * q + i]; } } \
            asm volatile("" : "+v"(acc[0][pt]), "+v"(acc[1][pt])); __builtin_amdgcn_sched_barrier(0); } while (0)
            SSD_YOFF(hbA, 0, 0); SSD_HLOAD(hbA, 1, 0); __builtin_amdgcn_sched_barrier(0);
            SSD_YOFF(hbB, 0, 1); SSD_HLOAD(hbB, 1, 1); __builtin_amdgcn_sched_barrier(0);
            SSD_YOFF(hbA, 1, 0);
            SSD_YOFF(hbB, 1, 1);
#undef SSD_YOFF
#undef SSD_HLOAD
            const float Dh = F.in[9][h];
#pragma unroll
            for (int lt = 0; lt < 2; ++lt)
#pragma unroll
                for (int pt = 0; pt < 2; ++pt)
#pragma unroll
                    for (int q = 0; q < 4; ++q) { const u32x2v xv = *(const u32x2v*)(xst + (size_t)(32 * pt + r) * CH + L0 + 32 * lt + 8 * q + 4 * hp);
                        acc[lt][pt][4 * q] += Dh * bflo(xv.x); acc[lt][pt][4 * q + 1] += Dh * bfhi(xv.x); acc[lt][pt][4 * q + 2] += Dh * bflo(xv.y); acc[lt][pt][4 * q + 3] += Dh * bfhi(xv.y); }
        }
        {
            __syncthreads();
            LAS float* stg = (LAS float*)(F.lds) + w * (32 * 68);
            const int row = lane >> 1, pc = (lane & 1) * 32;
            float gt[2][32];
#pragma unroll
            for (int lt = 0; lt < 2; ++lt) {
#pragma unroll
                for (int reg = 0; reg < 16; ++reg) { const int rr = (reg & 3) + 8 * (reg >> 2) + 4 * hp; stg[rr * 68 + r] = acc[lt][0][reg]; stg[rr * 68 + 32 + r] = acc[lt][1][reg]; }
                LDS_WAIT(); asm volatile("" ::: "memory");
                const bf16* zr = ZQ + (size_t)(m0 + L0 + 32 * lt + row) * 2048 + h * HD + pc;
                float ss = 0.f;
#pragma unroll
                for (int c = 0; c < 4; ++c) { const v4u zv = *(const v4u*)(zr + 8 * c); const f32x4 y0 = *(const LAS f32x4*)(stg + row * 68 + pc + 8 * c), y1 = *(const LAS f32x4*)(stg + row * 68 + pc + 8 * c + 4);
#pragma unroll
                    for (int e = 0; e < 4; ++e) { const float ya = e < 2 ? y0[2 * e] : y1[2 * e - 4], yb = e < 2 ? y0[2 * e + 1] : y1[2 * e - 3];
                        const float ga = ya * silu_f(bflo(zv[e])), gb = yb * silu_f(bfhi(zv[e])); gt[lt][8 * c + 2 * e] = ga; gt[lt][8 * c + 2 * e + 1] = gb; ss += ga * ga + gb * gb; } }
                ss += __shfl_xor(ss, 1);
                if ((lane & 1) == 0) rowss[(32 * lt + row) * 8 + w] = ss;
                LDS_WAIT(); asm volatile("" ::: "memory");
            }
            __syncthreads();
            if (F.tid < 64) { const f32x4 a = *(const LAS f32x4*)(rowss + F.tid * 8), b = *(const LAS f32x4*)(rowss + F.tid * 8 + 4);
                rstdv[F.tid] = 1.0f / sqrtf(((a[0] + a[1]) + (a[2] + a[3]) + (b[0] + b[1]) + (b[2] + b[3])) * (1.0f / 512.0f) + EPS); }
            __syncthreads();
            const float* nwp = F.in[10] + h * HD + pc;
#pragma unroll
            for (int lt = 0; lt < 2; ++lt) { const float rs = rstdv[32 * lt + row]; bf16* zo = ZQ + (size_t)(m0 + L0 + 32 * lt + row) * 2048 + h * HD + pc;
#pragma unroll
                for (int c = 0; c < 4; ++c) { const f32x4 w0 = *(const f32x4*)(nwp + 8 * c), w1 = *(const f32x4*)(nwp + 8 * c + 4); v4u o;
                    o.x = pk2(gt[lt][8 * c] * rs * w0[0], gt[lt][8 * c + 1] * rs * w0[1]); o.y = pk2(gt[lt][8 * c + 2] * rs * w0[2], gt[lt][8 * c + 3] * rs * w0[3]);
                    o.z = pk2(gt[lt][8 * c + 4] * rs * w1[0], gt[lt][8 * c + 5] * rs * w1[1]); o.w = pk2(gt[lt][8 * c + 6] * rs * w1[2], gt[lt][8 * c + 7] * rs * w1[3]);
                    if (!dry) *(v4u*)(zo + 8 * c) = o; } }
        }
        __syncthreads();
    }
}


__device__ __forceinline__ void ssd_states_mfma(Frame& F) {
    LAS unsigned char* BT = F.lds;
    LAS unsigned char* XT = F.lds + 32768;
    LAS float* wv = (LAS float*)(F.lds + 98304) + F.wave * 128;
    const bf16* XBC = (const bf16*)(F.ws + WS_XBC); const float* DT = (const float*)(F.ws + WS_DT);
    const float* cw = F.in[3]; const float* cbias = F.in[4];
    bf16* XST = (bf16*)((unsigned char*)F.out + SC_XST); bf16* BN = (bf16*)((unsigned char*)F.out + SC_BN); bf16* CN = (bf16*)((unsigned char*)F.out + SC_CN);
    float* DEC = (float*)(F.ws + WS_DEC);
    const int w = F.wave;
    for (int item = F.vcu; item < BATCH * NCH * NGRP * 2; item += F.G) {
        const int quad = item & 1, g = (item >> 1) & 1, bc = item >> 2, m0 = bc * CH, tbase = m0 & (T - 1);
        __syncthreads();
        int lane = F.lane; asm volatile("" : "+v"(lane));
        const int r = lane & 31, hp = lane >> 5, hq = w >> 1, dir = w & 1, h = HPG * g + 4 * quad + hq;
        const float Adec = -__expf((dir ? F.in[8] : F.in[7])[h]);
        const float d0 = DT[(size_t)(m0 + 2 * lane) * 32 + 16 * dir + h], d1 = DT[(size_t)(m0 + 2 * lane + 1) * 32 + 16 * dir + h];
        {
            int tid = F.tid; asm volatile("" : "+v"(tid));
            const int rb = tid & 7, cgi = tid >> 3;
            const int kind = cgi < 16 ? 0 : (cgi < 48 ? 1 : 2);
            const int ch0 = kind == 0 ? 1024 + NST * g + 8 * cgi : (kind == 1 ? HD * (HPG * g + 4 * quad) + 8 * (cgi - 16) : 1280 + NST * g + 8 * (cgi - 48));
            if (kind != 2 || quad == 0) {
                v4u in[20];
#pragma unroll
                for (int i = 0; i < 20; ++i) { const int t = tbase + 16 * rb - 2 + i; v4u z = {0u, 0u, 0u, 0u};
                    in[i] = (t >= 0 && t < T) ? *(const v4u*)(XBC + (size_t)(m0 + 16 * rb - 2 + i) * CONVD + ch0) : z; }
                f32x4 wk[5][2], bb[2];
#pragma unroll
                for (int k = 0; k < 5; ++k) { wk[k][0] = *(const f32x4*)(cw + k * CONVD + ch0); wk[k][1] = *(const f32x4*)(cw + k * CONVD + ch0 + 4); }
                bb[0] = *(const f32x4*)(cbias + ch0); bb[1] = *(const f32x4*)(cbias + ch0 + 4);
#pragma unroll
                for (int hf = 0; hf < 2; ++hf) {
                    const int lr0 = 16 * rb + 8 * hf;
                    unsigned tp[8][4];
                    f32x4 prev[2];
#pragma unroll
                    for (int o = 0; o < 8; ++o) {
                        f32x4 y0 = bb[0], y1 = bb[1];
#pragma unroll
                        for (int k = 0; k < 5; ++k) { const v4u xv = in[8 * hf + o + k];
                            const f32x4 x0 = {bflo(xv.x), bfhi(xv.x), bflo(xv.y), bfhi(xv.y)}, x1 = {bflo(xv.z), bfhi(xv.z), bflo(xv.w), bfhi(xv.w)};
                            y0 += wk[k][0] * x0; y1 += wk[k][1] * x1; }
#pragma unroll
                        for (int e = 0; e < 4; ++e) { y0[e] = silu_f(y0[e]); y1[e] = silu_f(y1[e]); }
                        if (kind != 1 && quad == 0) {
                            v4u o4; o4.x = pk2(y0[0], y0[1]); o4.y = pk2(y0[2], y0[3]); o4.z = pk2(y1[0], y1[1]); o4.w = pk2(y1[2], y1[3]);
                            bf16* dst = (kind == 0 ? BN : CN) + ((size_t)(bc * NGRP + g) * CH + lr0 + o) * NST + 8 * (kind == 0 ? cgi : cgi - 48);
                            *(v4u*)dst = o4; }
                        if (o & 1) {
#pragma unroll
                            for (int e = 0; e < 4; ++e) { tp[e][o >> 1] = pk2(prev[0][e], y0[e]); tp[4 + e][o >> 1] = pk2(prev[1][e], y1[e]); }
                        } else { prev[0] = y0; prev[1] = y1; }
                    }
                    const int chunk = 2 * rb + hf;
                    if (kind == 0) {
#pragma unroll
                        for (int c = 0; c < 8; ++c) { const int n = 8 * cgi + c; v4u v = {tp[c][0], tp[c][1], tp[c][2], tp[c][3]}; *(LAS v4u*)(BT + n * 256 + ((chunk ^ (n & 15)) << 4)) = v; }
                    } else if (kind == 1) {
#pragma unroll
                        for (int c = 0; c < 8; ++c) { const int pp = 8 * (cgi - 16) + c; v4u v = {tp[c][0], tp[c][1], tp[c][2], tp[c][3]}; *(LAS v4u*)(XT + pp * 256 + ((chunk ^ (pp & 15)) << 4)) = v;
                            *(v4u*)(XST + ((size_t)(bc * NH + HPG * g + 4 * quad) * HD + pp) * CH + lr0) = v; }
                    }
                }
            }
        }
        float total;
        {
            const int l0 = 2 * lane; const float a0 = d0 * Adec, a1 = d1 * Adec;
            float x = a0 + a1, y = x;
#pragma unroll
            for (int off = 1; off < 64; off <<= 1) { const float t = __shfl_up(x, off), u = __shfl_down(y, off); if (lane >= off) x += t; if (lane + off < 64) y += u; }
            total = __shfl(x, 63);
            const float e0 = dir ? y : x - a1, e1 = dir ? y - a0 : x;
            wv[l0] = d0 * __expf(total - e0); wv[l0 + 1] = d1 * __expf(total - e1);
        }
        __syncthreads();
        f32x16 acc[4][2];
#pragma unroll
        for (int a = 0; a < 4; ++a)
#pragma unroll
            for (int b = 0; b < 2; ++b) acc[a][b] = (f32x16){};
#pragma unroll 2
        for (int ks = 0; ks < 8; ++ks) {
            const int chunk = 2 * ks + hp;
            bf16x8 af[4], bfr[2];
#pragma unroll
            for (int nt = 0; nt < 4; ++nt) { const int n = 32 * nt + r; af[nt] = *(const LAS bf16x8*)(BT + n * 256 + ((chunk ^ (n & 15)) << 4)); }
            const f32x4 w0 = *(const LAS f32x4*)(wv + 16 * ks + 8 * hp), w1 = *(const LAS f32x4*)(wv + 16 * ks + 8 * hp + 4);
#pragma unroll
            for (int pt = 0; pt < 2; ++pt) { const int pp = 64 * hq + 32 * pt + r; const v4u xv = *(const LAS v4u*)(XT + pp * 256 + ((chunk ^ (pp & 15)) << 4));
                v4u sv; sv.x = pk2(bflo(xv.x) * w0[0], bfhi(xv.x) * w0[1]); sv.y = pk2(bflo(xv.y) * w0[2], bfhi(xv.y) * w0[3]);
                sv.z = pk2(bflo(xv.z) * w1[0], bfhi(xv.z) * w1[1]); sv.w = pk2(bflo(xv.w) * w1[2], bfhi(xv.w) * w1[3]);
                bfr[pt] = __builtin_bit_cast(bf16x8, sv); }
#pragma unroll
            for (int nt = 0; nt < 4; ++nt)
#pragma unroll
                for (int pt = 0; pt < 2; ++pt) acc[nt][pt] = __builtin_amdgcn_mfma_f32_32x32x16_bf16(af[nt], bfr[pt], acc[nt][pt], 0, 0, 0);
        }
        asm volatile("s_waitcnt lgkmcnt(0)" ::: "memory"); __syncthreads();
        {
            LAS unsigned char* stg = F.lds + w * (64 * 264);
#pragma unroll
            for (int nt = 0; nt < 4; ++nt)
#pragma unroll
                for (int pt = 0; pt < 2; ++pt)
#pragma unroll
                    for (int q = 0; q < 4; ++q) { u32x2v o; o.x = pk2(acc[nt][pt][4 * q], acc[nt][pt][4 * q + 1]); o.y = pk2(acc[nt][pt][4 * q + 2], acc[nt][pt][4 * q + 3]);
                        *(LAS u32x2v*)(stg + (32 * pt + r) * 264 + (32 * nt + 8 * q + 4 * hp) * 2) = o; }
            asm volatile("s_waitcnt lgkmcnt(0)" ::: "memory");
            bf16* Sp = (bf16*)(F.ws + (dir ? WS_SB : WS_SF)) + (size_t)(bc * NH + h) * (HD * NST);
#pragma unroll
            for (int j = 0; j < 16; ++j) { const int row = 4 * j + (lane >> 4), ch = lane & 15;
                const u32x2v a = *(const LAS u32x2v*)(stg + row * 264 + ch * 16), b2 = *(const LAS u32x2v*)(stg + row * 264 + ch * 16 + 8);
                v4u o; o.x = a.x; o.y = a.y; o.z = b2.x; o.w = b2.y; *(v4u*)(Sp + (size_t)row * NST + ch * 8) = o; }
            if (lane == 0) DEC[dir * (BATCH * NCH * NH) + bc * NH + h] = __expf(total);
        }
    }
    __syncthreads();
}

struct NaTile { float m, l; f32x4 o[4]; };
__device__ __forceinline__ void na_tile(NaTile& S, const bf16x8 (&kf)[4], const u32x2v (&vl)[4], const u32x2v (&vh)[4], const bf16x8 qf0, const bf16x8 qf1,
                                        const float (&be)[8]) {
    const f32x4 z = {0.f, 0.f, 0.f, 0.f};
    f32x4 s0 = __builtin_amdgcn_mfma_f32_16x16x32_bf16(kf[0], qf0, z, 0, 0, 0); s0 = __builtin_amdgcn_mfma_f32_16x16x32_bf16(kf[1], qf1, s0, 0, 0, 0);
    f32x4 s1 = __builtin_amdgcn_mfma_f32_16x16x32_bf16(kf[2], qf0, z, 0, 0, 0); s1 = __builtin_amdgcn_mfma_f32_16x16x32_bf16(kf[3], qf1, s1, 0, 0, 0);
    float sv[8]; float mx = -1e30f;
#pragma unroll
    for (int ct = 0; ct < 2; ++ct)
#pragma unroll
        for (int reg = 0; reg < 4; ++reg) { const float s = (ct ? s1[reg] : s0[reg]) + be[4 * ct + reg]; sv[4 * ct + reg] = s; mx = fmaxf(mx, s); }
    mx = red32_max(red16_max(mx));
    const float mn = fmaxf(S.m, mx), alpha = __builtin_amdgcn_exp2f(S.m - mn); S.m = mn;
    float ps = 0.f;
#pragma unroll
    for (int e = 0; e < 8; ++e) { sv[e] = __builtin_amdgcn_exp2f(sv[e] - mn); ps += sv[e]; }
    S.l = S.l * alpha + ps;
    v4u pb; pb.x = pk2(sv[0], sv[1]); pb.y = pk2(sv[2], sv[3]); pb.z = pk2(sv[4], sv[5]); pb.w = pk2(sv[6], sv[7]);
    const bf16x8 pf = __builtin_bit_cast(bf16x8, pb);
#pragma unroll
    for (int dt = 0; dt < 4; ++dt) { v4u vv; vv.x = vl[dt].x; vv.y = vl[dt].y; vv.z = vh[dt].x; vv.w = vh[dt].y;
        S.o[dt] = __builtin_amdgcn_mfma_f32_16x16x32_bf16(__builtin_bit_cast(bf16x8, vv), pf, S.o[dt] * alpha, 0, 0, 0); }
}
constexpr int NA_SLOT = 16384, NA_NSLOT = 9, NA_BIAS_OFF = NA_SLOT * NA_NSLOT;
__device__ __forceinline__ int na_r0(int i) { int r = i - KH / 2; return r < 0 ? 0 : (r > GROWS - KH ? GROWS - KH : r); }
__device__ __forceinline__ void na_mfma(Frame& F, const int dry) {
    LAS unsigned char* ring = F.lds;
    LAS float* bias = (LAS float*)(F.lds + NA_BIAS_OFF);
    bf16* ZQ = (bf16*)(F.ws + WS_ZQ); const bf16* KB = (const bf16*)(F.ws + WS_K); const bf16* VT = (const bf16*)(F.ws + WS_V);
    const int w = F.wave;
    constexpr int NITEM = BATCH * NH * (GROWS / 16);
    for (int item = F.vcu; item < NITEM; item += F.G) {
        const int bh = item >> 3, band = item & 7, b = bh / NH, hh = bh % NH;
        __syncthreads();
        for (int u = F.tid; u < 15 * 31; u += NWAVES * 64) bias[u] = F.in[13][hh * 465 + u];
        int lane = F.lane; asm volatile("" : "+v"(lane));
        const int c = lane & 15, g4 = lane >> 4, qrow = w >> 2, jb = w & 3, j0 = 16 * jb, j = j0 + c;
        int cs = j0 - 8; cs = cs < 0 ? 0 : (cs > 32 ? 32 : cs);
        int c0 = j - 8; c0 = c0 < 0 ? 0 : (c0 > GW - KW ? GW - KW : c0);
        const int kc0 = cs + 4 * g4, bcol = kc0 - j + 15;
        const int prow = 8 * w + (lane >> 3), lchunk = (lane & 7) ^ ((prow >> 1) & 7);
        const bf16* ksrc = KB + ((size_t)b * T + prow) * 1024 + hh * HD + 8 * lchunk;
        const bf16* vsrc = VT + (size_t)(hh * HD + prow) * M + (size_t)b * T + 8 * lchunk;
#define NA_DMA(kr) do { const int kr_ = (kr); LAS unsigned char* sl_ = ring + (kr_ % NA_NSLOT) * NA_SLOT + w * 1024; \
            __builtin_amdgcn_global_load_lds((const unsigned*)(ksrc + (size_t)kr_ * GW * 1024), (LAS unsigned*)(sl_), 16, 0, 0); \
            __builtin_amdgcn_global_load_lds((const unsigned*)(vsrc + (size_t)kr_ * GW), (LAS unsigned*)(sl_ + 8192), 16, 0, 0); } while (0)
        int koff[4], voff[4], voffh[4];
#pragma unroll
        for (int ct = 0; ct < 2; ++ct)
#pragma unroll
            for (int ks = 0; ks < 2; ++ks) { const int tok = cs + 16 * ct + c; koff[2 * ct + ks] = tok * 128 + (((4 * ks + g4) ^ ((tok >> 1) & 7)) << 4); }
        const int vob = ((cs + 4 * g4) * 2) & 15, vlc = ((cs + 4 * g4) * 2) >> 4;
#pragma unroll
        for (int dt = 0; dt < 4; ++dt) { const int d = 16 * dt + c; voff[dt] = 8192 + d * 128 + vob + ((vlc ^ ((d >> 1) & 7)) << 4); voffh[dt] = 8192 + d * 128 + vob + (((vlc + 2) ^ ((d >> 1) & 7)) << 4); }
        const int i00 = 16 * band;
        { const int rA = na_r0(i00), rB = na_r0(i00 + 1); for (int kr = rA; kr < rB + KH; ++kr) NA_DMA(kr); }
        bf16* qp = ZQ + ((size_t)b * T + (i00 + qrow) * GW + j) * 2048 + 1024 + hh * HD;
        bf16x8 qf0 = *(const bf16x8*)(qp + 8 * g4), qf1 = *(const bf16x8*)(qp + 32 + 8 * g4);
        asm volatile("s_waitcnt vmcnt(0)" ::: "memory"); __syncthreads();
        float be[8][8]; int cur_rel = 1000;
        u32x2v pend[4]; bf16* pendp = qp; bool have_pend = false;
#pragma unroll
        for (int dt = 0; dt < 4; ++dt) pend[dt] = (u32x2v){0u, 0u};
#pragma unroll 1
        for (int it = 0; it < 8; ++it) {
            const int i0 = i00 + 2 * it, i = i0 + qrow, r0 = na_r0(i);
            if (r0 - i != cur_rel) { cur_rel = r0 - i;
#pragma unroll
                for (int s_ = 0; s_ < 8; ++s_)
#pragma unroll
                    for (int ct = 0; ct < 2; ++ct)
#pragma unroll
                        for (int reg = 0; reg < 4; ++reg) { const int kc = kc0 + 16 * ct + reg; const bool ok = (kc >= c0) && (kc < c0 + KW);
                            const float bv = bias[ok ? (cur_rel + s_ + 7) * 31 + bcol + 16 * ct + reg : 0]; be[s_][4 * ct + reg] = ok ? bv * 1.4426950408889634f : -1e30f; } }
            NaTile t; t.m = -1e30f; t.l = 0.f;
#pragma unroll
            for (int dt = 0; dt < 4; ++dt) t.o[dt] = (f32x4){0.f, 0.f, 0.f, 0.f};
#define NA_STEP(s) do { const int kr_ = r0 + (s); const LAS unsigned char* sl_ = ring + (kr_ % NA_NSLOT) * NA_SLOT; bf16x8 kf_[4]; u32x2v vl_[4], vh_[4]; \
                _Pragma("unroll") for (int q_ = 0; q_ < 4; ++q_) kf_[q_] = *(const LAS bf16x8*)(sl_ + koff[q_]); \
                _Pragma("unroll") for (int q_ = 0; q_ < 4; ++q_) { vl_[q_] = *(const LAS u32x2v*)(sl_ + voff[q_]); vh_[q_] = *(const LAS u32x2v*)(sl_ + voffh[q_]); } \
                na_tile(t, kf_, vl_, vh_, qf0, qf1, be[s]); } while (0)
            NA_STEP(0); NA_STEP(1);
            asm volatile("s_waitcnt lgkmcnt(0)" ::: "memory"); __syncthreads();
            if (have_pend && !dry) {
#pragma unroll
                for (int dt = 0; dt < 4; ++dt) *(u32x2v*)(pendp + 16 * dt + 4 * g4) = pend[dt]; }
            bf16x8 nq0 = qf0, nq1 = qf1; bf16* nqp = qp + (size_t)2 * GW * 2048;
            if (it < 7) { const int rB = na_r0(i0 + 1), rB2 = na_r0(i0 + 3); for (int kr = rB + KH; kr < rB2 + KH; ++kr) NA_DMA(kr);
                nq0 = *(const bf16x8*)(nqp + 8 * g4); nq1 = *(const bf16x8*)(nqp + 32 + 8 * g4); }
            NA_STEP(2); NA_STEP(3); NA_STEP(4); NA_STEP(5); NA_STEP(6); NA_STEP(7);
#undef NA_STEP
            { const float l = red32_add(red16_add(t.l)); const float inv = __builtin_amdgcn_rcpf(l);
#pragma unroll
              for (int dt = 0; dt < 4; ++dt) { pend[dt].x = pk2(t.o[dt][0] * inv, t.o[dt][1] * inv); pend[dt].y = pk2(t.o[dt][2] * inv, t.o[dt][3] * inv); } }
            pendp = qp; have_pend = true;
            qp = nqp; qf0 = nq0; qf1 = nq1;
            asm volatile("s_waitcnt vmcnt(0) lgkmcnt(0)" ::: "memory"); __syncthreads();
        }
        if (!dry) {
#pragma unroll
            for (int dt = 0; dt < 4; ++dt) *(u32x2v*)(pendp + 16 * dt + 4 * g4) = pend[dt]; }
#undef NA_DMA
    }
    __syncthreads();
}

struct Args { const float* in[18]; float* out; unsigned char* ws; int ph_lo, ph_hi, li, pad; };
__global__ void __launch_bounds__(NWAVES * 64, 2) skel_fwd(Args args) {
    extern __shared__ __attribute__((aligned(16))) unsigned char lds[];
    Frame F;
    F.lds = (LAS unsigned char*)lds;
    F.MISC = (volatile LAS unsigned*)(F.lds + MISC_OFF);
    F.tid = threadIdx.x; F.lane = F.tid & 63; F.wave = __builtin_amdgcn_readfirstlane(F.tid >> 6);
    F.G = gridDim.x; { const int bx = blockIdx.x; F.vcu = (F.G % 8 == 0) ? (bx % 8) * (F.G / 8) + bx / 8 : bx; }
    F.ws = args.ws; F.out = args.out;
#pragma unroll
    for (int i = 0; i < 18; ++i) F.in[i] = args.in[i];
    F.ctl = (gu32*)(F.ws + WS_CTL);
#define GRID_BAR(seam) do { if (N_LAUNCHES == PER_PHASE) { if (F.tid == 0) __hip_atomic_store(F.ctl + CW_TMO, 0xBADBA0u | (unsigned)(seam), RLX_AGENT); } \
    else { xcd_barrier(bar); } } while (0)
    for (int u = F.tid; u < (LDS_BYTES - LDSCTL_OFF) / 4; u += NWAVES * 64) ((LAS unsigned*)(F.lds + LDSCTL_OFF))[u] = 0u;
    __syncthreads();
    XcdBarrier bar; bar.bar = (unsigned*)(F.ctl + CW_BAR); bar.x = 0; bar.st = nullptr;
    if (N_LAUNCHES != PER_PHASE) bar = xcd_barrier_post((unsigned*)(F.ctl + CW_BAR), F.MISC + 8);
    const int lo = args.ph_lo, hi = args.ph_hi;
#define IN(k) (lo <= (k) && (k) < hi)
#define BOTH(k) (IN(k) && IN((k) + 1))
    unsigned char* ws = F.ws;
#ifndef PROBE_PHASE
#define PROBE_PHASE -1
#endif
    const int dry0 = (PROBE_PHASE < 0) ? 0 : args.pad, dry1 = args.pad + 1;
#define RUN2(k, DRYCALL, CALL) do { if (PROBE_PHASE == (k)) { DRYCALL; __syncthreads(); } CALL; } while (0)
    if (IN(0)) { RUN2(0, p0_prologue(F), p0_prologue(F)); if (BOTH(0)) GRID_BAR(0); }
    if (IN(1)) {
#define P1_BODY do { \
        pg8::Gemm g{(const bf16*)(ws + WS_WIN), (const bf16*)(ws + WS_WIN), M, NMAIN, D}; pg8::P1Order S; S.init(M, NMAIN, F.G, (int)blockIdx.x); \
        pg8::EpiInProj E{(bf16*)(ws + WS_ZQ), (bf16*)(ws + WS_XBC), (bf16*)(ws + WS_K), (bf16*)(ws + WS_V), (float*)(ws + WS_DT), F.in[11], F.in[12], F.in[5], F.in[6]}; \
        pg8::gemm_phase<pg8::EpiInProj, pg8::P1Order, PG8_ALIGN, PG8_SP2>(F.lds + RING_OFF, g, S, E); } while (0)
        { const int c = (int)blockIdx.x; if (skew_on(F.G) && ((c >> 3) & 1)) { p_weights_late(F, 0, WL_IO + WL_I1, (c >> 4) * 8 + (c & 7), skew_n(F.G)); __syncthreads(); } }
        RUN2(1, P1_BODY, P1_BODY);
        if (BOTH(1)) GRID_BAR(1);
    }
    if (IN(2)) { RUN2(2, ssd_states_mfma(F), ssd_states_mfma(F)); RUN2(3, na_mfma(F, dry1), na_mfma(F, dry0)); if (BOTH(2)) GRID_BAR(2); }
    if (IN(3)) { RUN2(4, ssd_scan(F, dry1), ssd_scan(F, dry0)); if (!skew_on(F.G)) p_weights_late(F, 0, WL_IO + WL_I1 + WL_I2, F.vcu, F.G); if (BOTH(3)) GRID_BAR(3); }
    if (IN(4)) { RUN2(6, ssd_out_mfma(F, dry1), ssd_out_mfma(F, dry0)); if (BOTH(4)) GRID_BAR(4); }
    if (IN(5)) {
#define P5_BODY do { pg8::Gemm g{(const bf16*)(ws + WS_ZQ), (const bf16*)(ws + WS_WOUT), M, D, 2048}; pg8::StaticOrder S; S.init(M, D, F.G, (int)blockIdx.x); \
        pg8::EpiOutProj E{F.in[0], F.out, (bf16*)(ws + WS_XW), F.in[15], (float*)(ws + WS_SS)}; \
        pg8::gemm_phase<pg8::EpiOutProj, pg8::StaticOrder, false, PG8_SP2>(F.lds + RING_OFF, g, S, E); } while (0)
        RUN2(7, P5_BODY, P5_BODY);
        if (BOTH(5)) GRID_BAR(5);
    }
    if (IN(6)) {
#define P6_BODY do { pg8::Gemm g{(const bf16*)(ws + WS_XW), (const bf16*)(ws + WS_W1), M, FF, D}; pg8::StaticOrder S; S.init(M, FF, F.G, (int)blockIdx.x); \
        pg8::EpiMlpIn E{(bf16*)(ws + WS_H), (const float*)(ws + WS_SS)}; \
        pg8::gemm_phase<pg8::EpiMlpIn, pg8::StaticOrder, PG8_ALIGN, PG8_SP2>(F.lds + RING_OFF, g, S, E); } while (0)
        { const int c = (int)blockIdx.x; if (skew_on(F.G) && ((c >> 3) & 1)) { p_weights_late(F, WL_IO + WL_I1, WL_IO + WL_I1 + WL_I2, (c >> 4) * 8 + (c & 7), skew_n(F.G)); __syncthreads(); } }
        RUN2(8, P6_BODY, P6_BODY);
        if (BOTH(6)) GRID_BAR(6);
    }
    if (IN(7)) {
#define P7_BODY(DRY) do { pg8::Gemm g{(const bf16*)(ws + WS_H), (const bf16*)(ws + WS_W2), M, D, FF}; pg8::StaticOrder S; S.init(M, D, F.G, (int)blockIdx.x); \
        pg8::EpiMlpOut E{F.out, (const bf16*)(ws + WS_XW), F.in[15], DRY}; \
        pg8::gemm_phase<pg8::EpiMlpOut, pg8::StaticOrder, false, PG8_SP2>(F.lds + RING_OFF, g, S, E); } while (0)
        RUN2(9, P7_BODY(dry1), P7_BODY(dry0));
    }
#undef IN
#undef BOTH
}

extern "C" void kernel_launch(void* const* d_in, const int* in_sizes, int n_in, void* d_out, int out_size, void* d_ws, size_t ws_size, hipStream_t stream) {
    static int grid = 0;
    if (grid == 0) {
        if (n_in != 18 || in_sizes[0] != M * D || out_size != M * D || ws_size < WS_END) { fprintf(stderr, "kernel_launch: unexpected shapes (n_in %d, in0 %d, out %d, ws %zu); nothing launched\n", n_in, n_in > 0 ? in_sizes[0] : -1, out_size, ws_size); grid = -1; return; }
        int dev = 0, cus = 0, per_cu = 0;
        if (hipGetDevice(&dev) != hipSuccess || hipDeviceGetAttribute(&cus, hipDeviceAttributeMultiprocessorCount, dev) != hipSuccess) { grid = -1; return; }
        if (hipFuncSetAttribute((const void*)skel_fwd, hipFuncAttributeMaxDynamicSharedMemorySize, LDS_BYTES) != hipSuccess) { fprintf(stderr, "kernel_launch: hipFuncSetAttribute failed\n"); grid = -1; return; }
        if (hipOccupancyMaxActiveBlocksPerMultiprocessor(&per_cu, (const void*)skel_fwd, NWAVES * 64, LDS_BYTES) != hipSuccess || per_cu < 1)
            fprintf(stderr, "kernel_launch: note: occupancy query reports %d workgroups per CU\n", per_cu);
        (void)hipGetLastError();
        grid = cus;
    }
    if (grid < 0) return;
    if (hipMemsetAsync((char*)d_ws + WS_CTL, 0, CTL_ZERO_BYTES, stream) != hipSuccess) { fprintf(stderr, "kernel_launch: hipMemsetAsync failed\n"); return; }
    Args a{};
    for (int i = 0; i < 18; ++i) a.in[i] = (const float*)d_in[i];
    a.out = (float*)d_out; a.ws = (unsigned char*)d_ws;
    if (N_LAUNCHES == 1) { a.ph_lo = 0; a.ph_hi = PER_PHASE; a.li = 0; hipLaunchKernelGGL(skel_fwd, dim3(grid), dim3(NWAVES * 64), LDS_BYTES, stream, a); }
    else for (int li = 0; li < PER_PHASE; ++li) { a.ph_lo = li; a.ph_hi = li + 1; a.li = li; hipLaunchKernelGGL(skel_fwd, dim3(grid), dim3(NWAVES * 64), LDS_BYTES, stream, a); }
}
```

```cpp
#include <hip/hip_runtime.h>
#include <cstdio>
#include <cstdint>
namespace pg8 {
#define PG8_LAS __attribute__((address_space(3)))
typedef unsigned short bf16_t;
typedef short bf16x8 __attribute__((ext_vector_type(8)));
typedef float f32x4 __attribute__((ext_vector_type(4)));
typedef unsigned u32x4 __attribute__((ext_vector_type(4)));
constexpr int BM = 256, BK = 64, HALF = 128, HTB = HALF * BK * 2  , STAGE_BYTES = 8 * HTB, NXCD = 8, WGM = 4;

__host__ __device__ __forceinline__ int lds_byte(int r, int c) { const int st = (r >> 4) * 2 + (c >> 5), rr = r & 15, cc = c & 31, ob = rr * 64 + cc * 2; return st * 1024 + (ob ^ (((ob >> 9) & 1) << 5)); }
__host__ __device__ __forceinline__ void stage_rc(int b, int& R, int& C) { const int st = b / 1024, sb = b % 1024, swz = sb ^ (((sb >> 9) & 1) << 5); R = (st >> 1) * 16 + swz / 64; C = (st & 1) * 32 + (swz % 64) / 2; }
__host__ __device__ __forceinline__ int perm32(int rho) { const int n = rho >> 4, i = rho & 15; return 8 * (i >> 2) + 4 * n + (i & 3); }

struct Unit { int pm, pn; };
struct Gemm { const bf16_t* A; const bf16_t* Bt; int M, N, K; };

struct StaticOrder {
    int nM, nN, nwg, G, c;
    __host__ __device__ void init(int M, int N, int G_, int c_) { nM = M / BM; nN = N / BM; nwg = nM * nN; G = G_; c = c_; }
    __host__ __device__ bool next(int i, Unit& u) const {
        const long L = (long)i * G + c; if (L >= nwg) return false;
        int wgid = (int)L; { const int q = nwg / NXCD, r = nwg % NXCD, xcd = wgid % NXCD, off = wgid / NXCD; wgid = (xcd < r ? xcd * (q + 1) : r * (q + 1) + (xcd - r) * q) + off; }
        const int nig = WGM * nN, gid = wgid / nig, fm = gid * WGM, gsz = (nM - fm) < WGM ? (nM - fm) : WGM;
        u.pm = fm + ((wgid % nig) % gsz); u.pn = (wgid % nig) / gsz; return true;
    }
    __device__ __forceinline__ void a_ready(const Unit&) const {}
    __device__ __forceinline__ void done(const Unit&) const {}
};

typedef float f32x2_cv __attribute__((ext_vector_type(2))); typedef __bf16 bf16x2_cv __attribute__((ext_vector_type(2)));
__device__ __forceinline__ unsigned cvt_pk_bf16(float lo, float hi) { const f32x2_cv v = {lo, hi}; const bf16x2_cv b = __builtin_convertvector(v, bf16x2_cv); return __builtin_bit_cast(unsigned, b); }
typedef float f32x2 __attribute__((ext_vector_type(2)));
__device__ __forceinline__ f32x2 gelu_pk(f32x2 v) {
    const f32x2 av = __builtin_elementwise_abs(v), d = av * 0.2316418882f + 1.0f;
    f32x2 t; t.x = __builtin_amdgcn_rcpf(d.x); t.y = __builtin_amdgcn_rcpf(d.y);
    f32x2 q = t * 0.5307027145f + (-0.7265760135f); q = q * t + 0.7107068705f; q = q * t + (-0.142248368f); q = q * t + 0.127414796f; q = q * t;
    const f32x2 s = (v * v) * (-0.72134752044f);
    f32x2 e; e.x = __builtin_amdgcn_exp2f(s.x); e.y = __builtin_amdgcn_exp2f(s.y);
    const f32x2 m = v * (q * e), r = v - m;
    f32x2 o; o.x = v.x < 0.f ? m.x : r.x; o.y = v.y < 0.f ? m.y : r.y; return o;
}

template <int ACT  > struct EpiBf16 {
    static constexpr bool PERM = true, AFTER_DRAIN = false; static_assert(ACT == 0 || ACT == 1, "EpiBf16: ACT is 0 (none) or 1 (gelu_pk)");
    bf16_t* O; int ldc; const float* bias; int split_cols; size_t split_stride; float scale0;
    __device__ __forceinline__ void operator()(const f32x4 (&acc)[2][2][4][2], const Unit& u, int wr, int wc, int fr, int fq) const {
        const int row0 = u.pm * BM + wr * 64 + fr; int colt = u.pn * BM; bf16_t* base = O;
        float sc = 1.f; if (split_cols) { const int t = colt / split_cols; base += (size_t)t * split_stride; colt -= t * split_cols; if (t == 0) sc = scale0; }
        const int col0 = colt + wc * 32 + 8 * fq, bcol0 = u.pn * BM + wc * 32 + 8 * fq;
        f32x4 bv[2][2];
#pragma unroll
        for (int bj = 0; bj < 2; ++bj)
#pragma unroll
            for (int n = 0; n < 2; ++n) bv[bj][n] = bias ? *(const f32x4*)(bias + bcol0 + bj * HALF + 4 * n) : (f32x4){0.f, 0.f, 0.f, 0.f};
#pragma unroll
        for (int ai = 0; ai < 2; ++ai)
#pragma unroll
            for (int m = 0; m < 4; ++m) { bf16_t* rowp = base + (size_t)(row0 + ai * HALF + m * 16) * ldc + col0;
#pragma unroll
                for (int bj = 0; bj < 2; ++bj) { f32x4 v0 = acc[ai][bj][m][0] + bv[bj][0], v1 = acc[ai][bj][m][1] + bv[bj][1];
                    if (ACT == 1) { f32x2 a = gelu_pk((f32x2){v0[0], v0[1]}), b = gelu_pk((f32x2){v0[2], v0[3]}), c = gelu_pk((f32x2){v1[0], v1[1]}), d = gelu_pk((f32x2){v1[2], v1[3]});
                        v0 = (f32x4){a.x, a.y, b.x, b.y}; v1 = (f32x4){c.x, c.y, d.x, d.y}; }
                    v0 = v0 * sc; v1 = v1 * sc; u32x4 w; w.x = cvt_pk_bf16(v0[0], v0[1]); w.y = cvt_pk_bf16(v0[2], v0[3]); w.z = cvt_pk_bf16(v1[0], v1[1]); w.w = cvt_pk_bf16(v1[2], v1[3]);
                    *(u32x4*)(rowp + bj * HALF) = w; } }
    }
};
template <class Epi, class Sched, bool ALIGN_EPI = false, bool SP2 = false>
__device__ __forceinline__ void gemm_phase(PG8_LAS unsigned char* lds, const Gemm g, const Sched& S, const Epi& E) {
    const int tid = threadIdx.x, wid = __builtin_amdgcn_readfirstlane(tid >> 6), lane = tid & 63, wr = wid >> 2, wc = wid & 3, fr = lane & 15, fq = lane >> 4;
    const int K = g.K, nt = K / BK;
    unsigned voffA[2], voffB[2];
#pragma unroll
    for (int i = 0; i < 2; ++i) { int R, C; stage_rc(tid * 16 + i * 8192, R, C); const int Rb = Epi::PERM ? ((R & ~31) + perm32(R & 31)) : R;
        voffA[i] = (unsigned)(R * K + C) * 2u; voffB[i] = (unsigned)(Rb * K + C) * 2u; }
    const size_t kstep = (size_t)(BK * 2);
    const size_t hstep = (size_t)HALF * K * 2;
    const size_t tstep = 2 * hstep;
    const unsigned ldsw = (unsigned)wid * 1024u;
    const int aoff = lds_byte(wr * 64 + fr, fq * 8), boff = lds_byte(wc * 32 + fr, fq * 8);
#define PG8_SA(b, h) (((b) * 2 + (h)) * HTB)
#define PG8_SB(b, h) ((4 + (b) * 2 + (h)) * HTB)
#define PG8_STAGE(bufoff, gbase, voff) do { _Pragma("unroll") for (int _i = 0; _i < 2; ++_i) \
        __builtin_amdgcn_global_load_lds((const unsigned*)((const char*)(gbase) + (voff)[_i]), (PG8_LAS unsigned*)(lds + (bufoff) + ldsw + _i * 8192), 16, 0, 0); } while (0)
#define PG8_LDA(dst, b, h) do { _Pragma("unroll") for (int m = 0; m < 4; ++m) _Pragma("unroll") for (int k = 0; k < 2; ++k) dst[m][k] = *(const PG8_LAS bf16x8*)(lds + PG8_SA(b, h) + aoff + m * 2048 + k * 1024); } while (0)
#define PG8_LDB(dst, b, h) do { _Pragma("unroll") for (int n = 0; n < 2; ++n) _Pragma("unroll") for (int k = 0; k < 2; ++k) dst[n][k] = *(const PG8_LAS bf16x8*)(lds + PG8_SB(b, h) + boff + n * 2048 + k * 1024); } while (0)
#define PG8_MMA(ai, bj, At, Bt) do { __builtin_amdgcn_s_setprio(1); _Pragma("unroll") for (int m = 0; m < 4; ++m) _Pragma("unroll") for (int n = 0; n < 2; ++n) _Pragma("unroll") for (int k = 0; k < 2; ++k) \
        acc[ai][bj][m][n] = __builtin_amdgcn_mfma_f32_16x16x32_bf16(Bt[n][k], At[m][k], acc[ai][bj][m][n], 0, 0, 0); __builtin_amdgcn_s_setprio(0); } while (0)
#define PG8_WAIT_V(n) asm volatile("s_waitcnt vmcnt(" #n ")" ::: "memory")
#define PG8_WAIT_L(n) asm volatile("s_waitcnt lgkmcnt(" #n ")" ::: "memory")
#define PG8_BAR __builtin_amdgcn_s_barrier()
#define PG8_SCHED __builtin_amdgcn_sched_barrier(0)
    Unit cur, nxt; int ui = 0;
    if (!S.next(0, cur)) return;
    f32x4 acc[2][2][4][2];
#pragma unroll
    for (int a = 0; a < 2; ++a)
#pragma unroll
        for (int b = 0; b < 2; ++b)
#pragma unroll
            for (int m = 0; m < 4; ++m)
#pragma unroll
                for (int n = 0; n < 2; ++n) acc[a][b][m][n] = (f32x4){0.f, 0.f, 0.f, 0.f};
    bf16x8 At[4][2], B0[2][2], B1[2][2];
    const char* cA = (const char*)g.A + (size_t)cur.pm * tstep; const char* cB = (const char*)g.Bt + (size_t)cur.pn * tstep;
    S.a_ready(cur);
    if constexpr (SP2) {
        PG8_STAGE(PG8_SB(0, 0), cB, voffB); PG8_STAGE(PG8_SB(0, 1), cB + hstep, voffB); PG8_STAGE(PG8_SA(0, 0), cA, voffA); PG8_STAGE(PG8_SA(0, 1), cA + hstep, voffA);
        if (wr == 1) PG8_BAR;
        PG8_WAIT_V(2); PG8_BAR;
        PG8_STAGE(PG8_SB(1, 0), cB + kstep, voffB); PG8_STAGE(PG8_SA(1, 0), cA + kstep, voffA); PG8_STAGE(PG8_SB(1, 1), cB + hstep + kstep, voffB);
        PG8_WAIT_V(6); PG8_BAR;
    } else {
        PG8_STAGE(PG8_SB(0, 0), cB, voffB); PG8_STAGE(PG8_SA(0, 0), cA, voffA); PG8_STAGE(PG8_SB(0, 1), cB + hstep, voffB); PG8_STAGE(PG8_SA(0, 1), cA + hstep, voffA);
        if (wr == 1) PG8_BAR;
        PG8_WAIT_V(4); PG8_BAR;
        PG8_STAGE(PG8_SB(1, 0), cB + kstep, voffB); PG8_STAGE(PG8_SA(1, 0), cA + kstep, voffA); PG8_STAGE(PG8_SB(1, 1), cB + hstep + kstep, voffB);
        PG8_WAIT_V(6); PG8_BAR;
    }
    for (;;) {
        const bool has_next = S.next(ui + 1, nxt);
        const char* nA = has_next ? (const char*)g.A + (size_t)nxt.pm * tstep : cA; const char* nB = has_next ? (const char*)g.Bt + (size_t)nxt.pn * tstep : cB;
        for (int t = 0; t < nt; t += 2) {
            const bool last = (t == nt - 2);
            const char* a1 = cA + (size_t)(t + 1) * kstep;
            const char* a2 = last ? nA : cA + (size_t)(t + 2) * kstep; const char* b2 = last ? nB : cB + (size_t)(t + 2) * kstep;
            const char* a3 = a2 + kstep; const char* b3 = b2 + kstep;
            if (last && has_next) S.a_ready(nxt);
            if constexpr (SP2) {
            PG8_LDB(B0, 0, 0); PG8_LDB(B1, 0, 1); PG8_SCHED; PG8_LDA(At, 0, 0); PG8_STAGE(PG8_SA(1, 1), a1 + hstep, voffA);
            PG8_WAIT_V(8); PG8_WAIT_L(0); PG8_BAR; PG8_MMA(0, 0, At, B0); PG8_MMA(0, 1, At, B1); PG8_BAR; PG8_SCHED;
            PG8_LDA(At, 0, 1); PG8_STAGE(PG8_SB(0, 0), b2, voffB); PG8_STAGE(PG8_SB(0, 1), b2 + hstep, voffB); PG8_STAGE(PG8_SA(0, 0), a2, voffA);
            PG8_WAIT_V(8); PG8_WAIT_L(0); PG8_BAR; PG8_MMA(1, 0, At, B0); PG8_MMA(1, 1, At, B1); PG8_BAR; PG8_SCHED;
            PG8_LDB(B0, 1, 0); PG8_LDB(B1, 1, 1); PG8_SCHED; PG8_LDA(At, 1, 0); PG8_STAGE(PG8_SA(0, 1), a2 + hstep, voffA);
            PG8_WAIT_V(8); PG8_WAIT_L(0); PG8_BAR; PG8_MMA(0, 0, At, B0); PG8_MMA(0, 1, At, B1); PG8_BAR; PG8_SCHED;
            PG8_LDA(At, 1, 1); PG8_STAGE(PG8_SB(1, 0), b3, voffB); PG8_STAGE(PG8_SB(1, 1), b3 + hstep, voffB); PG8_STAGE(PG8_SA(1, 0), a3, voffA);
            PG8_WAIT_V(8); PG8_WAIT_L(0); PG8_BAR; PG8_MMA(1, 0, At, B0); PG8_MMA(1, 1, At, B1); PG8_BAR; PG8_SCHED;
            } else {
            PG8_LDB(B0, 0, 0); PG8_SCHED; PG8_LDA(At, 0, 0); PG8_STAGE(PG8_SA(1, 1), a1 + hstep, voffA);
            PG8_WAIT_L(8); PG8_BAR; PG8_WAIT_L(0); PG8_MMA(0, 0, At, B0); PG8_BAR; PG8_SCHED;
            PG8_LDB(B1, 0, 1); PG8_STAGE(PG8_SB(0, 0), b2, voffB);
            PG8_BAR; PG8_WAIT_L(0); PG8_MMA(0, 1, At, B1); PG8_BAR;
            PG8_LDA(At, 0, 1); PG8_STAGE(PG8_SA(0, 0), a2, voffA);
            PG8_BAR; PG8_WAIT_L(0); PG8_MMA(1, 0, At, B0); PG8_BAR; PG8_SCHED;
            PG8_STAGE(PG8_SB(0, 1), b2 + hstep, voffB);
            PG8_WAIT_V(6); PG8_BAR; PG8_MMA(1, 1, At, B1); PG8_BAR;
            PG8_LDB(B0, 1, 0); PG8_SCHED; PG8_LDA(At, 1, 0); PG8_STAGE(PG8_SA(0, 1), a2 + hstep, voffA);
            PG8_WAIT_L(8); PG8_BAR; PG8_WAIT_L(0); PG8_MMA(0, 0, At, B0); PG8_BAR; PG8_SCHED;
            PG8_LDB(B1, 1, 1); PG8_STAGE(PG8_SB(1, 0), b3, voffB);
            PG8_BAR; PG8_WAIT_L(0); PG8_MMA(0, 1, At, B1); PG8_BAR;
            PG8_LDA(At, 1, 1); PG8_STAGE(PG8_SA(1, 0), a3, voffA);
            PG8_BAR; PG8_WAIT_L(0); PG8_MMA(1, 0, At, B0); PG8_BAR; PG8_SCHED;
            PG8_STAGE(PG8_SB(1, 1), b3 + hstep, voffB);
            PG8_WAIT_V(6); PG8_BAR; PG8_MMA(1, 1, At, B1); PG8_BAR;
            }
        }
        if constexpr (ALIGN_EPI) { if (wr == 0) PG8_BAR; }
        if constexpr (!Epi::AFTER_DRAIN) { E(acc, cur, wr, wc, fr, fq); S.done(cur); }
        if (!has_next) break;
#pragma unroll
        for (int a = 0; a < 2; ++a)
#pragma unroll
            for (int b = 0; b < 2; ++b)
#pragma unroll
                for (int m = 0; m < 4; ++m)
#pragma unroll
                    for (int n = 0; n < 2; ++n) acc[a][b][m][n] = (f32x4){0.f, 0.f, 0.f, 0.f};
        cur = nxt; cA = nA; cB = nB; ++ui;
        if constexpr (ALIGN_EPI) { if (wr == 1) PG8_BAR; }
    }
    PG8_WAIT_V(0);
    if constexpr (!ALIGN_EPI) { if (wr == 0) PG8_BAR; }
    PG8_BAR;
    if constexpr (Epi::AFTER_DRAIN) { E.fused(acc, cur, wr, wc, fr, fq, lds, wid, lane); S.done(cur); }
#undef PG8_SA
#undef PG8_SB
#undef PG8_STAGE
#undef PG8_LDA
#undef PG8_LDB
#undef PG8_MMA
#undef PG8_WAIT_V
#undef PG8_WAIT_L
#undef PG8_BAR
#undef PG8_SCHED
}
}
namespace pg8 {
struct P1Order {
    StaticOrder main; int G, c;
    __host__ __device__ void init(int M_, int Nmain, int G_, int c_) { main.init(M_, Nmain, G_, c_); G = G_; c = c_; }
    __host__ __device__ bool next(int i, Unit& u) const {
        if (main.next(i, u)) { u.pm += 24; return true; }
        const long L = (long)i * G + c - main.nwg; if (L >= 256) return false;
        u.pm = 19 + (int)(L & 3); u.pn = 24 + (int)(L >> 2); return true;
    }
    __device__ __forceinline__ void a_ready(const Unit&) const {}
    __device__ __forceinline__ void done(const Unit&) const {}
};
typedef unsigned u32x2 __attribute__((ext_vector_type(2)));
__device__ __forceinline__ float softplus_f(float x) { const float e = __expf(-fabsf(x)); return fmaxf(x, 0.f) + (e < 1e-4f ? e * (1.0f - 0.5f * e) : __logf(1.0f + e)); }
struct EpiInProj {
    static constexpr bool PERM = true, AFTER_DRAIN = false;
    bf16_t* ZQ; bf16_t* XBC; bf16_t* KB; bf16_t* VB; float* DT; const float* qw; const float* kw; const float* dbf; const float* dbb;
    __device__ __forceinline__ void plain(const f32x4 (&acc)[2][2][4][2], bf16_t* base, int ldc, int row0, int col0) const {
#pragma unroll
        for (int ai = 0; ai < 2; ++ai)
#pragma unroll
            for (int m = 0; m < 4; ++m) { bf16_t* rowp = base + (size_t)(row0 + ai * HALF + m * 16) * ldc + col0;
#pragma unroll
                for (int bj = 0; bj < 2; ++bj) { const f32x4 v0 = acc[ai][bj][m][0], v1 = acc[ai][bj][m][1];
                    u32x4 w; w.x = cvt_pk_bf16(v0[0], v0[1]); w.y = cvt_pk_bf16(v0[2], v0[3]); w.z = cvt_pk_bf16(v1[0], v1[1]); w.w = cvt_pk_bf16(v1[2], v1[3]);
                    *(u32x4*)(rowp + bj * HALF) = w; } }
    }
    __device__ __forceinline__ void headnorm(const f32x4 (&acc)[2][2][4][2], bf16_t* base, int ldc, int row0, int colh, const float* w, float scale, int fq) const {
        f32x4 wv[2][2];
#pragma unroll
        for (int bj = 0; bj < 2; ++bj)
#pragma unroll
            for (int n = 0; n < 2; ++n) wv[bj][n] = *(const f32x4*)(w + 32 * bj + 8 * fq + 4 * n) * scale;
#pragma unroll
        for (int ai = 0; ai < 2; ++ai)
#pragma unroll
            for (int m = 0; m < 4; ++m) {
                float ss = 0.f;
#pragma unroll
                for (int bj = 0; bj < 2; ++bj)
#pragma unroll
                    for (int n = 0; n < 2; ++n) { const f32x4 x = acc[ai][bj][m][n]; ss += (x[0] * x[0] + x[1] * x[1]) + (x[2] * x[2] + x[3] * x[3]); }
                ss += __shfl_xor(ss, 16); ss += __shfl_xor(ss, 32);
                const float rstd = 1.0f / sqrtf(ss * (1.0f / 64.0f) + 1e-5f);
                bf16_t* rowp = base + (size_t)(row0 + ai * HALF + m * 16) * ldc + colh + 8 * fq;
#pragma unroll
                for (int bj = 0; bj < 2; ++bj) { const f32x4 v0 = acc[ai][bj][m][0] * rstd * wv[bj][0], v1 = acc[ai][bj][m][1] * rstd * wv[bj][1];
                    u32x4 o; o.x = cvt_pk_bf16(v0[0], v0[1]); o.y = cvt_pk_bf16(v0[2], v0[3]); o.z = cvt_pk_bf16(v1[0], v1[1]); o.w = cvt_pk_bf16(v1[2], v1[3]);
                    *(u32x4*)(rowp + 32 * bj) = o; } }
    }
    __device__ __forceinline__ void operator()(const f32x4 (&acc)[2][2][4][2], const Unit& u, int wr, int wc, int fr, int fq) const {
        asm volatile("" : "+v"(fr), "+v"(fq));
        const int colw = wc * 32 + 8 * fq;
        if (u.pn >= 24) { plain(acc, VB, 16384, (u.pm - 19) * BM + wr * 64 + fr, (u.pn - 24) * BM + colw); return; }
        const int row0 = (u.pm - 24) * BM + wr * 64 + fr, pn = u.pn;
        if (pn < 4) plain(acc, ZQ, 2048, row0, pn * 256 + colw);
        else if (pn < 10) plain(acc, XBC, 1536, row0, (pn - 4) * 256 + colw);
        else if (pn < 14) headnorm(acc, ZQ, 2048, row0, 1024 + 64 * (4 * (pn - 10) + wc), qw, 0.125f * 1.4426950408889634f, fq);
        else if (pn < 18) headnorm(acc, KB, 1024, row0, 64 * (4 * (pn - 14) + wc), kw, 1.0f, fq);
        else if (wc == 0) {
            f32x4 bv[2];
#pragma unroll
            for (int n = 0; n < 2; ++n) { const int c = 8 * fq + 4 * n; bv[n] = (c < 16) ? *(const f32x4*)(dbf + c) : *(const f32x4*)(dbb + c - 16); }
#pragma unroll
            for (int ai = 0; ai < 2; ++ai)
#pragma unroll
                for (int m = 0; m < 4; ++m) { float* rowp = DT + (size_t)(row0 + ai * HALF + m * 16) * 32 + 8 * fq;
#pragma unroll
                    for (int n = 0; n < 2; ++n) { const f32x4 x = acc[ai][0][m][n] + bv[n]; f32x4 o; o[0] = softplus_f(x[0]); o[1] = softplus_f(x[1]); o[2] = softplus_f(x[2]); o[3] = softplus_f(x[3]);
                        *(f32x4*)(rowp + 4 * n) = o; } }
        }
    }
};
struct EpiOutProj {
    static constexpr bool PERM = true, AFTER_DRAIN = false;
    const float* X; float* OUT; bf16_t* XW; const float* wn; float* SS;
    __device__ __forceinline__ void operator()(const f32x4 (&acc)[2][2][4][2], const Unit& u, int wr, int wc, int fr, int fq) const {
        const int row0 = u.pm * BM + wr * 64 + fr, col0 = u.pn * BM + wc * 32 + 8 * fq;
        f32x4 wv[2][2];
#pragma unroll
        for (int bj = 0; bj < 2; ++bj)
#pragma unroll
            for (int n = 0; n < 2; ++n) wv[bj][n] = *(const f32x4*)(wn + col0 + bj * HALF + 4 * n);
#pragma unroll
        for (int ai = 0; ai < 2; ++ai) {
            f32x4 xr[4][2][2];
#pragma unroll
            for (int m = 0; m < 4; ++m)
#pragma unroll
                for (int bj = 0; bj < 2; ++bj) { const size_t off = (size_t)(row0 + ai * HALF + m * 16) * 1024 + col0 + bj * HALF;
                    xr[m][bj][0] = *(const f32x4*)(X + off); xr[m][bj][1] = *(const f32x4*)(X + off + 4); }
            asm volatile("" ::: "memory");
#pragma unroll
            for (int m = 0; m < 4; ++m) { const int row = row0 + ai * HALF + m * 16; const size_t off = (size_t)row * 1024 + col0; float ss = 0.f;
#pragma unroll
                for (int bj = 0; bj < 2; ++bj) {
                    const f32x4 v0 = acc[ai][bj][m][0] + xr[m][bj][0], v1 = acc[ai][bj][m][1] + xr[m][bj][1];
                    ss += (v0[0] * v0[0] + v0[1] * v0[1]) + (v0[2] * v0[2] + v0[3] * v0[3]) + (v1[0] * v1[0] + v1[1] * v1[1]) + (v1[2] * v1[2] + v1[3] * v1[3]);
                    const f32x4 y0 = v0 * wv[bj][0], y1 = v1 * wv[bj][1];
                    u32x4 o; o.x = cvt_pk_bf16(y0[0], y0[1]); o.y = cvt_pk_bf16(y0[2], y0[3]); o.z = cvt_pk_bf16(y1[0], y1[1]); o.w = cvt_pk_bf16(y1[2], y1[3]);
                    *(u32x4*)(XW + off + bj * HALF) = o; }
                ss += __shfl_xor(ss, 16); ss += __shfl_xor(ss, 32);
                if (fq == 0) SS[(size_t)row * 16 + 4 * u.pn + wc] = ss; }
            asm volatile("" ::: "memory");
        }
    }
};
struct EpiMlpIn {
    static constexpr bool PERM = true, AFTER_DRAIN = false;
    bf16_t* H; const PG8_LAS float* RS; mutable int ui;
    __device__ __forceinline__ void operator()(const f32x4 (&acc)[2][2][4][2], const Unit& u, int wr, int wc, int fr, int fq) const {
        const int row0 = u.pm * BM + wr * 64 + fr, col0 = u.pn * BM + wc * 32 + 8 * fq;
        const PG8_LAS float* rs = RS + ui * 256 + wr * 64 + fr; ++ui;
        float rs2[2][4];
#pragma unroll
        for (int ai = 0; ai < 2; ++ai)
#pragma unroll
            for (int m = 0; m < 4; ++m) rs2[ai][m] = rs[ai * HALF + m * 16];
#pragma unroll
        for (int ai = 0; ai < 2; ++ai)
#pragma unroll
            for (int m = 0; m < 4; ++m) { bf16_t* rowp = H + (size_t)(row0 + ai * HALF + m * 16) * 4096 + col0; const float r2 = rs2[ai][m];
#pragma unroll
                for (int bj = 0; bj < 2; ++bj) { f32x4 v0 = acc[ai][bj][m][0], v1 = acc[ai][bj][m][1];
#pragma unroll
                    for (int j = 0; j < 4; ++j) { const float a = fmaxf(v0[j], 0.f), b = fmaxf(v1[j], 0.f); v0[j] = a * a * r2; v1[j] = b * b * r2; }
                    u32x4 o; o.x = cvt_pk_bf16(v0[0], v0[1]); o.y = cvt_pk_bf16(v0[2], v0[3]); o.z = cvt_pk_bf16(v1[0], v1[1]); o.w = cvt_pk_bf16(v1[2], v1[3]);
                    *(u32x4*)(rowp + bj * HALF) = o; } }
    }
};
struct EpiMlpOut {
    static constexpr bool PERM = true, AFTER_DRAIN = false;
    float* OUT; const bf16_t* XW; const float* wn; int dry;
    __device__ __forceinline__ void operator()(const f32x4 (&acc)[2][2][4][2], const Unit& u, int wr, int wc, int fr, int fq) const {
        const int row0 = u.pm * BM + wr * 64 + fr, col0 = u.pn * BM + wc * 32 + 8 * fq;
        f32x4 rw[2][2];
#pragma unroll
        for (int bj = 0; bj < 2; ++bj)
#pragma unroll
            for (int n = 0; n < 2; ++n) { const f32x4 w = *(const f32x4*)(wn + col0 + bj * HALF + 4 * n); rw[bj][n] = (f32x4){__builtin_amdgcn_rcpf(w[0]), __builtin_amdgcn_rcpf(w[1]), __builtin_amdgcn_rcpf(w[2]), __builtin_amdgcn_rcpf(w[3])}; }
#pragma unroll
        for (int ai = 0; ai < 2; ++ai) {
            u32x4 xr[4][2];
#pragma unroll
            for (int m = 0; m < 4; ++m)
#pragma unroll
                for (int bj = 0; bj < 2; ++bj) xr[m][bj] = *(const u32x4*)(XW + (size_t)(row0 + ai * HALF + m * 16) * 1024 + col0 + bj * HALF);
            asm volatile("" ::: "memory");
#pragma unroll
            for (int m = 0; m < 4; ++m)
#pragma unroll
                for (int bj = 0; bj < 2; ++bj) { float* rowp = OUT + (size_t)(row0 + ai * HALF + m * 16) * 1024 + col0 + bj * HALF; const u32x4 x = xr[m][bj];
                    const f32x4 x0 = {__builtin_bit_cast(float, x.x << 16), __builtin_bit_cast(float, x.x & 0xffff0000u), __builtin_bit_cast(float, x.y << 16), __builtin_bit_cast(float, x.y & 0xffff0000u)};
                    const f32x4 x1 = {__builtin_bit_cast(float, x.z << 16), __builtin_bit_cast(float, x.z & 0xffff0000u), __builtin_bit_cast(float, x.w << 16), __builtin_bit_cast(float, x.w & 0xffff0000u)};
                    if (!dry) { *(f32x4*)(rowp) = acc[ai][bj][m][0] + x0 * rw[bj][0]; *(f32x4*)(rowp + 4) = acc[ai][bj][m][1] + x1 * rw[bj][1]; } }
            asm volatile("" ::: "memory");
        }
    }
};
}
#ifndef PG8_SP2
#define PG8_SP2 true
#endif
#ifndef PG8_ALIGN
#define PG8_ALIGN true
#endif
#define GAS __attribute__((address_space(1)))
#define LAS __attribute__((address_space(3)))
typedef unsigned short bf16;
typedef unsigned v4u __attribute__((ext_vector_type(4)));
typedef float f32x4 __attribute__((ext_vector_type(4)));
typedef short bf16x8 __attribute__((ext_vector_type(8)));
typedef GAS unsigned gu32;
typedef GAS unsigned long long gu64;
#define RLX_AGENT __ATOMIC_RELAXED, __HIP_MEMORY_SCOPE_AGENT
#define LDS_WAIT() asm volatile("s_waitcnt lgkmcnt(0)" ::: "memory")
#define VM_WAIT() asm volatile("s_waitcnt vmcnt(0)" ::: "memory")
__device__ __forceinline__ unsigned long long rt() { return __builtin_amdgcn_s_memrealtime(); }
__device__ __forceinline__ unsigned f2bf(float f) { unsigned u = __builtin_bit_cast(unsigned, f); return (u + 0x7fffu + ((u >> 16) & 1u)) >> 16; }
typedef float f32x2_hw __attribute__((ext_vector_type(2))); typedef __bf16 bf16x2_hw __attribute__((ext_vector_type(2)));
__device__ __forceinline__ unsigned pk2(float lo, float hi) { const f32x2_hw v = {lo, hi}; const bf16x2_hw b = __builtin_convertvector(v, bf16x2_hw); return __builtin_bit_cast(unsigned, b); }

#define XB_TMO      128
#define XB_XCNT(j)  (256  + 64 * (j))
#define XB_XSUB(j)  (1280 + 64 * (j))
#define XB_XGEN(j)  (2304 + 64 * (j))
#define XB_TOP      3328
#define XB_TOPGEN   3392
#define XCD_BAR_WORDS 3456
#define XB_SPIN_CAP (1u << 18)

__device__ __forceinline__ unsigned xb_ld(unsigned* p)              { return __hip_atomic_load(p, __ATOMIC_RELAXED, __HIP_MEMORY_SCOPE_AGENT); }
__device__ __forceinline__ unsigned xb_add(unsigned* p, unsigned v) { return __hip_atomic_fetch_add(p, v, __ATOMIC_RELAXED, __HIP_MEMORY_SCOPE_AGENT); }
__device__ __forceinline__ unsigned xb_xcc_id() { return (unsigned)__builtin_amdgcn_s_getreg((3 << 11) | 20) & 0xFu; }
#define XB_SPIN(cond, bar) do { unsigned _sp = 0; while (cond) { __builtin_amdgcn_s_sleep(1); \
    if ((++_sp & 255u) == 0u) { if (xb_ld(&(bar)[XB_TMO])) break; if (_sp > XB_SPIN_CAP) { atomicAdd(&(bar)[XB_TMO], 1u); break; } } } } while (0)

struct XcdBarrier {
    unsigned* bar; unsigned x;
    volatile LAS unsigned* st;
};

__device__ __forceinline__ XcdBarrier xcd_barrier_post(unsigned* bar, volatile LAS unsigned* st) {
    XcdBarrier b; b.bar = bar; b.x = xb_xcc_id(); b.st = st;
    if (threadIdx.x == 0) (void)xb_add(&bar[XB_XCNT(b.x)], 1u);
    return b;
}
__device__ __forceinline__ void xcd_barrier_complete(unsigned* bar, unsigned x, unsigned& nloc, unsigned& nx) {
    const unsigned G = gridDim.x * gridDim.y * gridDim.z;
    unsigned sum, cnt, mine, sp = 0u;
    for (;;) {
        sum = 0u; cnt = 0u; mine = 0u;
#pragma unroll
        for (unsigned j = 0; j < 16; ++j) { const unsigned c = xb_ld(&bar[XB_XCNT(j)]); sum += c; cnt += (c > 0u) ? 1u : 0u; mine = (j == x) ? c : mine; }
        if (sum == G) break;
        __builtin_amdgcn_s_sleep(1);
        if ((++sp & 255u) == 0u) { if (xb_ld(&bar[XB_TMO])) break; if (sp > XB_SPIN_CAP) { atomicAdd(&bar[XB_TMO], 1u); break; } }
    }
    nloc = mine > 0u ? mine : 1u; nx = cnt > 0u ? cnt : 1u;
}

__device__ __forceinline__ void xcd_barrier(const XcdBarrier& b) {
    asm volatile("s_waitcnt vmcnt(0)" ::: "memory");
    __syncthreads();
    if (threadIdx.x == 0) {
        unsigned* bar = b.bar;
        __builtin_amdgcn_s_waitcnt(0);
        unsigned nloc = b.st[0], nx = b.st[1];
        if (nloc == 0u) { xcd_barrier_complete(bar, b.x, nloc, nx); b.st[0] = nloc; b.st[1] = nx; }
        const unsigned old = xb_add(&bar[XB_XSUB(b.x)], 1u);
        const unsigned gen = old / nloc;
        if (old + 1u == (gen + 1u) * nloc) {
            __builtin_amdgcn_fence(__ATOMIC_RELEASE, "agent");
            asm volatile("s_waitcnt vmcnt(0)" ::: "memory");
            const unsigned og = xb_add(&bar[XB_TOP], 1u);
            const unsigned tg = og / nx;
            if (og + 1u == (tg + 1u) * nx) xb_add(&bar[XB_TOPGEN], 1u);
            else XB_SPIN(xb_ld(&bar[XB_TOPGEN]) == tg, bar);
            __builtin_amdgcn_fence(__ATOMIC_ACQUIRE, "agent");
            xb_add(&bar[XB_XGEN(b.x)], 1u);
            asm volatile("s_waitcnt vmcnt(0)" ::: "memory");
        } else {
            XB_SPIN(xb_ld(&bar[XB_XGEN(b.x)]) == gen, bar);
            __builtin_amdgcn_fence(__ATOMIC_ACQUIRE, "agent");
            asm volatile("s_waitcnt vmcnt(0)" ::: "memory");
        }
    }
    __syncthreads();
}

constexpr int NWAVES = 8;
#ifndef MK_N_LAUNCHES
#define MK_N_LAUNCHES 1
#endif
constexpr int PER_PHASE = 8;
constexpr int N_LAUNCHES = MK_N_LAUNCHES;

constexpr int BATCH = 2, T = 8192, D = 1024, M = BATCH * T, FF = 4096;
constexpr int NH = 16, HD = 64, NGRP = 2, HPG = 8, NST = 128, CONVD = 1536, CH = 128, NCH = T / CH;
constexpr int GW = 64, GROWS = T / GW, KH = 8, KW = 16;
constexpr int PROJ = 5664, NPROJ = 5888, NMAIN = 4864;
constexpr float EPS = 1e-5f;

constexpr size_t MiB = 1u << 20;
constexpr size_t WS_CTL = 0, CTL_ZERO_BYTES = 65536;
constexpr size_t WS_WIN = 1 * MiB;
constexpr size_t WS_XN = 13 * MiB;
static_assert(WS_XN - WS_WIN == 24u * 256u * 1024u * 2u, "P1Order: XN must start 24 row panels above the weight copy");
constexpr size_t WS_SF = 1 * MiB;
constexpr size_t WS_SB = 33 * MiB;
constexpr size_t WS_ZQ = 65 * MiB;
constexpr size_t WS_XBC = 129 * MiB;
constexpr size_t WS_K = 177 * MiB;
constexpr size_t WS_V = 209 * MiB;
constexpr size_t WS_DT = 241 * MiB;
constexpr size_t WS_DEC = 255 * MiB;
constexpr size_t WS_WOUT = 243 * MiB;
constexpr size_t WS_W1 = 247 * MiB;
constexpr size_t WS_W2 = 189 * MiB;
constexpr size_t WS_XW = 1 * MiB;
constexpr size_t WS_SS = 33 * MiB;
constexpr size_t WS_H = 40 * MiB;
constexpr size_t WS_END = 256 * MiB;
constexpr size_t SC_XST = 0, SC_BN = 32 * MiB, SC_CN = 40 * MiB;
constexpr int CW_TMO = 0, CW_CODE = 1, CW_BAR = 4096;

constexpr int RING_OFF = 0, RING_BYTES = 131072;
constexpr int LDS_BYTES = 163840;
constexpr int LDSCTL_OFF = LDS_BYTES - 512, MISC_OFF = LDSCTL_OFF + 320;
static_assert(MISC_OFF + 128 <= LDS_BYTES, "LDS map");

struct Frame {
    LAS unsigned char* lds;
    volatile LAS unsigned* MISC;
    gu32* ctl;
    int tid, lane, wave;
    int vcu, G;
    const float* in[18]; float* out; unsigned char* ws;
};
#define PL_SWAP(W, m) unsigned a_ = __builtin_bit_cast(unsigned, m), b_ = a_; asm volatile("" : "+v"(b_)); const auto r_ = __builtin_amdgcn_permlane##W##_swap(a_, b_, false, false); \
    unsigned r0_ = r_[0], r1_ = r_[1]; asm volatile("" : "+v"(r0_), "+v"(r1_)); const float x0_ = __builtin_bit_cast(float, r0_), x1_ = __builtin_bit_cast(float, r1_)
__device__ __forceinline__ float red16_max(float m) { PL_SWAP(16, m); return fmaxf(x0_, x1_); }
__device__ __forceinline__ float red32_max(float m) { PL_SWAP(32, m); return fmaxf(x0_, x1_); }
__device__ __forceinline__ float red16_add(float m) { PL_SWAP(16, m); return x0_ + x1_; }
__device__ __forceinline__ float red32_add(float m) { PL_SWAP(32, m); return x0_ + x1_; }
__device__ __forceinline__ float bf2f(bf16 v) { return __builtin_bit_cast(float, (unsigned)v << 16); }
__device__ __forceinline__ float wave_sum(float v) {
#pragma unroll
    for (int o = 1; o < 64; o <<= 1) v += __shfl_xor(v, o);
    return v;
}
__device__ __forceinline__ float silu_f(float x) { return x * __builtin_amdgcn_rcpf(1.0f + __expf(-x)); }

__device__ __forceinline__ void p0_transpose_item(const float* W, int K, int N, bf16* WT, int kb, int src0, int dst0, LAS float* scr, int lane) {
    const int k0 = 64 * kb;
    if (src0 >= 0) {
#pragma unroll 8
        for (int i = 0; i < 32; ++i) { const int kk = 2 * i + (lane >> 5); scr[kk * 33 + (lane & 31)] = W[(size_t)(k0 + kk) * N + src0 + (lane & 31)]; }
    } else {
#pragma unroll 8
        for (int i = 0; i < 32; ++i) { const int kk = 2 * i + (lane >> 5); scr[kk * 33 + (lane & 31)] = 0.f; }
    }
    LDS_WAIT(); asm volatile("" ::: "memory");
    const int c = lane & 7;
#pragma unroll
    for (int j = 0; j < 4; ++j) { const int n = (lane >> 3) + 8 * j; const LAS float* s = scr + (8 * c) * 33 + n;
        v4u o; o.x = pk2(s[0 * 33], s[1 * 33]); o.y = pk2(s[2 * 33], s[3 * 33]); o.z = pk2(s[4 * 33], s[5 * 33]); o.w = pk2(s[6 * 33], s[7 * 33]);
        *(GAS v4u*)(WT + (size_t)(dst0 + n) * K + k0 + 8 * c) = o; }
    LDS_WAIT(); asm volatile("" ::: "memory");
}
__device__ __forceinline__ int inproj_src(int nb) {
    const int gc = 32 * nb;
    if (gc < 2560) return gc;
    if (gc < 4608) { const int r = gc - 2560, sel = r >> 10, rr = r & 1023, t = rr >> 8, c = rr & 255, bj = c >> 7, wc = (c >> 5) & 3;
        return 2592 + 1024 * sel + 64 * (4 * t + wc) + 32 * bj; }
    if (gc < 4640) return 2560;
    if (gc < 4864) return -1;
    return 4640 + (gc - 4864);
}
__device__ __forceinline__ void rms_row_to_bf16(int lane, const float* xrow, const float* w, bf16* orow) {
    const GAS f32x4* xr = (const GAS f32x4*)xrow + lane; const GAS f32x4* wr = (const GAS f32x4*)w + lane;
    f32x4 v[4]; float s = 0.f;
#pragma unroll
    for (int j = 0; j < 4; ++j) { v[j] = xr[64 * j]; s += (v[j].x * v[j].x + v[j].y * v[j].y) + (v[j].z * v[j].z + v[j].w * v[j].w); }
    const float rstd = 1.f / sqrtf(wave_sum(s) * (1.f / D) + EPS);
    GAS unsigned long long* o8 = (GAS unsigned long long*)orow + lane;
#pragma unroll
    for (int j = 0; j < 4; ++j) { const f32x4 ww = wr[64 * j];
        o8[64 * j] = (unsigned long long)pk2(v[j].x * rstd * ww.x, v[j].y * rstd * ww.y) | ((unsigned long long)pk2(v[j].z * rstd * ww.z, v[j].w * rstd * ww.w) << 32); }
}
__device__ __forceinline__ void p0_prologue(Frame& F) {
    LAS float* scr = (LAS float*)(F.lds + RING_OFF + F.wave * 16384);
    const int gw = F.vcu * NWAVES + F.wave, NGW = F.G * NWAVES;
    bf16* WinT = (bf16*)(F.ws + WS_WIN);
    constexpr int NITEMS = (D / 64) * (NPROJ / 32);
    for (int it = gw; it < NITEMS; it += NGW) { const int kb = it / (NPROJ / 32), nb = it % (NPROJ / 32);
        p0_transpose_item(F.in[2], D, PROJ, WinT, kb, inproj_src(nb), 32 * nb, scr, F.lane); }
    bf16* XN = (bf16*)(F.ws + WS_XN);
    for (int m = gw; m < M; m += NGW) rms_row_to_bf16(F.lane, F.in[0] + (size_t)m * D, F.in[1], XN + (size_t)m * D);
}
constexpr int WL_IO = (2048 / 64) * (1024 / 32), WL_I1 = (1024 / 64) * (4096 / 32), WL_I2 = (4096 / 64) * (1024 / 32);
__device__ __forceinline__ int skew_n(int G) { return (G >> 4) * 8 + ((G & 15) > 8 ? (G & 15) - 8 : 0); }
__device__ __forceinline__ bool skew_on(int G) { return skew_n(G) >= 32; }
__device__ __forceinline__ void p_weights_late(Frame& F, int lo, int hi, int rank, int nworkers) {
    LAS float* scr = (LAS float*)(F.lds + RING_OFF + F.wave * 16384);
    const int gw = rank * NWAVES + F.wave, NGW = nworkers * NWAVES;
    constexpr int I_O = WL_IO, I_1 = WL_I1;
    for (int it = lo + gw; it < hi; it += NGW) {
        int r = it;
        if (r < I_O) { p0_transpose_item(F.in[14], 2048, 1024, (bf16*)(F.ws + WS_WOUT), r / 32, 32 * (r % 32), 32 * (r % 32), scr, F.lane); continue; } r -= I_O;
        if (r < I_1) { p0_transpose_item(F.in[16], 1024, 4096, (bf16*)(F.ws + WS_W1), r / 128, 32 * (r % 128), 32 * (r % 128), scr, F.lane); continue; } r -= I_1;
        p0_transpose_item(F.in[17], 4096, 1024, (bf16*)(F.ws + WS_W2), r / 32, 32 * (r % 32), 32 * (r % 32), scr, F.lane);
    }
}

__device__ __forceinline__ void ssd_scan(Frame& F, const int dry) {
    const float* DEC = (const float*)(F.ws + WS_DEC);
    for (int gid = F.vcu * 512 + F.tid; gid < 2 * BATCH * NH * 2048; gid += F.G * 512) {
        const int dir = gid >> 16, rem = gid & 65535, b = rem >> 15, h = (rem >> 11) & 15, e4 = rem & 2047;
        unsigned long long* S = (unsigned long long*)(F.ws + (dir ? WS_SB : WS_SF)) + e4;
        const float* dec = DEC + dir * (BATCH * NCH * NH);
        float h0 = 0.f, h1 = 0.f, h2 = 0.f, h3 = 0.f;
        unsigned long long va[16], vb[16]; float da[16], db[16];
#define SCAN_ITEM(cc) ((b * NCH + (dir ? NCH - 1 - (cc) : (cc))) * NH + h)
#define SCAN_LOAD(V, Dv, bt) do { _Pragma("unroll") for (int i = 0; i < 16; ++i) { const int it_ = SCAN_ITEM(16 * (bt) + i); V[i] = S[(size_t)it_ * 2048]; Dv[i] = dec[it_]; } } while (0)
#define SCAN_PROC(V, Dv, bt) do { _Pragma("unroll") for (int i = 0; i < 16; ++i) { const int it_ = SCAN_ITEM(16 * (bt) + i); const unsigned long long v = V[i]; const float d = Dv[i]; \
            if (!dry) S[(size_t)it_ * 2048] = (unsigned long long)pk2(h0, h1) | ((unsigned long long)pk2(h2, h3) << 32); \
            h0 = d * h0 + __builtin_bit_cast(float, (unsigned)v << 16); h1 = d * h1 + __builtin_bit_cast(float, (unsigned)v & 0xffff0000u); \
            h2 = d * h2 + __builtin_bit_cast(float, (unsigned)(v >> 32) << 16); h3 = d * h3 + __builtin_bit_cast(float, (unsigned)(v >> 32) & 0xffff0000u); } } while (0)
        SCAN_LOAD(va, da, 0);
        SCAN_LOAD(vb, db, 1); SCAN_PROC(va, da, 0);
        SCAN_LOAD(va, da, 2); SCAN_PROC(vb, db, 1);
        SCAN_LOAD(vb, db, 3); SCAN_PROC(va, da, 2);
        SCAN_PROC(vb, db, 3);
#undef SCAN_ITEM
#undef SCAN_LOAD
#undef SCAN_PROC
    }
}

typedef float f32x16 __attribute__((ext_vector_type(16)));
typedef unsigned u32x2v __attribute__((ext_vector_type(2)));
constexpr int V_ACF = 0, V_RCB = 128, V_DTF = 256, V_DTB = 384, V_CFF = 512, V_CFB = 640, V_EF = 768, V_EB = 896;
__device__ __forceinline__ float bflo(unsigned u) { return __builtin_bit_cast(float, u << 16); }
__device__ __forceinline__ float bfhi(unsigned u) { return __builtin_bit_cast(float, u & 0xffff0000u); }
__device__ __forceinline__ void ssd_out_mfma(Frame& F, const int dry) {
    LAS unsigned char* CBs = F.lds;
    LAS unsigned char* Cs = F.lds + 16384;
    LAS float* vecs = (LAS float*)(F.lds + 32768) + F.wave * 1024;
    LAS float* rowss = (LAS float*)(F.lds + 69632);
    LAS float* rstdv = rowss + 512;
    bf16* ZQ = (bf16*)(F.ws + WS_ZQ); const float* DT = (const float*)(F.ws + WS_DT);
    const bf16* SF = (const bf16*)(F.ws + WS_SF); const bf16* SB = (const bf16*)(F.ws + WS_SB);
    const bf16* XST = (const bf16*)((const unsigned char*)F.out + SC_XST); const bf16* BN = (const bf16*)((const unsigned char*)F.out + SC_BN); const bf16* CN = (const bf16*)((const unsigned char*)F.out + SC_CN);
    const int w = F.wave;
    for (int item = F.vcu; item < BATCH * NCH * NGRP * 2; item += F.G) {
        int lane = F.lane; asm volatile("" : "+v"(lane));
        const int r = lane & 31, hp = lane >> 5;
        const int half = item & 1, g = (item >> 1) & 1, bc = item >> 2, m0 = bc * CH, h = HPG * g + w, L0 = 64 * half;
        const bf16* xst = XST + (size_t)(bc * NH + h) * (HD * CH);
        const size_t sbase = (size_t)(bc * NH + h) * (HD * NST);
        bf16x8 xsf[2][8], bfr[8];
        { const bf16* bn = BN + ((size_t)(bc * NGRP + g) * CH + 32 * (w & 3) + r) * NST + 8 * hp;
#pragma unroll
          for (int ks = 0; ks < 8; ++ks) bfr[ks] = *(const bf16x8*)(bn + 16 * ks);
#pragma unroll
          for (int pt = 0; pt < 2; ++pt)
#pragma unroll
              for (int ks = 0; ks < 8; ++ks) xsf[pt][ks] = *(const bf16x8*)(xst + (size_t)(32 * pt + r) * CH + 16 * ks + 8 * hp); }
        { const int row = F.tid >> 3, ch2 = 2 * (F.tid & 7); const v4u* src = (const v4u*)(CN + ((size_t)(bc * NGRP + g) * CH + L0 + row) * NST + 8 * ch2);
          const v4u a = src[0], b2 = src[1];
          *(LAS v4u*)(Cs + row * 256 + ((ch2 ^ (row & 15)) << 4)) = a; *(LAS v4u*)(Cs + row * 256 + (((ch2 + 1) ^ (row & 15)) << 4)) = b2; }
        {
            const float Af = -__expf(F.in[7][h]), Ab = -__expf(F.in[8][h]);
            const int l0 = 2 * lane;
            const float df0 = DT[(size_t)(m0 + l0) * 32 + h], df1 = DT[(size_t)(m0 + l0 + 1) * 32 + h], db0 = DT[(size_t)(m0 + l0) * 32 + 16 + h], db1 = DT[(size_t)(m0 + l0 + 1) * 32 + 16 + h];
            const float a0 = df0 * Af, a1 = df1 * Af, b0 = db0 * Ab, b1 = db1 * Ab;
            float x = a0 + a1, y = b0 + b1;
#pragma unroll
            for (int off = 1; off < 64; off <<= 1) { const float t = __shfl_up(x, off), u = __shfl_down(y, off); if (lane >= off) x += t; if (lane + off < 64) y += u; }
            const float acf0 = x - a1, acf1 = x, rcb0 = y, rcb1 = y - b0;
            vecs[V_ACF + l0] = acf0; vecs[V_ACF + l0 + 1] = acf1; vecs[V_RCB + l0] = rcb0; vecs[V_RCB + l0 + 1] = rcb1;
            vecs[V_DTF + l0] = df0; vecs[V_DTF + l0 + 1] = df1; vecs[V_DTB + l0] = db0; vecs[V_DTB + l0 + 1] = db1;
            vecs[V_EF + l0] = __expf(acf0); vecs[V_EF + l0 + 1] = __expf(acf1); vecs[V_EB + l0] = __expf(rcb0); vecs[V_EB + l0 + 1] = __expf(rcb1);
            LDS_WAIT(); asm volatile("" ::: "memory");
            const int kb = l0 >> 4; const float Rf = vecs[V_ACF + 16 * kb + 15], Rb = vecs[V_RCB + 16 * kb];
            vecs[V_CFF + l0] = __expf(Rf - acf0) * df0; vecs[V_CFF + l0 + 1] = __expf(Rf - acf1) * df1;
            vecs[V_CFB + l0] = __expf(Rb - rcb0) * db0; vecs[V_CFB + l0 + 1] = __expf(Rb - rcb1) * db1;
        }
        {
            const int lt = w >> 2, st = w & 3, crow = 32 * lt + r;
            __syncthreads();
            f32x16 c = {};
#pragma unroll
            for (int ks = 0; ks < 8; ++ks) { const bf16x8 a = *(const LAS bf16x8*)(Cs + crow * 256 + (((2 * ks + hp) ^ (crow & 15)) << 4)); c = __builtin_amdgcn_mfma_f32_32x32x16_bf16(a, bfr[ks], c, 0, 0, 0); }
            const int s = 32 * st + r;
#pragma unroll
            for (int reg = 0; reg < 16; ++reg) { const int l = 32 * lt + (reg & 3) + 8 * (reg >> 2) + 4 * hp;
                *(LAS bf16*)(CBs + l * 256 + ((((s >> 3) ^ (l & 15))) << 4) + (s & 7) * 2) = (bf16)pk2(c[reg], 0.f); }
        }
        __syncthreads();
        f32x16 acc[2][2];
#pragma unroll
        for (int a = 0; a < 2; ++a)
#pragma unroll
            for (int b = 0; b < 2; ++b) acc[a][b] = (f32x16){};
        bf16x8 hbA[8], hbB[8];
#define SSD_HLOAD(HB, dir, pt) do { const bf16* hrow_ = ((dir) ? SB : SF) + sbase + (size_t)(32 * (pt) + r) * NST + 8 * hp; \
            _Pragma("unroll") for (int ks = 0; ks < 8; ++ks) HB[ks] = *(const bf16x8*)(hrow_ + 16 * ks); } while (0)
        SSD_HLOAD(hbA, 0, 0);
        __builtin_amdgcn_sched_barrier(0);
        {
            float acl[2], rcl[2];
#pragma unroll
            for (int lt = 0; lt < 2; ++lt) { acl[lt] = vecs[V_ACF + L0 + 32 * lt + r]; rcl[lt] = vecs[V_RCB + L0 + 32 * lt + r]; }
#pragma unroll
            for (int ks = 0; ks < 8; ++ks) {
                const int s0 = 16 * ks + 8 * hp;
#pragma unroll
                for (int lt = 0; lt < 2; ++lt) {
                    const int lrow = 32 * lt + r, l = L0 + lrow, kd = 4 * half + 2 * lt;
                    const v4u cbv = *(const LAS v4u*)(CBs + lrow * 256 + (((2 * ks + hp) ^ (lrow & 15)) << 4));
                    float gv[8];
#pragma unroll
                    for (int e = 0; e < 4; ++e) { gv[2 * e] = bflo(cbv[e]); gv[2 * e + 1] = bfhi(cbv[e]); }
                    if (ks < kd) {
                        const float rf = __expf(acl[lt] - vecs[V_ACF + 16 * ks + 15]);
                        const f32x4 c0 = *(const LAS f32x4*)(vecs + V_CFF + s0), c1 = *(const LAS f32x4*)(vecs + V_CFF + s0 + 4);
#pragma unroll
                        for (int j = 0; j < 4; ++j) { gv[j] *= c0[j] * rf; gv[4 + j] *= c1[j] * rf; }
                    } else if (ks > kd + 1) {
                        const float rb = __expf(rcl[lt] - vecs[V_RCB + 16 * ks]);
                        const f32x4 c0 = *(const LAS f32x4*)(vecs + V_CFB + s0), c1 = *(const LAS f32x4*)(vecs + V_CFB + s0 + 4);
#pragma unroll
                        for (int j = 0; j < 4; ++j) { gv[j] *= c0[j] * rb; gv[4 + j] *= c1[j] * rb; }
                    } else {
#pragma unroll
                        for (int q = 0; q < 2; ++q) {
                            const f32x4 af = *(const LAS f32x4*)(vecs + V_ACF + s0 + 4 * q), rb = *(const LAS f32x4*)(vecs + V_RCB + s0 + 4 * q);
                            const f32x4 df = *(const LAS f32x4*)(vecs + V_DTF + s0 + 4 * q), db = *(const LAS f32x4*)(vecs + V_DTB + s0 + 4 * q);
#pragma unroll
                            for (int j = 0; j < 4; ++j) { const int s = s0 + 4 * q + j;
                                const float tf = __expf(fminf(acl[lt] - af[j], 0.f)) * df[j], tb = __expf(fminf(rcl[lt] - rb[j], 0.f)) * db[j];
                                const float mm = (l >= s ? tf : 0.f) + (l <= s ? tb : 0.f);
                                gv[4 * q + j] *= mm; }
                        }
                    }
                    v4u gp; gp.x = pk2(gv[0], gv[1]); gp.y = pk2(gv[2], gv[3]); gp.z = pk2(gv[4], gv[5]); gp.w = pk2(gv[6], gv[7]);
                    const bf16x8 ga = __builtin_bit_cast(bf16x8, gp);
#pragma unroll
                    for (int pt = 0; pt < 2; ++pt) acc[lt][pt] = __builtin_amdgcn_mfma_f32_32x32x16_bf16(ga, xsf[pt][ks], acc[lt][pt], 0, 0, 0);
                }
            }
        }
        __builtin_amdgcn_sched_barrier(0);
        SSD_HLOAD(hbB, 0, 1);
        __builtin_amdgcn_sched_barrier(0);
        {
#define SSD_YOFF(HB, dir, pt) do { f32x16 t0 = {}, t1 = {}; \
            _Pragma("unroll") for (int ks = 0; ks < 8; ++ks) { \
                const bf16x8 c0 = *(const LAS bf16x8*)(Cs + r * 256 + (((2 * ks + hp) ^ (r & 15)) << 4)), c1 = *(const LAS bf16x8*)(Cs + (32 + r) * 256 + (((2 * ks + hp) ^ (r & 15)) << 4)); \
                t0 = __builtin_amdgcn_mfma_f32_32x32x16_bf16(c0, HB[ks], t0, 0, 0, 0); t1 = __builtin_amdgcn_mfma_f32_32x32x16_bf16(c1, HB[ks], t1, 0, 0, 0); } \
            _Pragma("unroll") for (int q = 0; q < 4; ++q) { \
                const f32x4 e0 = *(const LAS f32x4*)(vecs + ((dir) ? V_EB : V_EF) + L0 + 8 * q + 4 * hp), e1 = *(const LAS f32x4*)(vecs + ((dir) ? V_EB : V_EF) + L0 + 32 + 8 * q + 4 * hp); \
                _Pragma("unroll") for (int i = 0; i < 4; ++i) { acc[0][pt][4 * q + i] += e0[i] * t0[4 * q + i]; acc[1][pt][4 * q + i] += e1[i] * t1[4 * q + i]; } } \
            asm volatile("" : "+v"(acc[0][pt]), "+v"(acc[1][pt])); __builtin_amdgcn_sched_barrier(0); } while (0)
            SSD_YOFF(hbA, 0, 0); SSD_HLOAD(hbA, 1, 0); __builtin_amdgcn_sched_barrier(0);
            SSD_YOFF(hbB, 0, 1); SSD_HLOAD(hbB, 1, 1); __builtin_amdgcn_sched_barrier(0);
            SSD_YOFF(hbA, 1, 0);
            SSD_YOFF(hbB, 1, 1);
#undef SSD_YOFF
#undef SSD_HLOAD
            const float Dh = F.in[9][h];
#pragma unroll
            for (int lt = 0; lt < 2; ++lt)
#pragma unroll
                for (int pt = 0; pt < 2; ++pt)
#pragma unroll
                    for (int q = 0; q < 4; ++q) { const u32x2v xv = *(const u32x2v*)(xst + (size_t)(32 * pt + r) * CH + L0 + 32 * lt + 8 * q + 4 * hp);
                        acc[lt][pt][4 * q] += Dh * bflo(xv.x); acc[lt][pt][4 * q + 1] += Dh * bfhi(xv.x); acc[lt][pt][4 * q + 2] += Dh * bflo(xv.y); acc[lt][pt][4 * q + 3] += Dh * bfhi(xv.y); }
        }
        {
            __syncthreads();
            LAS float* stg = (LAS float*)(F.lds) + w * (32 * 68);
            const int row = lane >> 1, pc = (lane & 1) * 32;
            float gt[2][32];
#pragma unroll
            for (int lt = 0; lt < 2; ++lt) {
#pragma unroll
                for (int reg = 0; reg < 16; ++reg) { const int rr = (reg & 3) + 8 * (reg >> 2) + 4 * hp; stg[rr * 68 + r] = acc[lt][0][reg]; stg[rr * 68 + 32 + r] = acc[lt][1][reg]; }
                LDS_WAIT(); asm volatile("" ::: "memory");
                const bf16* zr = ZQ + (size_t)(m0 + L0 + 32 * lt + row) * 2048 + h * HD + pc;
                float ss = 0.f;
#pragma unroll
                for (int c = 0; c < 4; ++c) { const v4u zv = *(const v4u*)(zr + 8 * c); const f32x4 y0 = *(const LAS f32x4*)(stg + row * 68 + pc + 8 * c), y1 = *(const LAS f32x4*)(stg + row * 68 + pc + 8 * c + 4);
#pragma unroll
                    for (int e = 0; e < 4; ++e) { const float ya = e < 2 ? y0[2 * e] : y1[2 * e - 4], yb = e < 2 ? y0[2 * e + 1] : y1[2 * e - 3];
                        const float ga = ya * silu_f(bflo(zv[e])), gb = yb * silu_f(bfhi(zv[e])); gt[lt][8 * c + 2 * e] = ga; gt[lt][8 * c + 2 * e + 1] = gb; ss += ga * ga + gb * gb; } }
                ss += __shfl_xor(ss, 1);
                if ((lane & 1) == 0) rowss[(32 * lt + row) * 8 + w] = ss;
                LDS_WAIT(); asm volatile("" ::: "memory");
            }
            __syncthreads();
            if (F.tid < 64) { const f32x4 a = *(const LAS f32x4*)(rowss + F.tid * 8), b = *(const LAS f32x4*)(rowss + F.tid * 8 + 4);
                rstdv[F.tid] = 1.0f / sqrtf(((a[0] + a[1]) + (a[2] + a[3]) + (b[0] + b[1]) + (b[2] + b[3])) * (1.0f / 512.0f) + EPS); }
            __syncthreads();
            const float* nwp = F.in[10] + h * HD + pc;
#pragma unroll
            for (int lt = 0; lt < 2; ++lt) { const float rs = rstdv[32 * lt + row]; bf16* zo = ZQ + (size_t)(m0 + L0 + 32 * lt + row) * 2048 + h * HD + pc;
#pragma unroll
                for (int c = 0; c < 4; ++c) { const f32x4 w0 = *(const f32x4*)(nwp + 8 * c), w1 = *(const f32x4*)(nwp + 8 * c + 4); v4u o;
                    o.x = pk2(gt[lt][8 * c] * rs * w0[0], gt[lt][8 * c + 1] * rs * w0[1]); o.y = pk2(gt[lt][8 * c + 2] * rs * w0[2], gt[lt][8 * c + 3] * rs * w0[3]);
                    o.z = pk2(gt[lt][8 * c + 4] * rs * w1[0], gt[lt][8 * c + 5] * rs * w1[1]); o.w = pk2(gt[lt][8 * c + 6] * rs * w1[2], gt[lt][8 * c + 7] * rs * w1[3]);
                    if (!dry) *(v4u*)(zo + 8 * c) = o; } }
        }
        __syncthreads();
    }
}


__device__ __forceinline__ void ssd_states_mfma(Frame& F) {
    LAS unsigned char* BT = F.lds;
    LAS unsigned char* XT = F.lds + 32768;
    LAS float* wv = (LAS float*)(F.lds + 98304) + F.wave * 128;
    const bf16* XBC = (const bf16*)(F.ws + WS_XBC); const float* DT = (const float*)(F.ws + WS_DT);
    const float* cw = F.in[3]; const float* cbias = F.in[4];
    bf16* XST = (bf16*)((unsigned char*)F.out + SC_XST); bf16* BN = (bf16*)((unsigned char*)F.out + SC_BN); bf16* CN = (bf16*)((unsigned char*)F.out + SC_CN);
    float* DEC = (float*)(F.ws + WS_DEC);
    const int w = F.wave;
    for (int item = F.vcu; item < BATCH * NCH * NGRP * 2; item += F.G) {
        const int quad = item & 1, g = (item >> 1) & 1, bc = item >> 2, m0 = bc * CH, tbase = m0 & (T - 1);
        __syncthreads();
        int lane = F.lane; asm volatile("" : "+v"(lane));
        const int r = lane & 31, hp = lane >> 5, hq = w >> 1, dir = w & 1, h = HPG * g + 4 * quad + hq;
        const float Adec = -__expf((dir ? F.in[8] : F.in[7])[h]);
        const float d0 = DT[(size_t)(m0 + 2 * lane) * 32 + 16 * dir + h], d1 = DT[(size_t)(m0 + 2 * lane + 1) * 32 + 16 * dir + h];
        {
            int tid = F.tid; asm volatile("" : "+v"(tid));
            const int rb = tid & 7, cgi = tid >> 3;
            const int kind = cgi < 16 ? 0 : (cgi < 48 ? 1 : 2);
            const int ch0 = kind == 0 ? 1024 + NST * g + 8 * cgi : (kind == 1 ? HD * (HPG * g + 4 * quad) + 8 * (cgi - 16) : 1280 + NST * g + 8 * (cgi - 48));
            if (kind != 2 || quad == 0) {
                v4u in[20];
#pragma unroll
                for (int i = 0; i < 20; ++i) { const int t = tbase + 16 * rb - 2 + i; v4u z = {0u, 0u, 0u, 0u};
                    in[i] = (t >= 0 && t < T) ? *(const v4u*)(XBC + (size_t)(m0 + 16 * rb - 2 + i) * CONVD + ch0) : z; }
                f32x4 wk[5][2], bb[2];
#pragma unroll
                for (int k = 0; k < 5; ++k) { wk[k][0] = *(const f32x4*)(cw + k * CONVD + ch0); wk[k][1] = *(const f32x4*)(cw + k * CONVD + ch0 + 4); }
                bb[0] = *(const f32x4*)(cbias + ch0); bb[1] = *(const f32x4*)(cbias + ch0 + 4);
#pragma unroll
                for (int hf = 0; hf < 2; ++hf) {
                    const int lr0 = 16 * rb + 8 * hf;
                    unsigned tp[8][4];
                    f32x4 prev[2];
#pragma unroll
                    for (int o = 0; o < 8; ++o) {
                        f32x4 y0 = bb[0], y1 = bb[1];
#pragma unroll
                        for (int k = 0; k < 5; ++k) { const v4u xv = in[8 * hf + o + k];
                            const f32x4 x0 = {bflo(xv.x), bfhi(xv.x), bflo(xv.y), bfhi(xv.y)}, x1 = {bflo(xv.z), bfhi(xv.z), bflo(xv.w), bfhi(xv.w)};
                            y0 += wk[k][0] * x0; y1 += wk[k][1] * x1; }
#pragma unroll
                        for (int e = 0; e < 4; ++e) { y0[e] = silu_f(y0[e]); y1[e] = silu_f(y1[e]); }
                        if (kind != 1 && quad == 0) {
                            v4u o4; o4.x = pk2(y0[0], y0[1]); o4.y = pk2(y0[2], y0[3]); o4.z = pk2(y1[0], y1[1]); o4.w = pk2(y1[2], y1[3]);
                            bf16* dst = (kind == 0 ? BN : CN) + ((size_t)(bc * NGRP + g) * CH + lr0 + o) * NST + 8 * (kind == 0 ? cgi : cgi - 48);
                            *(v4u*)dst = o4; }
                        if (o & 1) {
#pragma unroll
                            for (int e = 0; e < 4; ++e) { tp[e][o >> 1] = pk2(prev[0][e], y0[e]); tp[4 + e][o >> 1] = pk2(prev[1][e], y1[e]); }
                        } else { prev[0] = y0; prev[1] = y1; }
                    }
                    const int chunk = 2 * rb + hf;
                    if (kind == 0) {
#pragma unroll
                        for (int c = 0; c < 8; ++c) { const int n = 8 * cgi + c; v4u v = {tp[c][0], tp[c][1], tp[c][2], tp[c][3]}; *(LAS v4u*)(BT + n * 256 + ((chunk ^ (n & 15)) << 4)) = v; }
                    } else if (kind == 1) {
#pragma unroll
                        for (int c = 0; c < 8; ++c) { const int pp = 8 * (cgi - 16) + c; v4u v = {tp[c][0], tp[c][1], tp[c][2], tp[c][3]}; *(LAS v4u*)(XT + pp * 256 + ((chunk ^ (pp & 15)) << 4)) = v;
                            *(v4u*)(XST + ((size_t)(bc * NH + HPG * g + 4 * quad) * HD + pp) * CH + lr0) = v; }
                    }
                }
            }
        }
        float total;
        {
            const int l0 = 2 * lane; const float a0 = d0 * Adec, a1 = d1 * Adec;
            float x = a0 + a1, y = x;
#pragma unroll
            for (int off = 1; off < 64; off <<= 1) { const float t = __shfl_up(x, off), u = __shfl_down(y, off); if (lane >= off) x += t; if (lane + off < 64) y += u; }
            total = __shfl(x, 63);
            const float e0 = dir ? y : x - a1, e1 = dir ? y - a0 : x;
            wv[l0] = d0 * __expf(total - e0); wv[l0 + 1] = d1 * __expf(total - e1);
        }
        __syncthreads();
        f32x16 acc[4][2];
#pragma unroll
        for (int a = 0; a < 4; ++a)
#pragma unroll
            for (int b = 0; b < 2; ++b) acc[a][b] = (f32x16){};
#pragma unroll 2
        for (int ks = 0; ks < 8; ++ks) {
            const int chunk = 2 * ks + hp;
            bf16x8 af[4], bfr[2];
#pragma unroll
            for (int nt = 0; nt < 4; ++nt) { const int n = 32 * nt + r; af[nt] = *(const LAS bf16x8*)(BT + n * 256 + ((chunk ^ (n & 15)) << 4)); }
            const f32x4 w0 = *(const LAS f32x4*)(wv + 16 * ks + 8 * hp), w1 = *(const LAS f32x4*)(wv + 16 * ks + 8 * hp + 4);
#pragma unroll
            for (int pt = 0; pt < 2; ++pt) { const int pp = 64 * hq + 32 * pt + r; const v4u xv = *(const LAS v4u*)(XT + pp * 256 + ((chunk ^ (pp & 15)) << 4));
                v4u sv; sv.x = pk2(bflo(xv.x) * w0[0], bfhi(xv.x) * w0[1]); sv.y = pk2(bflo(xv.y) * w0[2], bfhi(xv.y) * w0[3]);
                sv.z = pk2(bflo(xv.z) * w1[0], bfhi(xv.z) * w1[1]); sv.w = pk2(bflo(xv.w) * w1[2], bfhi(xv.w) * w1[3]);
                bfr[pt] = __builtin_bit_cast(bf16x8, sv); }
#pragma unroll
            for (int nt = 0; nt < 4; ++nt)
#pragma unroll
                for (int pt = 0; pt < 2; ++pt) acc[nt][pt] = __builtin_amdgcn_mfma_f32_32x32x16_bf16(af[nt], bfr[pt], acc[nt][pt], 0, 0, 0);
        }
        asm volatile("s_waitcnt lgkmcnt(0)" ::: "memory"); __syncthreads();
        {
            LAS unsigned char* stg = F.lds + w * (64 * 264);
#pragma unroll
            for (int nt = 0; nt < 4; ++nt)
#pragma unroll
                for (int pt = 0; pt < 2; ++pt)
#pragma unroll
                    for (int q = 0; q < 4; ++q) { u32x2v o; o.x = pk2(acc[nt][pt][4 * q], acc[nt][pt][4 * q + 1]); o.y = pk2(acc[nt][pt][4 * q + 2], acc[nt][pt][4 * q + 3]);
                        *(LAS u32x2v*)(stg + (32 * pt + r) * 264 + (32 * nt + 8 * q + 4 * hp) * 2) = o; }
            asm volatile("s_waitcnt lgkmcnt(0)" ::: "memory");
            bf16* Sp = (bf16*)(F.ws + (dir ? WS_SB : WS_SF)) + (size_t)(bc * NH + h) * (HD * NST);
#pragma unroll
            for (int j = 0; j < 16; ++j) { const int row = 4 * j + (lane >> 4), ch = lane & 15;
                const u32x2v a = *(const LAS u32x2v*)(stg + row * 264 + ch * 16), b2 = *(const LAS u32x2v*)(stg + row * 264 + ch * 16 + 8);
                v4u o; o.x = a.x; o.y = a.y; o.z = b2.x; o.w = b2.y; *(v4u*)(Sp + (size_t)row * NST + ch * 8) = o; }
            if (lane == 0) DEC[dir * (BATCH * NCH * NH) + bc * NH + h] = __expf(total);
        }
    }
    __syncthreads();
}

struct NaTile { float m, l; f32x4 o[4]; };
__device__ __forceinline__ void na_tile(NaTile& S, const bf16x8 (&kf)[4], const u32x2v (&vl)[4], const u32x2v (&vh)[4], const bf16x8 qf0, const bf16x8 qf1,
                                        const float (&be)[8]) {
    const f32x4 z = {0.f, 0.f, 0.f, 0.f};
    f32x4 s0 = __builtin_amdgcn_mfma_f32_16x16x32_bf16(kf[0], qf0, z, 0, 0, 0); s0 = __builtin_amdgcn_mfma_f32_16x16x32_bf16(kf[1], qf1, s0, 0, 0, 0);
    f32x4 s1 = __builtin_amdgcn_mfma_f32_16x16x32_bf16(kf[2], qf0, z, 0, 0, 0); s1 = __builtin_amdgcn_mfma_f32_16x16x32_bf16(kf[3], qf1, s1, 0, 0, 0);
    float sv[8]; float mx = -1e30f;
#pragma unroll
    for (int ct = 0; ct < 2; ++ct)
#pragma unroll
        for (int reg = 0; reg < 4; ++reg) { const float s = (ct ? s1[reg] : s0[reg]) + be[4 * ct + reg]; sv[4 * ct + reg] = s; mx = fmaxf(mx, s); }
    mx = red32_max(red16_max(mx));
    const float mn = fmaxf(S.m, mx), alpha = __builtin_amdgcn_exp2f(S.m - mn); S.m = mn;
    float ps = 0.f;
#pragma unroll
    for (int e = 0; e < 8; ++e) { sv[e] = __builtin_amdgcn_exp2f(sv[e] - mn); ps += sv[e]; }
    S.l = S.l * alpha + ps;
    v4u pb; pb.x = pk2(sv[0], sv[1]); pb.y = pk2(sv[2], sv[3]); pb.z = pk2(sv[4], sv[5]); pb.w = pk2(sv[6], sv[7]);
    const bf16x8 pf = __builtin_bit_cast(bf16x8, pb);
#pragma unroll
    for (int dt = 0; dt < 4; ++dt) { v4u vv; vv.x = vl[dt].x; vv.y = vl[dt].y; vv.z = vh[dt].x; vv.w = vh[dt].y;
        S.o[dt] = __builtin_amdgcn_mfma_f32_16x16x32_bf16(__builtin_bit_cast(bf16x8, vv), pf, S.o[dt] * alpha, 0, 0, 0); }
}
constexpr int NA_SLOT = 16384, NA_NSLOT = 9, NA_BIAS_OFF = NA_SLOT * NA_NSLOT;
__device__ __forceinline__ int na_r0(int i) { int r = i - KH / 2; return r < 0 ? 0 : (r > GROWS - KH ? GROWS - KH : r); }
__device__ __forceinline__ void na_mfma(Frame& F, const int dry) {
    LAS unsigned char* ring = F.lds;
    LAS float* bias = (LAS float*)(F.lds + NA_BIAS_OFF);
    bf16* ZQ = (bf16*)(F.ws + WS_ZQ); const bf16* KB = (const bf16*)(F.ws + WS_K); const bf16* VT = (const bf16*)(F.ws + WS_V);
    const int w = F.wave;
    constexpr int NITEM = BATCH * NH * (GROWS / 16);
    for (int item = F.vcu; item < NITEM; item += F.G) {
        const int bh = item >> 3, band = item & 7, b = bh / NH, hh = bh % NH;
        __syncthreads();
        for (int u = F.tid; u < 15 * 31; u += NWAVES * 64) bias[u] = F.in[13][hh * 465 + u];
        int lane = F.lane; asm volatile("" : "+v"(lane));
        const int c = lane & 15, g4 = lane >> 4, qrow = w >> 2, jb = w & 3, j0 = 16 * jb, j = j0 + c;
        int cs = j0 - 8; cs = cs < 0 ? 0 : (cs > 32 ? 32 : cs);
        int c0 = j - 8; c0 = c0 < 0 ? 0 : (c0 > GW - KW ? GW - KW : c0);
        const int kc0 = cs + 4 * g4, bcol = kc0 - j + 15;
        const int prow = 8 * w + (lane >> 3), lchunk = (lane & 7) ^ ((prow >> 1) & 7);
        const bf16* ksrc = KB + ((size_t)b * T + prow) * 1024 + hh * HD + 8 * lchunk;
        const bf16* vsrc = VT + (size_t)(hh * HD + prow) * M + (size_t)b * T + 8 * lchunk;
#define NA_DMA(kr) do { const int kr_ = (kr); LAS unsigned char* sl_ = ring + (kr_ % NA_NSLOT) * NA_SLOT + w * 1024; \
            __builtin_amdgcn_global_load_lds((const unsigned*)(ksrc + (size_t)kr_ * GW * 1024), (LAS unsigned*)(sl_), 16, 0, 0); \
            __builtin_amdgcn_global_load_lds((const unsigned*)(vsrc + (size_t)kr_ * GW), (LAS unsigned*)(sl_ + 8192), 16, 0, 0); } while (0)
        int koff[4], voff[4], voffh[4];
#pragma unroll
        for (int ct = 0; ct < 2; ++ct)
#pragma unroll
            for (int ks = 0; ks < 2; ++ks) { const int tok = cs + 16 * ct + c; koff[2 * ct + ks] = tok * 128 + (((4 * ks + g4) ^ ((tok >> 1) & 7)) << 4); }
        const int vob = ((cs + 4 * g4) * 2) & 15, vlc = ((cs + 4 * g4) * 2) >> 4;
#pragma unroll
        for (int dt = 0; dt < 4; ++dt) { const int d = 16 * dt + c; voff[dt] = 8192 + d * 128 + vob + ((vlc ^ ((d >> 1) & 7)) << 4); voffh[dt] = 8192 + d * 128 + vob + (((vlc + 2) ^ ((d >> 1) & 7)) << 4); }
        const int i00 = 16 * band;
        { const int rA = na_r0(i00), rB = na_r0(i00 + 1); for (int kr = rA; kr < rB + KH; ++kr) NA_DMA(kr); }
        bf16* qp = ZQ + ((size_t)b * T + (i00 + qrow) * GW + j) * 2048 + 1024 + hh * HD;
        bf16x8 qf0 = *(const bf16x8*)(qp + 8 * g4), qf1 = *(const bf16x8*)(qp + 32 + 8 * g4);
        asm volatile("s_waitcnt vmcnt(0)" ::: "memory"); __syncthreads();
        float be[8][8]; int cur_rel = 1000;
        u32x2v pend[4]; bf16* pendp = qp; bool have_pend = false;
#pragma unroll
        for (int dt = 0; dt < 4; ++dt) pend[dt] = (u32x2v){0u, 0u};
#pragma unroll 1
        for (int it = 0; it < 8; ++it) {
            const int i0 = i00 + 2 * it, i = i0 + qrow, r0 = na_r0(i);
            if (r0 - i != cur_rel) { cur_rel = r0 - i;
#pragma unroll
                for (int s_ = 0; s_ < 8; ++s_)
#pragma unroll
                    for (int ct = 0; ct < 2; ++ct)
#pragma unroll
                        for (int reg = 0; reg < 4; ++reg) { const int kc = kc0 + 16 * ct + reg; const bool ok = (kc >= c0) && (kc < c0 + KW);
                            const float bv = bias[ok ? (cur_rel + s_ + 7) * 31 + bcol + 16 * ct + reg : 0]; be[s_][4 * ct + reg] = ok ? bv * 1.4426950408889634f : -1e30f; } }
            NaTile t; t.m = -1e30f; t.l = 0.f;
#pragma unroll
            for (int dt = 0; dt < 4; ++dt) t.o[dt] = (f32x4){0.f, 0.f, 0.f, 0.f};
#define NA_STEP(s) do { const int kr_ = r0 + (s); const LAS unsigned char* sl_ = ring + (kr_ % NA_NSLOT) * NA_SLOT; bf16x8 kf_[4]; u32x2v vl_[4], vh_[4]; \
                _Pragma("unroll") for (int q_ = 0; q_ < 4; ++q_) kf_[q_] = *(const LAS bf16x8*)(sl_ + koff[q_]); \
                _Pragma("unroll") for (int q_ = 0; q_ < 4; ++q_) { vl_[q_] = *(const LAS u32x2v*)(sl_ + voff[q_]); vh_[q_] = *(const LAS u32x2v*)(sl_ + voffh[q_]); } \
                na_tile(t, kf_, vl_, vh_, qf0, qf1, be[s]); } while (0)
            NA_STEP(0); NA_STEP(1);
            asm volatile("s_waitcnt lgkmcnt(0)" ::: "memory"); __syncthreads();
            if (have_pend && !dry) {
#pragma unroll
                for (int dt = 0; dt < 4; ++dt) *(u32x2v*)(pendp + 16 * dt + 4 * g4) = pend[dt]; }
            bf16x8 nq0 = qf0, nq1 = qf1; bf16* nqp = qp + (size_t)2 * GW * 2048;
            if (it < 7) { const int rB = na_r0(i0 + 1), rB2 = na_r0(i0 + 3); for (int kr = rB + KH; kr < rB2 + KH; ++kr) NA_DMA(kr);
                nq0 = *(const bf16x8*)(nqp + 8 * g4); nq1 = *(const bf16x8*)(nqp + 32 + 8 * g4); }
            NA_STEP(2); NA_STEP(3); NA_STEP(4); NA_STEP(5); NA_STEP(6); NA_STEP(7);
#undef NA_STEP
            { const float l = red32_add(red16_add(t.l)); const float inv = __builtin_amdgcn_rcpf(l);
#pragma unroll
              for (int dt = 0; dt < 4; ++dt) { pend[dt].x = pk2(t.o[dt][0] * inv, t.o[dt][1] * inv); pend[dt].y = pk2(t.o[dt][2] * inv, t.o[dt][3] * inv); } }
            pendp = qp; have_pend = true;
            qp = nqp; qf0 = nq0; qf1 = nq1;
            asm volatile("s_waitcnt vmcnt(0) lgkmcnt(0)" ::: "memory"); __syncthreads();
        }
        if (!dry) {
#pragma unroll
            for (int dt = 0; dt < 4; ++dt) *(u32x2v*)(pendp + 16 * dt + 4 * g4) = pend[dt]; }
#undef NA_DMA
    }
    __syncthreads();
}

struct Args { const float* in[18]; float* out; unsigned char* ws; int ph_lo, ph_hi, li, pad; };
__global__ void __launch_bounds__(NWAVES * 64, 2) skel_fwd(Args args) {
    extern __shared__ __attribute__((aligned(16))) unsigned char lds[];
    Frame F;
    F.lds = (LAS unsigned char*)lds;
    F.MISC = (volatile LAS unsigned*)(F.lds + MISC_OFF);
    F.tid = threadIdx.x; F.lane = F.tid & 63; F.wave = __builtin_amdgcn_readfirstlane(F.tid >> 6);
    F.G = gridDim.x; { const int bx = blockIdx.x; F.vcu = (F.G % 8 == 0) ? (bx % 8) * (F.G / 8) + bx / 8 : bx; }
    F.ws = args.ws; F.out = args.out;
#pragma unroll
    for (int i = 0; i < 18; ++i) F.in[i] = args.in[i];
    F.ctl = (gu32*)(F.ws + WS_CTL);
#define GRID_BAR(seam) do { if (N_LAUNCHES == PER_PHASE) { if (F.tid == 0) __hip_atomic_store(F.ctl + CW_TMO, 0xBADBA0u | (unsigned)(seam), RLX_AGENT); } \
    else { xcd_barrier(bar); } } while (0)
    for (int u = F.tid; u < (LDS_BYTES - LDSCTL_OFF) / 4; u += NWAVES * 64) ((LAS unsigned*)(F.lds + LDSCTL_OFF))[u] = 0u;
    __syncthreads();
    XcdBarrier bar; bar.bar = (unsigned*)(F.ctl + CW_BAR); bar.x = 0; bar.st = nullptr;
    if (N_LAUNCHES != PER_PHASE) bar = xcd_barrier_post((unsigned*)(F.ctl + CW_BAR), F.MISC + 8);
    const int lo = args.ph_lo, hi = args.ph_hi;
#define IN(k) (lo <= (k) && (k) < hi)
#define BOTH(k) (IN(k) && IN((k) + 1))
    unsigned char* ws = F.ws;
#ifndef PROBE_PHASE
#define PROBE_PHASE -1
#endif
    const int dry0 = (PROBE_PHASE < 0) ? 0 : args.pad, dry1 = args.pad + 1;
#define RUN2(k, DRYCALL, CALL) do { if (PROBE_PHASE == (k)) { DRYCALL; __syncthreads(); } CALL; } while (0)
    if (IN(0)) { RUN2(0, p0_prologue(F), p0_prologue(F)); if (BOTH(0)) GRID_BAR(0); }
    if (IN(1)) {
#define P1_BODY do { \
        pg8::Gemm g{(const bf16*)(ws + WS_WIN), (const bf16*)(ws + WS_WIN), M, NMAIN, D}; pg8::P1Order S; S.init(M, NMAIN, F.G, (int)blockIdx.x); \
        pg8::EpiInProj E{(bf16*)(ws + WS_ZQ), (bf16*)(ws + WS_XBC), (bf16*)(ws + WS_K), (bf16*)(ws + WS_V), (float*)(ws + WS_DT), F.in[11], F.in[12], F.in[5], F.in[6]}; \
        pg8::gemm_phase<pg8::EpiInProj, pg8::P1Order, PG8_ALIGN, PG8_SP2>(F.lds + RING_OFF, g, S, E); } while (0)
        { const int c = (int)blockIdx.x; if (skew_on(F.G) && ((c >> 3) & 1)) { p_weights_late(F, 0, WL_IO + WL_I1, (c >> 4) * 8 + (c & 7), skew_n(F.G)); __syncthreads(); } }
        RUN2(1, P1_BODY, P1_BODY);
        if (BOTH(1)) GRID_BAR(1);
    }
    if (IN(2)) { RUN2(2, ssd_states_mfma(F), ssd_states_mfma(F)); RUN2(3, na_mfma(F, dry1), na_mfma(F, dry0)); if (BOTH(2)) GRID_BAR(2); }
    if (IN(3)) { RUN2(4, ssd_scan(F, dry1), ssd_scan(F, dry0)); if (!skew_on(F.G)) p_weights_late(F, 0, WL_IO + WL_I1 + WL_I2, F.vcu, F.G); if (BOTH(3)) GRID_BAR(3); }
    if (IN(4)) { RUN2(6, ssd_out_mfma(F, dry1), ssd_out_mfma(F, dry0)); if (BOTH(4)) GRID_BAR(4); }
    if (IN(5)) {
#define P5_BODY do { pg8::Gemm g{(const bf16*)(ws + WS_ZQ), (const bf16*)(ws + WS_WOUT), M, D, 2048}; pg8::StaticOrder S; S.init(M, D, F.G, (int)blockIdx.x); \
        pg8::EpiOutProj E{F.in[0], F.out, (bf16*)(ws + WS_XW), F.in[15], (float*)(ws + WS_SS)}; \
        pg8::gemm_phase<pg8::EpiOutProj, pg8::StaticOrder, false, PG8_SP2>(F.lds + RING_OFF, g, S, E); } while (0)
        RUN2(7, P5_BODY, P5_BODY);
        if (BOTH(5)) GRID_BAR(5);
    }
    if (IN(6)) {
#define P6_BODY do { pg8::Gemm g{(const bf16*)(ws + WS_XW), (const bf16*)(ws + WS_W1), M, FF, D}; pg8::StaticOrder S; S.init(M, FF, F.G, (int)blockIdx.x); \
        LAS float* rsl = (LAS float*)(F.lds + RING_OFF + RING_BYTES); { const float* SSp = (const float*)(ws + WS_SS); pg8::Unit u_; \
          for (int i_ = 0; i_ < 16 && S.next(i_, u_); ++i_) { const int r_ = F.tid >> 1, hf_ = F.tid & 1; const float* p_ = SSp + (size_t)(u_.pm * 256 + r_) * 16 + hf_ * 8; \
            const pg8::f32x4 a_ = *(const pg8::f32x4*)p_, b_ = *(const pg8::f32x4*)(p_ + 4); float s_ = ((a_[0] + a_[1]) + (a_[2] + a_[3])) + ((b_[0] + b_[1]) + (b_[2] + b_[3])); s_ += __shfl_xor(s_, 1); \
            if (!hf_) rsl[i_ * 256 + r_] = __builtin_amdgcn_rcpf(s_ * (1.0f / 1024.0f) + 1e-5f); } \
          __syncthreads(); } \
        pg8::EpiMlpIn E{(bf16*)(ws + WS_H), rsl, 0}; \
        pg8::gemm_phase<pg8::EpiMlpIn, pg8::StaticOrder, PG8_ALIGN, PG8_SP2>(F.lds + RING_OFF, g, S, E); } while (0)
        { const int c = (int)blockIdx.x; if (skew_on(F.G) && ((c >> 3) & 1)) { p_weights_late(F, WL_IO + WL_I1, WL_IO + WL_I1 + WL_I2, (c >> 4) * 8 + (c & 7), skew_n(F.G)); __syncthreads(); } }
        RUN2(8, P6_BODY, P6_BODY);
        if (BOTH(6)) GRID_BAR(6);
    }
    if (IN(7)) {
#define P7_BODY(DRY) do { pg8::Gemm g{(const bf16*)(ws + WS_H), (const bf16*)(ws + WS_W2), M, D, FF}; pg8::StaticOrder S; S.init(M, D, F.G, (int)blockIdx.x); \
        pg8::EpiMlpOut E{F.out, (const bf16*)(ws + WS_XW), F.in[15], DRY}; \
        pg8::gemm_phase<pg8::EpiMlpOut, pg8::StaticOrder, false, PG8_SP2>(F.lds + RING_OFF, g, S, E); } while (0)
        RUN2(9, P7_BODY(dry1), P7_BODY(dry0));
    }
#undef IN
#undef BOTH
}

extern "C" void kernel_launch(void* const* d_in, const int* in_sizes, int n_in, void* d_out, int out_size, void* d_ws, size_t ws_size, hipStream_t stream) {
    static int grid = 0;
    if (grid == 0) {
        if (n_in != 18 || in_sizes[0] != M * D || out_size != M * D || ws_size < WS_END) { fprintf(stderr, "kernel_launch: unexpected shapes (n_in %d, in0 %d, out %d, ws %zu); nothing launched\n", n_in, n_in > 0 ? in_sizes[0] : -1, out_size, ws_size); grid = -1; return; }
        int dev = 0, cus = 0, per_cu = 0;
        if (hipGetDevice(&dev) != hipSuccess || hipDeviceGetAttribute(&cus, hipDeviceAttributeMultiprocessorCount, dev) != hipSuccess) { grid = -1; return; }
        if (hipFuncSetAttribute((const void*)skel_fwd, hipFuncAttributeMaxDynamicSharedMemorySize, LDS_BYTES) != hipSuccess) { fprintf(stderr, "kernel_launch: hipFuncSetAttribute failed\n"); grid = -1; return; }
        if (hipOccupancyMaxActiveBlocksPerMultiprocessor(&per_cu, (const void*)skel_fwd, NWAVES * 64, LDS_BYTES) != hipSuccess || per_cu < 1)
            fprintf(stderr, "kernel_launch: note: occupancy query reports %d workgroups per CU\n", per_cu);
        (void)hipGetLastError();
        grid = cus;
    }
    if (grid < 0) return;
    if (hipMemsetAsync((char*)d_ws + WS_CTL, 0, CTL_ZERO_BYTES, stream) != hipSuccess) { fprintf(stderr, "kernel_launch: hipMemsetAsync failed\n"); return; }
    Args a{};
    for (int i = 0; i < 18; ++i) a.in[i] = (const float*)d_in[i];
    a.out = (float*)d_out; a.ws = (unsigned char*)d_ws;
    if (N_LAUNCHES == 1) { a.ph_lo = 0; a.ph_hi = PER_PHASE; a.li = 0; hipLaunchKernelGGL(skel_fwd, dim3(grid), dim3(NWAVES * 64), LDS_BYTES, stream, a); }
    else for (int li = 0; li < PER_PHASE; ++li) { a.ph_lo = li; a.ph_hi = li + 1; a.li = li; hipLaunchKernelGGL(skel_fwd, dim3(grid), dim3(NWAVES * 64), LDS_BYTES, stream, a); }
}
```
